# Optimizing an MI355X kernel written in HIP

```python
import jax, jax.numpy as jnp
from jax import lax
import numpy as np

D_MODEL = 1024
BATCH = 8
SEQ = 8192
DEPTH = 4

CHUNK = 64
REC_CHUNK = 16
Q_BLOCK = 128
N_MEM = 256
EPS = 1e-6
MASK_VALUE = -1e30
LB_FLOOR = 1e-30

MLA_HEADS = 4
MLA_Q_LORA = 256
MLA_KV_LORA = 256
MLA_NOPE = 128
MLA_ROPE = 64
MLA_V = 128
MLA_QK = MLA_NOPE + MLA_ROPE
ROPE_THETA = 10000.0

GLA_HEADS = 4
GLA_DK = 32
GLA_DV = 64
GLA_GATE_RANK = 16
GLA_TAU = 16.0

HGRN_HEADS = 4
HGRN_DK = 64
HGRN_DV = 64

D_MIX = MLA_HEADS * MLA_V + GLA_HEADS * GLA_DV + HGRN_HEADS * HGRN_DV

IN_SIZES = (
    MLA_Q_LORA, MLA_KV_LORA, MLA_ROPE,
    GLA_HEADS * GLA_DK, GLA_HEADS * GLA_DK, GLA_HEADS * GLA_DV,
    GLA_GATE_RANK, GLA_HEADS * GLA_DV,
    HGRN_HEADS * HGRN_DK, HGRN_HEADS * HGRN_DK,
    HGRN_HEADS * HGRN_DV, HGRN_HEADS * HGRN_DV,
)
P_IN = sum(IN_SIZES)

CA_HEADS = 4
CA_HEAD_DIM = 128

D_FF = 2816
CONV_WIDTH = 3

kernel_name = 'hybrid_mla_gla_hgrn2_memory_convglu'


def rms_norm(x, gain):
    xf = x.astype(jnp.float32)
    y = xf * lax.rsqrt(jnp.mean(xf * xf, axis=-1, keepdims=True) + EPS)
    return y.astype(x.dtype) * gain


def rotary(x, cos, sin):
    x1, x2 = jnp.split(x, 2, axis=-1)
    return jnp.concatenate([x1 * cos - x2 * sin, x2 * cos + x1 * sin], axis=-1)


def chunked_gated_recurrence(q, k, v, log_decay):
    B, S, H, DK = q.shape
    DV = v.shape[-1]
    n = S // REC_CHUNK

    def to_chunks(t):
        return t.astype(jnp.float32).reshape(B, n, REC_CHUNK, H, t.shape[-1]).transpose(0, 3, 1, 2, 4)

    qc, kc, vc, gc = to_chunks(q), to_chunks(k), to_chunks(v), to_chunks(log_decay)
    b = jnp.cumsum(gc, axis=3)
    b_last = b[:, :, :, -1:, :]
    causal = jnp.tril(jnp.ones((REC_CHUNK, REC_CHUNK), dtype=jnp.float32))
    rel = b[:, :, :, :, None, :] - b[:, :, :, None, :, :]
    pair_decay = jnp.exp(jnp.minimum(rel, 0.0)) * causal[:, :, None]
    scores = jnp.einsum('bhnid,bhnjd,bhnijd->bhnij', qc, kc, pair_decay)
    o_intra = jnp.einsum('bhnij,bhnjv->bhniv', scores, vc)

    updates = jnp.einsum('bhnjd,bhnjv->bhndv', kc * jnp.exp(b_last - b), vc)
    decays = jnp.exp(b_last[:, :, :, 0, :])

    def step(state, inp):
        decay, upd = inp
        return decay[..., None] * state + upd, state

    init = jnp.zeros((B, H, DK, DV), jnp.float32)
    _, starts = lax.scan(step, init, (jnp.moveaxis(decays, 2, 0), jnp.moveaxis(updates, 2, 0)))
    starts = jnp.moveaxis(starts, 0, 2)
    o_inter = jnp.einsum('bhnid,bhndv->bhniv', qc * jnp.exp(b), starts)
    o = (o_intra + o_inter).transpose(0, 2, 3, 1, 4).reshape(B, S, H, DV)
    return o.astype(v.dtype)


def mla_mixer(q_lat, kv_lat, k_rope, cos, sin, q_lat_norm, w_q_up, kv_lat_norm, w_kv_up, q_norm, k_norm):
    B, S, _ = q_lat.shape
    H = MLA_HEADS
    q = (rms_norm(q_lat, q_lat_norm) @ w_q_up).reshape(B, S, H, MLA_QK)
    kv = (rms_norm(kv_lat, kv_lat_norm) @ w_kv_up).reshape(B, S, H, MLA_NOPE + MLA_V)
    k_nope, v = kv[..., :MLA_NOPE], kv[..., MLA_NOPE:]
    k = jnp.concatenate([k_nope, jnp.broadcast_to(k_rope[:, :, None, :], (B, S, H, MLA_ROPE))], axis=-1)
    q = rms_norm(q, q_norm)
    k = rms_norm(k, k_norm)
    q = jnp.concatenate([q[..., :MLA_NOPE], rotary(q[..., MLA_NOPE:], cos, sin)], axis=-1)
    k = jnp.concatenate([k[..., :MLA_NOPE], rotary(k[..., MLA_NOPE:], cos, sin)], axis=-1)

    n_blocks = S // Q_BLOCK
    q_blocks = jnp.moveaxis(q.reshape(B, n_blocks, Q_BLOCK, H, MLA_QK), 1, 0)
    key_chunk = jnp.arange(S) // CHUNK
    scale = MLA_QK ** -0.5

    def attend(args):
        qb, blk = args
        s = jnp.einsum('bqhd,bkhd->bhqk', qb, k).astype(jnp.float32) * scale
        q_chunk = (blk * Q_BLOCK + jnp.arange(Q_BLOCK)) // CHUNK
        s = jnp.where(key_chunk[None, :] <= q_chunk[:, None], s, MASK_VALUE)
        p = jax.nn.softmax(s, axis=-1).astype(v.dtype)
        return jnp.einsum('bhqk,bkhd->bqhd', p, v)

    out = lax.map(attend, (q_blocks, jnp.arange(n_blocks)))
    return jnp.moveaxis(out, 0, 1).reshape(B, S, H * MLA_V)


def gla_mixer(q, k, v, gate_lr, r, w_gate, b_gate, out_norm):
    B, S, _ = q.shape
    H = GLA_HEADS
    log_alpha = jax.nn.log_sigmoid((gate_lr @ w_gate + b_gate).astype(jnp.float32)) / GLA_TAU
    o = chunked_gated_recurrence(
        q.reshape(B, S, H, GLA_DK) * (GLA_DK ** -0.5),
        k.reshape(B, S, H, GLA_DK),
        v.reshape(B, S, H, GLA_DV),
        log_alpha.reshape(B, S, H, GLA_DK))
    o = rms_norm(o, out_norm) * jax.nn.silu(r.reshape(B, S, H, GLA_DV))
    return o.reshape(B, S, H * GLA_DV)


def hgrn2_mixer(q, f_logit, i, g, lower_bound, out_norm):
    B, S, _ = q.shape
    H = HGRN_HEADS
    z = f_logit.astype(jnp.float32)
    log_f = jnp.logaddexp(jnp.log(jnp.maximum(lower_bound, LB_FLOOR)),
                          jnp.log1p(-lower_bound) + jax.nn.log_sigmoid(z))
    log_f = jnp.minimum(log_f, 0.0)
    one_minus_f = (1.0 - lower_bound) * jax.nn.sigmoid(-z)
    o = chunked_gated_recurrence(
        jax.nn.silu(q).reshape(B, S, H, HGRN_DK) * (HGRN_DK ** -0.5),
        one_minus_f.reshape(B, S, H, HGRN_DK),
        i.reshape(B, S, H, HGRN_DV),
        log_f.reshape(B, S, H, HGRN_DK))
    o = rms_norm(o, out_norm) * jax.nn.silu(g.reshape(B, S, H, HGRN_DV))
    return o.reshape(B, S, H * HGRN_DV)


def memory_cross_attention(h_norm, mem_norm, w_q, w_kv, q_norm, k_norm, w_out):
    B, S, _ = h_norm.shape
    M = mem_norm.shape[1]
    q = (h_norm @ w_q).reshape(B, S, CA_HEADS, CA_HEAD_DIM)
    kv = (mem_norm @ w_kv).reshape(B, M, CA_HEADS, 2 * CA_HEAD_DIM)
    k, v = kv[..., :CA_HEAD_DIM], kv[..., CA_HEAD_DIM:]
    q = rms_norm(q, q_norm)
    k = rms_norm(k, k_norm)
    s = jnp.einsum('bshd,bmhd->bhsm', q, k).astype(jnp.float32) * (CA_HEAD_DIM ** -0.5)
    p = jax.nn.softmax(s, axis=-1).astype(v.dtype)
    o = jnp.einsum('bhsm,bmhd->bshd', p, v).reshape(B, S, CA_HEADS * CA_HEAD_DIM)
    return o @ w_out


def conv_glu_ffn(h_norm, w_in, conv_w, conv_b, w_out):
    gate, up = jnp.split(h_norm @ w_in, 2, axis=-1)
    S = gate.shape[1]
    padded = jnp.pad(gate, ((0, 0), (CONV_WIDTH - 1, 0), (0, 0)))
    conv = conv_b
    for t in range(CONV_WIDTH):
        conv = conv + padded[:, t:t + S, :] * conv_w[t]
    return (jax.nn.silu(conv) * up) @ w_out


def setup_inputs(seed: int = 0) -> dict:
    key = jax.random.key(seed)
    ks = iter(jax.random.split(key, 40))
    f32 = jnp.float32
    out_scale = (2 * DEPTH) ** -0.5

    def dense(shape, fan_in, scale=1.0):
        return jax.random.normal(next(ks), shape, f32) * (scale * fan_in ** -0.5)

    def gain(shape):
        return 1.0 + 0.02 * jax.random.normal(next(ks), shape, f32)

    def small(shape):
        return 0.01 * jax.random.normal(next(ks), shape, f32)

    L = DEPTH
    x = jax.random.normal(next(ks), (BATCH, SEQ, D_MODEL), f32)
    mem = jax.random.normal(next(ks), (BATCH, N_MEM, D_MODEL), f32)
    start = jax.random.randint(next(ks), (BATCH, 1), 0, 4096, dtype=jnp.int32)
    positions = (start + jnp.arange(SEQ, dtype=jnp.int32)[None, :]).astype(jnp.int32)
    return {
        'x': x,
        'mem': mem,
        'positions': positions,
        'norm_mix': gain((L, D_MODEL)),
        'w_in': dense((L, D_MODEL, P_IN), D_MODEL),
        'mla_q_lat_norm': gain((L, MLA_Q_LORA)),
        'w_q_up': dense((L, MLA_Q_LORA, MLA_HEADS * MLA_QK), MLA_Q_LORA),
        'mla_kv_lat_norm': gain((L, MLA_KV_LORA)),
        'w_kv_up': dense((L, MLA_KV_LORA, MLA_HEADS * (MLA_NOPE + MLA_V)), MLA_KV_LORA),
        'mla_q_norm': gain((L, MLA_QK)),
        'mla_k_norm': gain((L, MLA_QK)),
        'gla_w_gate': dense((L, GLA_GATE_RANK, GLA_HEADS * GLA_DK), GLA_GATE_RANK),
        'gla_b_gate': small((L, GLA_HEADS * GLA_DK)),
        'gla_out_norm': gain((L, GLA_DV)),
        'hgrn_lb_logits': 0.1 * jax.random.normal(next(ks), (L, HGRN_HEADS * HGRN_DK), f32),
        'hgrn_out_norm': gain((L, HGRN_DV)),
        'w_mix_out': dense((L, D_MIX, D_MODEL), D_MIX, out_scale),
        'norm_ca': gain((L, D_MODEL)),
        'norm_mem': gain((L, D_MODEL)),
        'w_ca_q': dense((L, D_MODEL, CA_HEADS * CA_HEAD_DIM), D_MODEL),
        'w_ca_kv': dense((L, D_MODEL, 2 * CA_HEADS * CA_HEAD_DIM), D_MODEL),
        'ca_q_norm': gain((L, CA_HEAD_DIM)),
        'ca_k_norm': gain((L, CA_HEAD_DIM)),
        'w_ca_out': dense((L, CA_HEADS * CA_HEAD_DIM, D_MODEL), CA_HEADS * CA_HEAD_DIM, out_scale),
        'norm_ffn': gain((L, D_MODEL)),
        'w_ffn_in': dense((L, D_MODEL, 2 * D_FF), D_MODEL),
        'ffn_conv_w': dense((L, CONV_WIDTH, D_FF), CONV_WIDTH),
        'ffn_conv_b': small((L, D_FF)),
        'w_ffn_out': dense((L, D_FF, D_MODEL), D_FF, out_scale),
    }


def reference(x, mem, positions, norm_mix, w_in, mla_q_lat_norm, w_q_up, mla_kv_lat_norm, w_kv_up,
              mla_q_norm, mla_k_norm, gla_w_gate, gla_b_gate, gla_out_norm, hgrn_lb_logits, hgrn_out_norm,
              w_mix_out, norm_ca, norm_mem, w_ca_q, w_ca_kv, ca_q_norm, ca_k_norm, w_ca_out,
              norm_ffn, w_ffn_in, ffn_conv_w, ffn_conv_b, w_ffn_out):
    gamma = jax.nn.softmax(hgrn_lb_logits.astype(jnp.float32), axis=0)
    lower_bounds = jnp.cumsum(gamma, axis=0) - gamma[0]

    inv_freq = ROPE_THETA ** (-jnp.arange(0, MLA_ROPE, 2, dtype=jnp.float32) / MLA_ROPE)
    ang = positions.astype(jnp.float32)[..., None] * inv_freq
    cos = jnp.cos(ang)[:, :, None, :].astype(x.dtype)
    sin = jnp.sin(ang)[:, :, None, :].astype(x.dtype)

    split_points = np.cumsum(IN_SIZES)[:-1].tolist()
    h = x
    for l in range(DEPTH):
        n = rms_norm(h, norm_mix[l])
        (a_q_lat, a_kv_lat, a_k_rope, b_q, b_k, b_v, b_gate_lr, b_r,
         c_q, c_f, c_i, c_g) = jnp.split(n @ w_in[l], split_points, axis=-1)
        y_a = mla_mixer(a_q_lat, a_kv_lat, a_k_rope, cos, sin, mla_q_lat_norm[l], w_q_up[l],
                        mla_kv_lat_norm[l], w_kv_up[l], mla_q_norm[l], mla_k_norm[l])
        y_b = gla_mixer(b_q, b_k, b_v, b_gate_lr, b_r, gla_w_gate[l], gla_b_gate[l], gla_out_norm[l])
        y_c = hgrn2_mixer(c_q, c_f, c_i, c_g, lower_bounds[l], hgrn_out_norm[l])
        h = h + jnp.concatenate([y_a, y_b, y_c], axis=-1) @ w_mix_out[l]
        h = h + memory_cross_attention(rms_norm(h, norm_ca[l]), rms_norm(mem, norm_mem[l]),
                                       w_ca_q[l], w_ca_kv[l], ca_q_norm[l], ca_k_norm[l], w_ca_out[l])
        h = h + conv_glu_ffn(rms_norm(h, norm_ffn[l]), w_ffn_in[l], ffn_conv_w[l], ffn_conv_b[l], w_ffn_out[l])
    return h
```

```cpp
#include <hip/hip_runtime.h>
#include <cstdio>
#include <cstdint>

#ifndef PROBE_MASK
#define PROBE_MASK 0
#endif
#ifndef MK_FUSED
#define MK_FUSED 1
#endif

#define LAS __attribute__((address_space(3)))
typedef unsigned short bf16_t;
typedef short bf16x8 __attribute__((ext_vector_type(8)));
typedef short s16x4 __attribute__((ext_vector_type(4)));
typedef float f32x2 __attribute__((ext_vector_type(2)));
typedef float f32x4 __attribute__((ext_vector_type(4)));
typedef float f32x16 __attribute__((ext_vector_type(16)));
typedef unsigned u32x2 __attribute__((ext_vector_type(2)));
typedef unsigned u32x4 __attribute__((ext_vector_type(4)));

constexpr int NB = 8, SEQ = 8192, DM = 1024, DEPTH = 4, T = NB * SEQ;
constexpr int NMEM = 256, P_IN = 2384, D_FF = 2816;
constexpr float EPS = 1e-6f, LOG2E = 1.4426950408889634f;
constexpr int NWAVES = 8, NTHREADS = 512;

typedef __bf16 bf16x2_t __attribute__((ext_vector_type(2)));
__device__ __forceinline__ unsigned cvt_pk_bf16(float lo, float hi) { const f32x2 v = {lo, hi}; return __builtin_bit_cast(unsigned, __builtin_convertvector(v, bf16x2_t)); }
__device__ __forceinline__ float bf2f(unsigned short b) { return __uint_as_float(((unsigned)b) << 16); }
__device__ __forceinline__ float bflo(unsigned w) { return __uint_as_float(w << 16); }
__device__ __forceinline__ float bfhi(unsigned w) { return __uint_as_float(w & 0xffff0000u); }
__device__ __forceinline__ bf16_t f2bf(float f) { return (bf16_t)(cvt_pk_bf16(f, 0.f) & 0xffffu); }
__device__ __forceinline__ float wave_sum(float v) {
#pragma unroll
    for (int o = 1; o < 64; o <<= 1) v += __shfl_xor(v, o);
    return v;
}

__device__ __forceinline__ float wave_sum_dpp(float v) {
#define DPPF(x, ctrl, rm, bc) __builtin_bit_cast(float, __builtin_amdgcn_update_dpp(0, __builtin_bit_cast(int, (x)), (ctrl), (rm), 0xf, (bc)))
    v += DPPF(v, 0x111, 0xf, true); v += DPPF(v, 0x112, 0xf, true); v += DPPF(v, 0x114, 0xf, true); v += DPPF(v, 0x118, 0xf, true);
    v += DPPF(v, 0x142, 0xa, false); v += DPPF(v, 0x143, 0xc, false);
#undef DPPF
    return __uint_as_float((unsigned)__builtin_amdgcn_readlane((int)__float_as_uint(v), 63));
}
__device__ __forceinline__ float sum16(float v) {
    v += __shfl_xor(v, 1); v += __shfl_xor(v, 2); v += __shfl_xor(v, 4); v += __shfl_xor(v, 8); return v;
}
__device__ __forceinline__ float fast_sigmoid(float x) { return __builtin_amdgcn_rcpf(1.0f + __expf(-x)); }
__device__ __forceinline__ float fast_silu(float x) { return x * fast_sigmoid(x); }
__device__ __forceinline__ u32x4 pack8(f32x4 a, f32x4 b) { u32x4 w; w.x = cvt_pk_bf16(a[0], a[1]); w.y = cvt_pk_bf16(a[2], a[3]); w.z = cvt_pk_bf16(b[0], b[1]); w.w = cvt_pk_bf16(b[2], b[3]); return w; }


typedef _Float16 f16x2_t __attribute__((ext_vector_type(2)));
typedef _Float16 f16x8_t __attribute__((ext_vector_type(8)));
__device__ __forceinline__ unsigned cvt_pk_f16(float lo, float hi) { const f32x2 v = {lo, hi}; return __builtin_bit_cast(unsigned, __builtin_convertvector(v, f16x2_t)); }
__device__ __forceinline__ u32x4 pack8h(f32x4 a, f32x4 b) { u32x4 w; w.x = cvt_pk_f16(a[0], a[1]); w.y = cvt_pk_f16(a[2], a[3]); w.z = cvt_pk_f16(b[0], b[1]); w.w = cvt_pk_f16(b[2], b[3]); return w; }
__device__ __forceinline__ f32x2 unpk_f16(unsigned w) { return __builtin_convertvector(__builtin_bit_cast(f16x2_t, w), f32x2); }

#define XB_TMO      128
#define XB_XCNT(j)  (256  + 64 * (j))
#define XB_XSUB(j)  (1280 + 64 * (j))
#define XB_XGEN(j)  (2304 + 64 * (j))
#define XB_TOP      3328
#define XB_TOPGEN   3392
#define XCD_BAR_WORDS 3456
#define XB_SPIN_CAP (1u << 20)

__device__ __forceinline__ unsigned xb_ld(unsigned* p)              { return __hip_atomic_load(p, __ATOMIC_RELAXED, __HIP_MEMORY_SCOPE_AGENT); }
__device__ __forceinline__ unsigned xb_add(unsigned* p, unsigned v) { return __hip_atomic_fetch_add(p, v, __ATOMIC_RELAXED, __HIP_MEMORY_SCOPE_AGENT); }
__device__ __forceinline__ unsigned xb_xcc_id() { return (unsigned)__builtin_amdgcn_s_getreg((3 << 11) | 20) & 0xFu; }
#define XB_SPIN(cond, bar) do { unsigned _sp = 0; while (cond) { __builtin_amdgcn_s_sleep(1); \
    if ((++_sp & 255u) == 0u) { if (xb_ld(&(bar)[XB_TMO])) break; if (_sp > XB_SPIN_CAP) { atomicAdd(&(bar)[XB_TMO], 1u); break; } } } } while (0)

struct XcdBarrier { unsigned* bar; unsigned x; volatile LAS unsigned* st; };

__device__ __forceinline__ XcdBarrier xcd_barrier_post(unsigned* bar, volatile LAS unsigned* st) {
    XcdBarrier b; b.bar = bar; b.x = xb_xcc_id(); b.st = st;
    if (threadIdx.x == 0) (void)xb_add(&bar[XB_XCNT(b.x)], 1u);
    return b;
}
__device__ __forceinline__ void xcd_barrier_complete(unsigned* bar, unsigned x, unsigned& nloc, unsigned& nx) {
    const unsigned G = gridDim.x * gridDim.y * gridDim.z;
    unsigned sum, cnt, mine, sp = 0u;
    for (;;) {
        sum = 0u; cnt = 0u; mine = 0u;
#pragma unroll
        for (unsigned j = 0; j < 16; ++j) { const unsigned c = xb_ld(&bar[XB_XCNT(j)]); sum += c; cnt += (c > 0u) ? 1u : 0u; mine = (j == x) ? c : mine; }
        if (sum == G) break;
        __builtin_amdgcn_s_sleep(1);
        if ((++sp & 255u) == 0u) { if (xb_ld(&bar[XB_TMO])) break; if (sp > XB_SPIN_CAP) { atomicAdd(&bar[XB_TMO], 1u); break; } }
    }
    nloc = mine > 0u ? mine : 1u; nx = cnt > 0u ? cnt : 1u;
}
__device__ __forceinline__ void xcd_barrier(const XcdBarrier& b) {
    asm volatile("s_waitcnt vmcnt(0)" ::: "memory");
    __syncthreads();
    if (threadIdx.x == 0) {
        unsigned* bar = b.bar;
        __builtin_amdgcn_s_waitcnt(0);
        unsigned nloc = b.st[0], nx = b.st[1];
        if (nloc == 0u) { xcd_barrier_complete(bar, b.x, nloc, nx); b.st[0] = nloc; b.st[1] = nx; }
        const unsigned old = xb_add(&bar[XB_XSUB(b.x)], 1u);
        const unsigned gen = old / nloc;
        if (old + 1u == (gen + 1u) * nloc) {
            __builtin_amdgcn_fence(__ATOMIC_RELEASE, "agent");
            asm volatile("s_waitcnt vmcnt(0)" ::: "memory");
            const unsigned og = xb_add(&bar[XB_TOP], 1u);
            const unsigned tg = og / nx;
            if (og + 1u == (tg + 1u) * nx) xb_add(&bar[XB_TOPGEN], 1u);
            else XB_SPIN(xb_ld(&bar[XB_TOPGEN]) == tg, bar);
            __builtin_amdgcn_fence(__ATOMIC_ACQUIRE, "agent");
            xb_add(&bar[XB_XGEN(b.x)], 1u);
            asm volatile("s_waitcnt vmcnt(0)" ::: "memory");
        } else {
            XB_SPIN(xb_ld(&bar[XB_XGEN(b.x)]) == gen, bar);
            __builtin_amdgcn_fence(__ATOMIC_ACQUIRE, "agent");
            asm volatile("s_waitcnt vmcnt(0)" ::: "memory");
        }
    }
    __syncthreads();
}

namespace pg8 {
#define PG8_LAS __attribute__((address_space(3)))
constexpr int BM = 256, BK = 64, HALF = 128, HTB = HALF * BK * 2, STAGE_BYTES = 8 * HTB, NXCD = 8, WGM = 8;
__host__ __device__ __forceinline__ int lds_byte(int r, int c) { const int st = (r >> 4) * 2 + (c >> 5), rr = r & 15, cc = c & 31, ob = rr * 64 + cc * 2; return st * 1024 + (ob ^ (((ob >> 9) & 1) << 5)); }
__host__ __device__ __forceinline__ void stage_rc(int b, int& R, int& C) { const int st = b / 1024, sb = b % 1024, swz = sb ^ (((sb >> 9) & 1) << 5); R = (st >> 1) * 16 + swz / 64; C = (st & 1) * 32 + (swz % 64) / 2; }
__host__ __device__ __forceinline__ int perm32(int rho) { const int n = rho >> 4, i = rho & 15; return 8 * (i >> 2) + 4 * n + (i & 3); }
struct Unit { int pm, pn; };
struct Gemm { const bf16_t* A; const bf16_t* Bt; int M, N, K; };
struct StaticOrder {
    int nM, nN, nwg, G, c;
    __host__ __device__ void init(int M, int N, int G_, int c_) { nM = M / BM; nN = N / BM; nwg = nM * nN; G = G_; c = c_; }
    __host__ __device__ bool next(int i, Unit& u) const {
        const long L = (long)i * G + c; if (L >= nwg) return false;
        int wgid = (int)L; { const int q = nwg / NXCD, r = nwg % NXCD, xcd = wgid % NXCD, off = wgid / NXCD; wgid = (xcd < r ? xcd * (q + 1) : r * (q + 1) + (xcd - r) * q) + off; }
        const int nig = WGM * nN, gid = wgid / nig, fm = gid * WGM, gsz = (nM - fm) < WGM ? (nM - fm) : WGM;
        u.pm = fm + ((wgid % nig) % gsz); u.pn = (wgid % nig) / gsz; return true;
    }
    __device__ __forceinline__ void a_ready(const Unit&) const {}
    __device__ __forceinline__ void done(const Unit&) const {}
};
struct StaticOrderG1 : StaticOrder {
    __device__ __forceinline__ bool next(int i, Unit& u) const {
        const bool r = StaticOrder::next(i, u);
        if (r) { const int q = u.pn; u.pn = (q == 3) ? 4 : (q == 4) ? 3 : (q == 8) ? 9 : (q == 9) ? 8 : q; }
        return r; }
};
struct PanelOrder {
    int pm, n;
    __device__ __forceinline__ bool next(int i, Unit& u) const { if (i >= n) return false; u.pm = pm; u.pn = i; return true; }
    __device__ __forceinline__ void a_ready(const Unit&) const {}
    __device__ __forceinline__ void done(const Unit&) const {}
};

template <class Epi, class Sched, bool F16 = false, bool ALIGN_EPI = true, bool SP2 = true>
__device__ __forceinline__ void gemm_phase(PG8_LAS unsigned char* lds, const Gemm g, const Sched& S, const Epi& E) {
    int tid = threadIdx.x; asm volatile("" : "+v"(tid));
    const int wid = __builtin_amdgcn_readfirstlane(tid >> 6), lane = tid & 63, wr = wid >> 2, wc = wid & 3, fr = lane & 15, fq = lane >> 4;
    const int K = g.K, nt = K / BK;
    unsigned voffA[2], voffB[2];
#pragma unroll
    for (int i = 0; i < 2; ++i) { int R, C; stage_rc(tid * 16 + i * 8192, R, C); const int Rb = Epi::PERM ? ((R & ~31) + perm32(R & 31)) : R;
        voffA[i] = (unsigned)(R * K + C) * 2u; voffB[i] = (unsigned)(Rb * K + C) * 2u; }
    const size_t kstep = (size_t)(BK * 2);
    const size_t hstep = (size_t)HALF * K * 2;
    const size_t tstep = 2 * hstep;
    const unsigned ldsw = (unsigned)wid * 1024u;
    const int aoff = lds_byte(wr * 64 + fr, fq * 8), boff = lds_byte(wc * 32 + fr, fq * 8);
#define PG8_SA(b, h) (((b) * 2 + (h)) * HTB)
#define PG8_SB(b, h) ((4 + (b) * 2 + (h)) * HTB)
#define PG8_STAGE(bufoff, gbase, voff) do { _Pragma("unroll") for (int _i = 0; _i < 2; ++_i) \
        __builtin_amdgcn_global_load_lds((const unsigned*)((const char*)(gbase) + (voff)[_i]), (PG8_LAS unsigned*)(lds + (bufoff) + ldsw + _i * 8192), 16, 0, 0); } while (0)
#define PG8_LDA(dst, b, h) do { _Pragma("unroll") for (int m = 0; m < 4; ++m) _Pragma("unroll") for (int k = 0; k < 2; ++k) dst[m][k] = *(const PG8_LAS bf16x8*)(lds + PG8_SA(b, h) + aoff + m * 2048 + k * 1024); } while (0)
#define PG8_LDB(dst, b, h) do { _Pragma("unroll") for (int n = 0; n < 2; ++n) _Pragma("unroll") for (int k = 0; k < 2; ++k) dst[n][k] = *(const PG8_LAS bf16x8*)(lds + PG8_SB(b, h) + boff + n * 2048 + k * 1024); } while (0)
#define PG8_MMA(ai, bj, At, Bt) do { __builtin_amdgcn_s_setprio(1); _Pragma("unroll") for (int m = 0; m < 4; ++m) _Pragma("unroll") for (int n = 0; n < 2; ++n) _Pragma("unroll") for (int k = 0; k < 2; ++k) \
        acc[ai][bj][m][n] = F16 ? __builtin_amdgcn_mfma_f32_16x16x32_f16(__builtin_bit_cast(f16x8_t, Bt[n][k]), __builtin_bit_cast(f16x8_t, At[m][k]), acc[ai][bj][m][n], 0, 0, 0) \
                                : __builtin_amdgcn_mfma_f32_16x16x32_bf16(Bt[n][k], At[m][k], acc[ai][bj][m][n], 0, 0, 0); __builtin_amdgcn_s_setprio(0); } while (0)
#define PG8_WAIT_V(n) asm volatile("s_waitcnt vmcnt(" #n ")" ::: "memory")
#define PG8_WAIT_L(n) asm volatile("s_waitcnt lgkmcnt(" #n ")" ::: "memory")
#define PG8_BAR __builtin_amdgcn_s_barrier()
#define PG8_SCHED __builtin_amdgcn_sched_barrier(0)
    Unit cur, nxt; int ui = 0;
    if (!S.next(0, cur)) return;
    f32x4 acc[2][2][4][2];
#pragma unroll
    for (int a = 0; a < 2; ++a)
#pragma unroll
        for (int b = 0; b < 2; ++b)
#pragma unroll
            for (int m = 0; m < 4; ++m)
#pragma unroll
                for (int n = 0; n < 2; ++n) acc[a][b][m][n] = (f32x4){0.f, 0.f, 0.f, 0.f};
    bf16x8 At[4][2], B0[2][2], B1[2][2];
    const char* cA = (const char*)g.A + (size_t)cur.pm * tstep; const char* cB = (const char*)g.Bt + (size_t)cur.pn * tstep;
    S.a_ready(cur);
    E.prefetch(cur, wid, lane);
    if constexpr (SP2) {
        PG8_STAGE(PG8_SB(0, 0), cB, voffB); PG8_STAGE(PG8_SB(0, 1), cB + hstep, voffB); PG8_STAGE(PG8_SA(0, 0), cA, voffA); PG8_STAGE(PG8_SA(0, 1), cA + hstep, voffA);
        if (wr == 1) PG8_BAR;
        PG8_WAIT_V(2); PG8_BAR;
        PG8_STAGE(PG8_SB(1, 0), cB + kstep, voffB); PG8_STAGE(PG8_SA(1, 0), cA + kstep, voffA); PG8_STAGE(PG8_SB(1, 1), cB + hstep + kstep, voffB);
        PG8_WAIT_V(6); PG8_BAR;
    } else {
        PG8_STAGE(PG8_SB(0, 0), cB, voffB); PG8_STAGE(PG8_SA(0, 0), cA, voffA); PG8_STAGE(PG8_SB(0, 1), cB + hstep, voffB); PG8_STAGE(PG8_SA(0, 1), cA + hstep, voffA);
        if (wr == 1) PG8_BAR;
        PG8_WAIT_V(4); PG8_BAR;
        PG8_STAGE(PG8_SB(1, 0), cB + kstep, voffB); PG8_STAGE(PG8_SA(1, 0), cA + kstep, voffA); PG8_STAGE(PG8_SB(1, 1), cB + hstep + kstep, voffB);
        PG8_WAIT_V(6); PG8_BAR;
    }
    for (;;) {
        const bool has_next = S.next(ui + 1, nxt);
        const char* nA = has_next ? (const char*)g.A + (size_t)nxt.pm * tstep : cA; const char* nB = has_next ? (const char*)g.Bt + (size_t)nxt.pn * tstep : cB;
        for (int t = 0; t < nt; t += 2) {
            const bool last = (t == nt - 2);
            const char* a1 = cA + (size_t)(t + 1) * kstep;
            const char* a2 = last ? nA : cA + (size_t)(t + 2) * kstep; const char* b2 = last ? nB : cB + (size_t)(t + 2) * kstep;
            const char* a3 = a2 + kstep; const char* b3 = b2 + kstep;
            if (last && has_next) S.a_ready(nxt);
            if constexpr (SP2) {
            PG8_LDB(B0, 0, 0); PG8_LDB(B1, 0, 1); PG8_SCHED; PG8_LDA(At, 0, 0); PG8_STAGE(PG8_SA(1, 1), a1 + hstep, voffA);
            PG8_WAIT_V(8); PG8_WAIT_L(0); PG8_BAR; PG8_MMA(0, 0, At, B0); PG8_MMA(0, 1, At, B1); PG8_BAR; PG8_SCHED;
            PG8_LDA(At, 0, 1); PG8_STAGE(PG8_SB(0, 0), b2, voffB); PG8_STAGE(PG8_SB(0, 1), b2 + hstep, voffB); PG8_STAGE(PG8_SA(0, 0), a2, voffA);
            PG8_WAIT_V(8); PG8_WAIT_L(0); PG8_BAR; PG8_MMA(1, 0, At, B0); PG8_MMA(1, 1, At, B1); PG8_BAR; PG8_SCHED;
            PG8_LDB(B0, 1, 0); PG8_LDB(B1, 1, 1); PG8_SCHED; PG8_LDA(At, 1, 0); PG8_STAGE(PG8_SA(0, 1), a2 + hstep, voffA);
            PG8_WAIT_V(8); PG8_WAIT_L(0); PG8_BAR; PG8_MMA(0, 0, At, B0); PG8_MMA(0, 1, At, B1); PG8_BAR; PG8_SCHED;
            PG8_LDA(At, 1, 1); PG8_STAGE(PG8_SB(1, 0), b3, voffB); PG8_STAGE(PG8_SB(1, 1), b3 + hstep, voffB); PG8_STAGE(PG8_SA(1, 0), a3, voffA);
            PG8_WAIT_V(8); PG8_WAIT_L(0); PG8_BAR; PG8_MMA(1, 0, At, B0); PG8_MMA(1, 1, At, B1); PG8_BAR; PG8_SCHED;
            } else {
            PG8_LDB(B0, 0, 0); PG8_SCHED; PG8_LDA(At, 0, 0); PG8_STAGE(PG8_SA(1, 1), a1 + hstep, voffA);
            PG8_WAIT_L(8); PG8_BAR; PG8_WAIT_L(0); PG8_MMA(0, 0, At, B0); PG8_BAR; PG8_SCHED;
            PG8_LDB(B1, 0, 1); PG8_STAGE(PG8_SB(0, 0), b2, voffB);
            PG8_BAR; PG8_WAIT_L(0); PG8_MMA(0, 1, At, B1); PG8_BAR;
            PG8_LDA(At, 0, 1); PG8_STAGE(PG8_SA(0, 0), a2, voffA);
            PG8_BAR; PG8_WAIT_L(0); PG8_MMA(1, 0, At, B0); PG8_BAR; PG8_SCHED;
            PG8_STAGE(PG8_SB(0, 1), b2 + hstep, voffB);
            PG8_WAIT_V(6); PG8_BAR; PG8_MMA(1, 1, At, B1); PG8_BAR;
            PG8_LDB(B0, 1, 0); PG8_SCHED; PG8_LDA(At, 1, 0); PG8_STAGE(PG8_SA(0, 1), a2 + hstep, voffA);
            PG8_WAIT_L(8); PG8_BAR; PG8_WAIT_L(0); PG8_MMA(0, 0, At, B0); PG8_BAR; PG8_SCHED;
            PG8_LDB(B1, 1, 1); PG8_STAGE(PG8_SB(1, 0), b3, voffB);
            PG8_BAR; PG8_WAIT_L(0); PG8_MMA(0, 1, At, B1); PG8_BAR;
            PG8_LDA(At, 1, 1); PG8_STAGE(PG8_SA(1, 0), a3, voffA);
            PG8_BAR; PG8_WAIT_L(0); PG8_MMA(1, 0, At, B0); PG8_BAR; PG8_SCHED;
            PG8_STAGE(PG8_SB(1, 1), b3 + hstep, voffB);
            PG8_WAIT_V(6); PG8_BAR; PG8_MMA(1, 1, At, B1); PG8_BAR;
            }
        }
        if constexpr (ALIGN_EPI) { if (wr == 0) PG8_BAR; }
        E(acc, cur, wr, wc, fr, fq);
        if (!has_next) break;
        E.prefetch(nxt, wid, lane);
#pragma unroll
        for (int a = 0; a < 2; ++a)
#pragma unroll
            for (int b = 0; b < 2; ++b)
#pragma unroll
                for (int m = 0; m < 4; ++m)
#pragma unroll
                    for (int n = 0; n < 2; ++n) acc[a][b][m][n] = (f32x4){0.f, 0.f, 0.f, 0.f};
        cur = nxt; cA = nA; cB = nB; ++ui;
        if constexpr (ALIGN_EPI) { if (wr == 1) PG8_BAR; }
    }
    PG8_WAIT_V(0);
    if constexpr (!ALIGN_EPI) { if (wr == 0) PG8_BAR; }
    PG8_BAR;
#undef PG8_SA
#undef PG8_SB
#undef PG8_STAGE
#undef PG8_LDA
#undef PG8_LDB
#undef PG8_MMA
#undef PG8_WAIT_V
#undef PG8_WAIT_L
#undef PG8_BAR
#undef PG8_SCHED
}
}


constexpr size_t MiB = 1024 * 1024;
constexpr size_t al256(size_t x) { return (x + 255) / 256 * 256; }
constexpr size_t W_IN = 0, W_Q = W_IN + (size_t)2560 * 1024, W_KV = W_Q + (size_t)1024 * 256, W_MIX = W_KV + (size_t)1024 * 256, W_CAQ = W_MIX + (size_t)1024 * 1024,
                 W_CAKV = W_CAQ + (size_t)512 * 1024, W_CAO = W_CAKV + (size_t)1024 * 1024, W_FFI = W_CAO + (size_t)1024 * 512, W_FFO = W_FFI + (size_t)5632 * 1024,
                 W_LAYER = W_FFO + (size_t)1024 * 2816;
constexpr size_t WS_CTL = 0, CTL_BYTES = 65536;
constexpr size_t WS_LB = WS_CTL + CTL_BYTES;
constexpr size_t WS_RSTD = WS_LB + 4096;
constexpr size_t WS_CQ = WS_RSTD + (size_t)T * 4, WS_CKV = WS_CQ + (size_t)T * 4;
constexpr size_t WS_MEMRSTD = WS_CKV + (size_t)T * 4;
constexpr size_t WS_MEMB = WS_MEMRSTD + 8192;
constexpr size_t WS_KVRAW = WS_MEMB + (size_t)2048 * 1024 * 2;
constexpr size_t WS_KCA = WS_KVRAW + (size_t)2048 * 1024 * 4;
constexpr size_t WS_VCA = WS_KCA + (size_t)4 * 2048 * 512 * 2;
constexpr size_t WS_ROT = WS_VCA + (size_t)4 * 2048 * 512 * 2;
constexpr size_t WS_PART = WS_ROT + (size_t)T * 32 * 8;
constexpr size_t WS_LATP = WS_PART + (size_t)T * 16 * 4;
constexpr size_t WS_W = WS_LATP + (size_t)T * 16 * 4;
constexpr size_t WS_HB = al256(WS_W + 4 * W_LAYER * 2);
constexpr size_t WS_R = WS_HB + (size_t)T * 1024 * 2;
constexpr size_t R_GQK = WS_R, R_GA = R_GQK + 32 * MiB, R_GV = R_GA + 32 * MiB, R_GR = R_GV + 32 * MiB, R_HQ = R_GR + 32 * MiB, R_HA = R_HQ + 32 * MiB, R_HI = R_HA + 64 * MiB,
                 R_HG = R_HI + 32 * MiB, R_QLAT = R_HG + 32 * MiB  , R_KVLAT = R_QLAT + 32 * MiB, R_KROPE = R_KVLAT + 32 * MiB, R_Y = R_KROPE + 8 * MiB  ,
                 R_SG = R_Y + 128 * MiB, R_SH = R_SG + 8 * MiB, R_PG = R_SH + 16 * MiB, R_PH = R_PG + 1 * MiB, R_Q = R_PH + 1 * MiB  , R_KRH = R_Q + 96 * MiB, R_HK = R_KRH + 32 * MiB, R_END1 = R_HK + 32 * MiB;
constexpr size_t R_QRAW = WS_R, R_KVRAW = WS_R + 128 * MiB;
constexpr size_t R_KN = WS_R, R_V = WS_R + 64 * MiB;
constexpr size_t R_QCA = WS_R, R_OCA = WS_R + 64 * MiB;
constexpr size_t R_GH = WS_R, R_UH = WS_R + 16 * MiB, R_URAW = WS_R + 352 * MiB, R_END3 = R_URAW + 352 * MiB;
constexpr size_t WS_END = R_END3;
static_assert(R_END1 <= R_END3, "mixer window must fit the region");
static_assert(WS_END <= (size_t)1024 * MiB, "workspace map exceeds 1 GiB");

constexpr size_t LDS_STAGE = 131072, LDS_MISC = 163840 - 256, LDS_BYTES = 163840;


__device__ __forceinline__ void stat_dma(const float* tab, PG8_LAS float* st, const int pm, const int wid, const int lane) {
#pragma unroll
    for (int i = 0; i < 2; ++i)
        __builtin_amdgcn_global_load_lds((const unsigned*)(tab + ((size_t)pm * 256 + 32 * wid) * 16 + (i * 64 + lane) * 4), (PG8_LAS unsigned*)((PG8_LAS unsigned char*)st + wid * 2048 + i * 1024), 16, 0, 0);
}
__device__ __forceinline__ float rstd_from_lds(const PG8_LAS float* strow) {
    const f32x4 v = *(const PG8_LAS f32x4*)strow;
    float sq = (v[0] + v[1]) + (v[2] + v[3]); sq += __shfl_xor(sq, 16); sq += __shfl_xor(sq, 32);
    return __builtin_amdgcn_rsqf(sq * (1.0f / DM) + EPS);
}
__device__ __forceinline__ float rstd_from_part(const float* part, const size_t row, const int fq) {
    const f32x4 v = *(const f32x4*)(part + row * 16 + 4 * fq);
    float s = (v[0] + v[1]) + (v[2] + v[3]);
    s += __shfl_xor(s, 16); s += __shfl_xor(s, 32);
    return __builtin_amdgcn_rsqf(s * (1.0f / DM) + EPS);
}
struct EpiInProj {
    static constexpr bool PERM = true, AFTER_DRAIN = false;
    unsigned char* wsb;
    const float* bgate; const float* lb;
    PG8_LAS float* st;
    template <int MODE>
    __device__ __forceinline__ void run(const f32x4 (&acc)[2][2][4][2], const int row0, const int cw, const int wc, bf16_t* dst, const float sc, const int lslot, const PG8_LAS float* strow) const {
        const int fq = (cw >> 3) & 3;
#pragma unroll
        for (int ai = 0; ai < 2; ++ai)
#pragma unroll
            for (int m = 0; m < 4; ++m) {
                const size_t row = (size_t)(row0 + ai * 128 + m * 16);
                const float rs = rstd_from_lds(strow + (ai * 128 + m * 16) * 16);
                float lss = 0.f;
#pragma unroll
                for (int bj = 0; bj < 2; ++bj) {
                    f32x4 v0 = acc[ai][bj][m][0] * rs, v1 = acc[ai][bj][m][1] * rs;
                    const int c = bj * 128 + cw;
                    if constexpr (MODE == 0 || MODE == 4) { *(u32x4*)(dst + row * 256 + c) = pack8(v0, v1);
                        if constexpr (MODE == 4) lss += (v0[0] * v0[0] + v0[1] * v0[1]) + (v0[2] * v0[2] + v0[3] * v0[3]) + (v1[0] * v1[0] + v1[1] * v1[1]) + (v1[2] * v1[2] + v1[3] * v1[3]); }
                    else if constexpr (MODE == 1) {
#pragma unroll
                        for (int j = 0; j < 4; ++j) { v0[j] = fast_silu(v0[j]) * sc; v1[j] = fast_silu(v1[j]) * sc; }
                        *(u32x4*)(dst + row * 256 + c) = pack8(v0, v1);
                    } else if constexpr (MODE == 2) {
                        const f32x4 l0 = *(const f32x4*)(lb + c), l1 = *(const f32x4*)(lb + c + 4);
                        f32x4 k0, k1;
#pragma unroll
                        for (int j = 0; j < 4; ++j) { const float a0 = l0[j] + (1.0f - l0[j]) * fast_sigmoid(v0[j]), a1 = l1[j] + (1.0f - l1[j]) * fast_sigmoid(v1[j]);
                            k0[j] = 1.0f - a0; k1[j] = 1.0f - a1; v0[j] = fminf(__logf(a0), 0.f); v1[j] = fminf(__logf(a1), 0.f); }
                        *(u32x4*)((bf16_t*)(wsb + R_HA) + row * 256 + c) = pack8h(v0, v1);
                        *(u32x4*)((bf16_t*)(wsb + R_HK) + row * 256 + c) = pack8(k0, k1);
                    } else {
                        if (bj == 0) {
                            const f32x4 b0 = *(const f32x4*)(bgate + cw), b1 = *(const f32x4*)(bgate + cw + 4);
#pragma unroll
                            for (int j = 0; j < 4; ++j) {
                                const float z0 = v0[j] + b0[j], z1 = v1[j] + b1[j];
                                const float ls0 = fminf(z0, 0.f) - __logf(1.0f + __expf(-fabsf(z0))), ls1 = fminf(z1, 0.f) - __logf(1.0f + __expf(-fabsf(z1)));
                                v0[j] = ls0 * 0.0625f; v1[j] = ls1 * 0.0625f;
                            }
                            *(u32x4*)((bf16_t*)(wsb + R_GA) + row * 128 + cw) = pack8h(v0, v1);
                        } else if (wc < 2) {
                            *(u32x4*)((bf16_t*)(wsb + R_KROPE) + row * 64 + cw) = pack8(v0, v1);
                            float ks = (v0[0] * v0[0] + v0[1] * v0[1]) + (v0[2] * v0[2] + v0[3] * v0[3]) + (v1[0] * v1[0] + v1[1] * v1[1]) + (v1[2] * v1[2] + v1[3] * v1[3]);
                            ks += __shfl_xor(ks, 16); ks += __shfl_xor(ks, 32);
                            if (fq == 0) ((float*)(wsb + WS_LATP))[row * 16 + 8 + wc] = ks;
                        }
                    }
                }
                if constexpr (MODE == 4) { lss += __shfl_xor(lss, 16); lss += __shfl_xor(lss, 32); if (fq == 0) ((float*)(wsb + WS_LATP))[row * 16 + lslot + wc] = lss; }
            }
    }
    __device__ __forceinline__ void prefetch(const pg8::Unit& u, int wid, int lane) const { __builtin_amdgcn_s_barrier(); stat_dma((const float*)(wsb + WS_PART), st, u.pm, wid, lane); }
    __device__ __forceinline__ void operator()(const f32x4 (&acc)[2][2][4][2], const pg8::Unit& u, int wr, int wc, int fr, int fq) const {
        asm volatile("" : "+v"(fr), "+v"(fq));
        const int row0 = u.pm * 256 + wr * 64 + fr, cw = wc * 32 + 8 * fq, pn = u.pn;
        const PG8_LAS float* strow = st + (wr * 64 + fr) * 16 + 4 * fq;
        if (pn == 3) run<3>(acc, row0, cw, wc, nullptr, 1.f, 0, strow);
        else if (pn == 7) run<2>(acc, row0, cw, wc, nullptr, 1.f, 0, strow);
        else if (pn == 5 || pn == 6 || pn == 9) run<1>(acc, row0, cw, wc, (bf16_t*)(wsb + ((pn == 5) ? R_GR : ((pn == 9) ? R_HG : R_HQ))), (pn == 6) ? 0.125f : 1.0f, 0, strow);
        else if (pn < 2) run<4>(acc, row0, cw, wc, (bf16_t*)(wsb + ((pn == 0) ? R_QLAT : R_KVLAT)), 1.f, pn * 4, strow);
        else run<0>(acc, row0, cw, wc, (bf16_t*)(wsb + ((pn == 2) ? R_GQK : (pn == 4) ? R_GV : R_HI)), 1.f, 0, strow);
    }
};
template <bool PARTS>
struct EpiScaleBf16 {
    static constexpr bool PERM = true, AFTER_DRAIN = false;
    const float* rs; bf16_t* O; int ldc;
    PG8_LAS float* st;
    __device__ __forceinline__ void prefetch(const pg8::Unit& u, int wid, int lane) const { if constexpr (PARTS) { __builtin_amdgcn_s_barrier(); stat_dma(rs, st, u.pm, wid, lane); } }
    __device__ __forceinline__ void operator()(const f32x4 (&acc)[2][2][4][2], const pg8::Unit& u, int wr, int wc, int fr, int fq) const {
        asm volatile("" : "+v"(fr), "+v"(fq));
        const int row0 = u.pm * 256 + wr * 64 + fr, c0 = u.pn * 256 + wc * 32 + 8 * fq;
        const PG8_LAS float* strow = st + (wr * 64 + fr) * 16 + 4 * fq;
#pragma unroll
        for (int ai = 0; ai < 2; ++ai)
#pragma unroll
            for (int m = 0; m < 4; ++m) {
                const size_t row = (size_t)(row0 + ai * 128 + m * 16); const float s = PARTS ? rstd_from_lds(strow + (ai * 128 + m * 16) * 16) : rs[row];
#pragma unroll
                for (int bj = 0; bj < 2; ++bj) *(u32x4*)(O + row * ldc + c0 + bj * 128) = pack8(acc[ai][bj][m][0] * s, acc[ai][bj][m][1] * s);
            }
    }
};
struct EpiScaleF32 {
    static constexpr bool PERM = true, AFTER_DRAIN = false;
    const float* rs; float* O; int ldc;
    __device__ __forceinline__ void prefetch(const pg8::Unit&, int, int) const {}
    __device__ __forceinline__ void operator()(const f32x4 (&acc)[2][2][4][2], const pg8::Unit& u, int wr, int wc, int fr, int fq) const {
        asm volatile("" : "+v"(fr), "+v"(fq));
        const int row0 = u.pm * 256 + wr * 64 + fr, c0 = u.pn * 256 + wc * 32 + 8 * fq;
#pragma unroll
        for (int ai = 0; ai < 2; ++ai)
#pragma unroll
            for (int m = 0; m < 4; ++m) {
                const size_t row = (size_t)(row0 + ai * 128 + m * 16); const float s = rs[row];
#pragma unroll
                for (int bj = 0; bj < 2; ++bj) { float* p = O + row * ldc + c0 + bj * 128; *(f32x4*)p = acc[ai][bj][m][0] * s; *(f32x4*)(p + 4) = acc[ai][bj][m][1] * s; }
            }
    }
};
struct EpiResid {
    static constexpr bool PERM = true, AFTER_DRAIN = false;
    bf16_t* h16; bf16_t* h16o; float* out; float* parts; int last;
    __device__ __forceinline__ void prefetch(const pg8::Unit&, int, int) const {}
    __device__ __forceinline__ void operator()(const f32x4 (&acc)[2][2][4][2], const pg8::Unit& u, int wr, int wc, int fr, int fq) const {
        asm volatile("" : "+v"(fr), "+v"(fq));
        const int row0 = u.pm * 256 + wr * 64 + fr, c0 = u.pn * 256 + wc * 32 + 8 * fq;
#pragma unroll
        for (int ai = 0; ai < 2; ++ai) {
            u32x4 hw[4][2];
#pragma unroll
            for (int m = 0; m < 4; ++m)
#pragma unroll
                for (int bj = 0; bj < 2; ++bj) hw[m][bj] = *(const u32x4*)(h16 + (size_t)(row0 + ai * 128 + m * 16) * DM + c0 + bj * 128);
#pragma unroll
            for (int m = 0; m < 4; ++m) {
                const size_t row = (size_t)(row0 + ai * 128 + m * 16);
                float ss = 0.f;
#pragma unroll
                for (int bj = 0; bj < 2; ++bj) { const size_t o = row * DM + c0 + bj * 128;
                    const f32x2 a0 = unpk_f16(hw[m][bj].x), a1 = unpk_f16(hw[m][bj].y), a2 = unpk_f16(hw[m][bj].z), a3 = unpk_f16(hw[m][bj].w);
                    const f32x4 h0 = (f32x4){a0[0], a0[1], a1[0], a1[1]} + acc[ai][bj][m][0], h1 = (f32x4){a2[0], a2[1], a3[0], a3[1]} + acc[ai][bj][m][1];
                    if (last) { *(f32x4*)(out + o) = h0; *(f32x4*)(out + o + 4) = h1; }
                    else { *(u32x4*)(h16o + o) = pack8h(h0, h1);
                        ss += (h0[0] * h0[0] + h0[1] * h0[1]) + (h0[2] * h0[2] + h0[3] * h0[3]) + (h1[0] * h1[0] + h1[1] * h1[1]) + (h1[2] * h1[2] + h1[3] * h1[3]); } }
                if (!last) { ss += __shfl_xor(ss, 16); ss += __shfl_xor(ss, 32); if (fq == 0) parts[row * 16 + u.pn * 4 + wc] = ss; }
            }
        }
    }
};
struct EpiQUp {
    static constexpr bool PERM = true, AFTER_DRAIN = false;
    unsigned char* wsb; const float* qg; PG8_LAS float* sx; PG8_LAS float* st;
    __device__ __forceinline__ void prefetch(const pg8::Unit& u, int wid, int lane) const { __builtin_amdgcn_s_barrier(); stat_dma((const float*)(wsb + WS_LATP), st, u.pm, wid, lane); }
    __device__ __forceinline__ void operator()(const f32x4 (&acc)[2][2][4][2], const pg8::Unit& u, int wr, int wc, int fr, int fq) const {
        asm volatile("" : "+v"(fr), "+v"(fq));
        const int lrow0 = wr * 64 + fr, cw = wc * 32 + 8 * fq, h = u.pn, jb = 4 * (4 * wc + fq);
#pragma unroll
        for (int ai = 0; ai < 2; ++ai)
#pragma unroll
            for (int m = 0; m < 4; ++m) { const int lrow = lrow0 + ai * 128 + m * 16; const size_t row = (size_t)u.pm * 256 + lrow;
                const f32x4 lp = *(const PG8_LAS f32x4*)(st + lrow * 16);
                const float cl1 = __builtin_amdgcn_rsqf(((lp[0] + lp[1]) + (lp[2] + lp[3])) * (1.0f / 256.0f) + EPS);
                float ss = 0.f;
#pragma unroll
                for (int bj = 0; bj < 2; ++bj)
#pragma unroll
                    for (int n = 0; n < 2; ++n) { const f32x4 x = acc[ai][bj][m][n] * cl1; ss += (x[0] * x[0] + x[1] * x[1]) + (x[2] * x[2] + x[3] * x[3]); }
                ss += __shfl_xor(ss, 16); ss += __shfl_xor(ss, 32);
                if (fq == 0) sx[lrow * 4 + wc] = ss; }
        asm volatile("s_waitcnt lgkmcnt(0)" ::: "memory"); __builtin_amdgcn_s_barrier(); asm volatile("" ::: "memory");
        const f32x4 g0 = *(const f32x4*)(qg + cw), g1 = *(const f32x4*)(qg + cw + 4);
        f32x4 gr1 = {0.f, 0.f, 0.f, 0.f}, gr2 = {0.f, 0.f, 0.f, 0.f};
        if (wc < 2) { gr1 = *(const f32x4*)(qg + 128 + jb); gr2 = *(const f32x4*)(qg + 160 + jb); }
#pragma unroll
        for (int ai = 0; ai < 2; ++ai)
#pragma unroll
            for (int m = 0; m < 4; ++m) { const int lrow = lrow0 + ai * 128 + m * 16; const size_t row = (size_t)u.pm * 256 + lrow;
                const f32x4 t4 = *(const PG8_LAS f32x4*)(sx + lrow * 4);
                const f32x4 lp2 = *(const PG8_LAS f32x4*)(st + lrow * 16);
                const float cl2 = __builtin_amdgcn_rsqf(((lp2[0] + lp2[1]) + (lp2[2] + lp2[3])) * (1.0f / 256.0f) + EPS);
                const float sc = cl2 * __builtin_amdgcn_rsqf(((t4[0] + t4[1]) + (t4[2] + t4[3])) * (1.0f / 192.0f) + EPS);
                bf16_t* qrow = (bf16_t*)(wsb + R_Q) + (((size_t)(row >> 13) * 4 + h) * SEQ + (row & (SEQ - 1))) * 192;
                *(u32x4*)(qrow + cw) = pack8(acc[ai][0][m][0] * sc * g0, acc[ai][0][m][1] * sc * g1);
                if (wc < 2) {
                    const f32x4 x1 = acc[ai][1][m][0] * sc * gr1, x2 = acc[ai][1][m][1] * sc * gr2;
                    const f32x4 csa = *(const f32x4*)((const f32x2*)(wsb + WS_ROT) + row * 32 + jb), csb = *(const f32x4*)((const f32x2*)(wsb + WS_ROT) + row * 32 + jb + 2);
                    const float o10 = x1[0] * csa[0] - x2[0] * csa[1], o11 = x1[1] * csa[2] - x2[1] * csa[3], o12 = x1[2] * csb[0] - x2[2] * csb[1], o13 = x1[3] * csb[2] - x2[3] * csb[3];
                    const float o20 = x2[0] * csa[0] + x1[0] * csa[1], o21 = x2[1] * csa[2] + x1[1] * csa[3], o22 = x2[2] * csb[0] + x1[2] * csb[1], o23 = x2[3] * csb[2] + x1[3] * csb[3];
                    *(u32x2*)(qrow + 128 + jb) = (u32x2){cvt_pk_bf16(o10, o11), cvt_pk_bf16(o12, o13)};
                    *(u32x2*)(qrow + 160 + jb) = (u32x2){cvt_pk_bf16(o20, o21), cvt_pk_bf16(o22, o23)};
                } }
    }
};
struct EpiKVUp {
    static constexpr bool PERM = true, AFTER_DRAIN = false;
    unsigned char* wsb; const float* kg; PG8_LAS float* sx; PG8_LAS float* st;
    __device__ __forceinline__ void prefetch(const pg8::Unit& u, int wid, int lane) const { __builtin_amdgcn_s_barrier(); stat_dma((const float*)(wsb + WS_LATP), st, u.pm, wid, lane); }
    __device__ __forceinline__ void operator()(const f32x4 (&acc)[2][2][4][2], const pg8::Unit& u, int wr, int wc, int fr, int fq) const {
        asm volatile("" : "+v"(fr), "+v"(fq));
        const int lrow0 = wr * 64 + fr, cw = wc * 32 + 8 * fq, h = u.pn, j2 = 2 * (4 * wc + fq);
#pragma unroll
        for (int ai = 0; ai < 2; ++ai)
#pragma unroll
            for (int m = 0; m < 4; ++m) { const int lrow = lrow0 + ai * 128 + m * 16; const size_t row = (size_t)u.pm * 256 + lrow;
                const f32x4 lp = *(const PG8_LAS f32x4*)(st + lrow * 16 + 4);
                const float cl1 = __builtin_amdgcn_rsqf(((lp[0] + lp[1]) + (lp[2] + lp[3])) * (1.0f / 256.0f) + EPS);
                float ss = 0.f;
#pragma unroll
                for (int n = 0; n < 2; ++n) { const f32x4 x = acc[ai][0][m][n] * cl1; ss += (x[0] * x[0] + x[1] * x[1]) + (x[2] * x[2] + x[3] * x[3]); }
                ss += __shfl_xor(ss, 16); ss += __shfl_xor(ss, 32);
                if (fq == 0) sx[lrow * 4 + wc] = ss; }
        asm volatile("s_waitcnt lgkmcnt(0)" ::: "memory"); __builtin_amdgcn_s_barrier(); asm volatile("" ::: "memory");
        const f32x4 g0 = *(const f32x4*)(kg + cw), g1 = *(const f32x4*)(kg + cw + 4);
        const f32x2 gk1 = *(const f32x2*)(kg + 128 + j2), gk2 = *(const f32x2*)(kg + 160 + j2);
#pragma unroll
        for (int ai = 0; ai < 2; ++ai)
#pragma unroll
            for (int m = 0; m < 4; ++m) { const int lrow = lrow0 + ai * 128 + m * 16; const size_t row = (size_t)u.pm * 256 + lrow;
                const f32x4 t4 = *(const PG8_LAS f32x4*)(sx + lrow * 4);
                const f32x2 kr = *(const PG8_LAS f32x2*)(st + lrow * 16 + 8);
                const float rk = __builtin_amdgcn_rsqf((((t4[0] + t4[1]) + (t4[2] + t4[3])) + (kr[0] + kr[1])) * (1.0f / 192.0f) + EPS);
                const size_t bhs = ((size_t)(row >> 13) * 4 + h) * SEQ + (row & (SEQ - 1));
                const f32x4 lp2 = *(const PG8_LAS f32x4*)(st + lrow * 16 + 4);
                const float cl2 = __builtin_amdgcn_rsqf(((lp2[0] + lp2[1]) + (lp2[2] + lp2[3])) * (1.0f / 256.0f) + EPS);
                const float sc = cl2 * rk;
                *(u32x4*)((bf16_t*)(wsb + R_KN) + bhs * 128 + cw) = pack8(acc[ai][0][m][0] * sc * g0, acc[ai][0][m][1] * sc * g1);
                *(u32x4*)((bf16_t*)(wsb + R_V) + bhs * 128 + cw) = pack8(acc[ai][1][m][0] * cl2, acc[ai][1][m][1] * cl2);
                const unsigned x1w = *(const unsigned*)((const bf16_t*)(wsb + R_KROPE) + row * 64 + j2), x2w = *(const unsigned*)((const bf16_t*)(wsb + R_KROPE) + row * 64 + 32 + j2);
                const f32x4 cs = *(const f32x4*)((const f32x2*)(wsb + WS_ROT) + row * 32 + j2);
                const float a0 = bflo(x1w) * rk * gk1[0], a1 = bfhi(x1w) * rk * gk1[1], b0 = bflo(x2w) * rk * gk2[0], b1 = bfhi(x2w) * rk * gk2[1];
                *(unsigned*)((bf16_t*)(wsb + R_KRH) + bhs * 64 + j2) = cvt_pk_bf16(a0 * cs[0] - b0 * cs[1], a1 * cs[2] - b1 * cs[3]);
                *(unsigned*)((bf16_t*)(wsb + R_KRH) + bhs * 64 + 32 + j2) = cvt_pk_bf16(b0 * cs[0] + a0 * cs[1], b1 * cs[2] + a1 * cs[3]); }
    }
};

#define DPPU_(old, x, ctrl) ((unsigned)__builtin_amdgcn_update_dpp((int)(old), (int)(x), (ctrl), 0xf, 0xf, false))
__device__ __forceinline__ f16x2_t f2h2(float a, float b) { const f32x2 v = {a, b}; return __builtin_convertvector(v, f16x2_t); }
__device__ __forceinline__ f16x2_t silu_mul_h2(f16x2_t cv, f16x2_t up) {
    const f16x2_t nl = {(_Float16)-1.4426950408889634f, (_Float16)-1.4426950408889634f}, one = {(_Float16)1.0f, (_Float16)1.0f};
    const f16x2_t d = one + __builtin_elementwise_exp2(cv * nl);
    f16x2_t r; r.x = __builtin_amdgcn_rcph(d.x); r.y = __builtin_amdgcn_rcph(d.y);
    return cv * r * up;
}
#define TRANS_PK4(OP, r, x) asm(OP "_e32 %0, %4\n\t" OP "_e32 %1, %5\n\t" OP "_e32 %2, %6\n\t" OP "_e32 %3, %7\n\t" \
        OP "_sdwa %0, %4 dst_sel:WORD_1 dst_unused:UNUSED_PRESERVE src0_sel:WORD_1\n\t" OP "_sdwa %1, %5 dst_sel:WORD_1 dst_unused:UNUSED_PRESERVE src0_sel:WORD_1\n\t" \
        OP "_sdwa %2, %6 dst_sel:WORD_1 dst_unused:UNUSED_PRESERVE src0_sel:WORD_1\n\t" OP "_sdwa %3, %7 dst_sel:WORD_1 dst_unused:UNUSED_PRESERVE src0_sel:WORD_1\n\ts_nop 0" \
        : "=&v"(r[0]), "=&v"(r[1]), "=&v"(r[2]), "=&v"(r[3]) : "v"(x[0]), "v"(x[1]), "v"(x[2]), "v"(x[3]))
struct EpiGateUpConv {
    static constexpr bool PERM = true, AFTER_DRAIN = false;
    const float* parts; bf16_t* act; float* gh; float* uh;
    const float* cw_; const float* cb_;
    PG8_LAS float* hx;
    PG8_LAS float* st;
    __device__ __forceinline__ void prefetch(const pg8::Unit& u, int wid, int lane) const {
        stat_dma(parts, st, u.pm, wid, lane);
    }
    __device__ __forceinline__ void operator()(const f32x4 (&acc)[2][2][4][2], const pg8::Unit& u, int wr, int wc, int fr, int fq) const {
        asm volatile("" : "+v"(fr), "+v"(fq));
        const int row0 = u.pm * 256 + wr * 64 + fr, cw = wc * 32 + 8 * fq, c0 = u.pn * 128 + cw;
        f16x2_t w0p[4], w1p[4], w2p[4], bbp[4];
#pragma unroll
        for (int n = 0; n < 2; ++n) { const f32x4 a = *(const f32x4*)(cw_ + c0 + 4 * n), b = *(const f32x4*)(cw_ + D_FF + c0 + 4 * n), c = *(const f32x4*)(cw_ + 2 * D_FF + c0 + 4 * n), d = *(const f32x4*)(cb_ + c0 + 4 * n);
            w0p[2 * n] = f2h2(a[0], a[1]); w0p[2 * n + 1] = f2h2(a[2], a[3]); w1p[2 * n] = f2h2(b[0], b[1]); w1p[2 * n + 1] = f2h2(b[2], b[3]);
            w2p[2 * n] = f2h2(c[0], c[1]); w2p[2 * n + 1] = f2h2(c[2], c[3]); bbp[2 * n] = f2h2(d[0], d[1]); bbp[2 * n + 1] = f2h2(d[2], d[3]); }
        float rs[2][4];
#pragma unroll
        for (int ai = 0; ai < 2; ++ai)
#pragma unroll
            for (int m = 0; m < 4; ++m) { const f32x4 v = *(const PG8_LAS f32x4*)(st + (wr * 64 + fr + ai * 128 + m * 16) * 16 + 4 * fq);
                float sq = (v[0] + v[1]) + (v[2] + v[3]); sq += __shfl_xor(sq, 16); sq += __shfl_xor(sq, 32);
                rs[ai][m] = __builtin_amdgcn_rsqf(sq * (1.0f / DM) + EPS); }
        if (fr >= 14) {
#pragma unroll
            for (int ai = 0; ai < 2; ++ai)
#pragma unroll
                for (int n = 0; n < 2; ++n) { const f32x4 g = acc[ai][0][3][n] * rs[ai][3];
                    *(PG8_LAS f32x4*)(hx + ((ai * 2 + wr) * 2 + (fr - 14)) * 128 + cw + 4 * n) = g;
                    if (ai == 1 && wr == 1) *(f32x4*)(gh + ((size_t)u.pm * 4 + (fr - 14)) * D_FF + c0 + 4 * n) = g; }
        }
        if (wr == 0 && fr < 2) {
#pragma unroll
            for (int n = 0; n < 2; ++n) { *(f32x4*)(gh + ((size_t)u.pm * 4 + 2 + fr) * D_FF + c0 + 4 * n) = acc[0][0][0][n] * rs[0][0];
                                          *(f32x4*)(uh + ((size_t)u.pm * 2 + fr) * D_FF + c0 + 4 * n) = acc[0][1][0][n] * rs[0][0]; }
        }
        asm volatile("s_waitcnt lgkmcnt(0)" ::: "memory"); __builtin_amdgcn_s_barrier(); asm volatile("" ::: "memory");
#pragma unroll
        for (int ai = 0; ai < 2; ++ai) {
            const int pblk = ai * 2 + wr - 1;
            unsigned prv[4];
#pragma unroll
            for (int n = 0; n < 2; ++n) { const f32x4 pv4 = (pblk >= 0) ? *(const PG8_LAS f32x4*)(hx + (pblk * 2 + (fr & 1)) * 128 + cw + 4 * n) : (f32x4){0.f, 0.f, 0.f, 0.f};
                prv[2 * n] = __builtin_bit_cast(unsigned, f2h2(pv4[0], pv4[1])); prv[2 * n + 1] = __builtin_bit_cast(unsigned, f2h2(pv4[2], pv4[3])); }
#pragma unroll
            for (int m = 0; m < 4; ++m) {
                const size_t row = (size_t)(row0 + ai * 128 + m * 16);
                unsigned gg[4], upk[4], t1[4], t2[4], g1[4], g2[4], xe[4], ee[4], dd[4], rr[4], ow[4]; f16x2_t cv[4];
#pragma unroll
                for (int n = 0; n < 2; ++n) { const f32x4 g0 = acc[ai][0][m][n] * rs[ai][m], up = acc[ai][1][m][n] * rs[ai][m];
                    gg[2 * n] = __builtin_bit_cast(unsigned, f2h2(g0[0], g0[1])); gg[2 * n + 1] = __builtin_bit_cast(unsigned, f2h2(g0[2], g0[3]));
                    upk[2 * n] = __builtin_bit_cast(unsigned, f2h2(up[0], up[1])); upk[2 * n + 1] = __builtin_bit_cast(unsigned, f2h2(up[2], up[3])); }
                asm volatile("" : "+v"(gg[0]), "+v"(gg[1]), "+v"(gg[2]), "+v"(gg[3]), "+v"(prv[0]), "+v"(prv[1]), "+v"(prv[2]), "+v"(prv[3]));
                asm volatile("" : "=v"(t1[0]), "=v"(t1[1]), "=v"(t1[2]), "=v"(t1[3]), "=v"(t2[0]), "=v"(t2[1]), "=v"(t2[2]), "=v"(t2[3]));
#pragma unroll
                for (int q = 0; q < 4; ++q) t1[q] = DPPU_(t1[q], prv[q], 0x15F);
#pragma unroll
                for (int q = 0; q < 4; ++q) g1[q] = DPPU_(t1[q], gg[q], 0x111);
#pragma unroll
                for (int q = 0; q < 4; ++q) t2[q] = DPPU_(t2[q], prv[q], 0x15E);
#pragma unroll
                for (int q = 0; q < 4; ++q) g2[q] = DPPU_(t2[q], g1[q], 0x111);
                const f16x2_t nl = {(_Float16)-1.4426950408889634f, (_Float16)-1.4426950408889634f}, one = {(_Float16)1.0f, (_Float16)1.0f};
#pragma unroll
                for (int q = 0; q < 4; ++q) { cv[q] = bbp[q] + __builtin_bit_cast(f16x2_t, g2[q]) * w0p[q] + __builtin_bit_cast(f16x2_t, g1[q]) * w1p[q] + __builtin_bit_cast(f16x2_t, gg[q]) * w2p[q];
                    xe[q] = __builtin_bit_cast(unsigned, cv[q] * nl); }
                TRANS_PK4("v_exp_f16", ee, xe);
#pragma unroll
                for (int q = 0; q < 4; ++q) dd[q] = __builtin_bit_cast(unsigned, one + __builtin_bit_cast(f16x2_t, ee[q]));
                TRANS_PK4("v_rcp_f16", rr, dd);
#pragma unroll
                for (int q = 0; q < 4; ++q) { ow[q] = __builtin_bit_cast(unsigned, cv[q] * __builtin_bit_cast(f16x2_t, rr[q]) * __builtin_bit_cast(f16x2_t, upk[q])); prv[q] = gg[q]; }
                *(u32x4*)(act + row * D_FF + c0) = (u32x4){ow[0], ow[1], ow[2], ow[3]};
            }
        }
    }
};

namespace att {
constexpr int KVBLK = 64;
constexpr float THR = 8.f;
constexpr size_t SHM_V = 64 * 128 * 2, SHM_K = 64 * 128 * 2, SHM_KR = 64 * 64 * 2;
constexpr size_t OFF_V = 0, OFF_K = 2 * SHM_V, OFF_KR = OFF_K + 2 * SHM_K, OFF_WS = OFF_KR + 2 * SHM_KR, OFF_QR = OFF_WS + 8 * 64 * 4, SHM_ATTN = OFF_QR + 8 * 9216;
#define KSWZ(row, colB) ((row) * 256 + ((colB) ^ (((row) & 7) << 4)))
#define KRSWZ(row, colB) ((row) * 128 + ((colB) ^ ((((row) >> 1) & 7) << 4)))
#define SBAR() __builtin_amdgcn_sched_barrier(0)
__device__ __forceinline__ int crow(int r, int hi) { return (r & 3) + 8 * (r >> 2) + 4 * hi; }

__device__ __forceinline__ void partialSM(f32x16& p0, f32x16& p1, float& m_reg, float& mn, float& alpha, const float Cl, const bool masked) {
    float pmax = p0[0];
#pragma unroll
    for (int r = 1; r < 16; ++r) pmax = fmaxf(pmax, p0[r]);
#pragma unroll
    for (int r = 0; r < 16; ++r) pmax = fmaxf(pmax, p1[r]);
    { auto rr = __builtin_amdgcn_permlane32_swap(__float_as_uint(pmax), __float_as_uint(pmax), false, false);
      pmax = fmaxf(__uint_as_float(rr[0]), __uint_as_float(rr[1])); }
    pmax = masked ? -1e30f : pmax;
    if (__builtin_expect(__all((pmax - m_reg) * Cl <= THR * LOG2E), 1)) { mn = m_reg; alpha = 1.f; }
    else { mn = fmaxf(m_reg, pmax); alpha = __builtin_amdgcn_exp2f((m_reg - mn) * Cl); m_reg = mn; }
    const float mnC = -mn * Cl - (masked ? 1e30f : 0.f);
#pragma unroll
    for (int r = 0; r < 16; ++r) p0[r] = fmaf(p0[r], Cl, mnC);
#pragma unroll
    for (int r = 0; r < 16; ++r) p1[r] = fmaf(p1[r], Cl, mnC);
#pragma unroll
    for (int r = 0; r < 16; ++r) p0[r] = __builtin_amdgcn_exp2f(p0[r]);
}
__device__ __forceinline__ void finishSM(f32x16& p0, f32x16& p1, float alpha, float& l_reg, bf16x8& pa0, bf16x8& pa1, bf16x8& pa2, bf16x8& pa3) {
#pragma unroll
    for (int r = 0; r < 16; ++r) p1[r] = __builtin_amdgcn_exp2f(p1[r]);
    float ps = 0;
#pragma unroll
    for (int r = 0; r < 16; ++r) ps += p0[r];
#pragma unroll
    for (int r = 0; r < 16; ++r) ps += p1[r];
    { auto rr = __builtin_amdgcn_permlane32_swap(__float_as_uint(ps), __float_as_uint(ps), false, false);
      ps = __uint_as_float(rr[0]) + __uint_as_float(rr[1]); }
    l_reg = l_reg * alpha + ps;
#define PK4(P, BASE, OUT) do { unsigned a0 = cvt_pk_bf16(P[BASE + 0], P[BASE + 1]), a1 = cvt_pk_bf16(P[BASE + 2], P[BASE + 3]);   \
    unsigned b0 = cvt_pk_bf16(P[BASE + 4], P[BASE + 5]), b1 = cvt_pk_bf16(P[BASE + 6], P[BASE + 7]);                              \
    auto r0 = __builtin_amdgcn_permlane32_swap(a0, b0, false, false); auto r1 = __builtin_amdgcn_permlane32_swap(a1, b1, false, false); \
    u32x4 w = {r0[0], r1[0], r0[1], r1[1]}; OUT = *reinterpret_cast<bf16x8*>(&w); } while (0)
    PK4(p0, 0, pa0); PK4(p0, 8, pa1); PK4(p1, 0, pa2); PK4(p1, 8, pa3);
#undef PK4
}
template <int NQ, int NQREG>
__device__ __forceinline__ void qkt(f32x16& p0, f32x16& p1, const char* Ks, const char* Krs, const bf16x8* qr, const char* qrl, int r32, int hi) {
    p0 = f32x16{}; p1 = f32x16{};
#pragma unroll
    for (int d0 = 0; d0 < 8; ++d0) { const int cb = (d0 * 16 + hi * 8) * 2;
        bf16x8 b0 = *reinterpret_cast<const bf16x8*>(Ks + KSWZ(r32, cb));
        bf16x8 b1 = *reinterpret_cast<const bf16x8*>(Ks + KSWZ(32 + r32, cb));
        bf16x8 qf; if (d0 < NQREG) qf = qr[d0 < NQREG ? d0 : 0]; else qf = *reinterpret_cast<const bf16x8*>(qrl + (d0 - NQREG) * 1024);
        p0 = __builtin_amdgcn_mfma_f32_32x32x16_bf16(b0, qf, p0, 0, 0, 0);
        p1 = __builtin_amdgcn_mfma_f32_32x32x16_bf16(b1, qf, p1, 0, 0, 0); }
    if constexpr (NQ == 12) {
        SBAR();
#pragma unroll
        for (int d1 = 0; d1 < 4; ++d1) { const int cb = (d1 * 16 + hi * 8) * 2;
            bf16x8 b0 = *reinterpret_cast<const bf16x8*>(Krs + KRSWZ(r32, cb));
            bf16x8 b1 = *reinterpret_cast<const bf16x8*>(Krs + KRSWZ(32 + r32, cb));
            bf16x8 qf; if (8 + d1 < NQREG) qf = qr[8 + d1 < NQREG ? 8 + d1 : 0]; else qf = *reinterpret_cast<const bf16x8*>(qrl + (8 + d1 - NQREG) * 1024);
            p0 = __builtin_amdgcn_mfma_f32_32x32x16_bf16(b0, qf, p0, 0, 0, 0);
            p1 = __builtin_amdgcn_mfma_f32_32x32x16_bf16(b1, qf, p1, 0, 0, 0); }
    }
}
__device__ __forceinline__ int v_st(int k, int c) { const int kk = (k & ~0xC) | ((k & 4) << 1) | ((k & 8) >> 1); return ((kk >> 3) * 4 + (c >> 5)) * 512 + ((kk & 7) * 32 + (c & 31)) * 2; }
__device__ __forceinline__ int v_rd_base(int lane) { return ((lane & 3) << 3) | (((lane >> 2) & 3) << 6) | (((lane >> 4) & 1) << 5) | (((lane >> 5) & 1) << 8); }
constexpr int v_rd_off(int d0, int ks, int half) { return d0 * 512 + ks * 4096 + half * 2048; }
template <int OFF> __device__ __forceinline__ s16x4 tr_read(int vb) {
    s16x4 r; asm volatile("ds_read_b64_tr_b16 %0, %1 offset:%2" : "=&v"(r) : "v"(vb), "i"(OFF) : "memory"); return r;
}
template <int D0> __device__ __forceinline__ void pv_one(f32x16& od, int vb, bf16x8 pa0, bf16x8 pa1, bf16x8 pa2, bf16x8 pa3) {
    const s16x4 l0 = tr_read<v_rd_off(D0, 0, 0)>(vb), h0 = tr_read<v_rd_off(D0, 0, 1)>(vb), l1 = tr_read<v_rd_off(D0, 1, 0)>(vb), h1 = tr_read<v_rd_off(D0, 1, 1)>(vb);
    const s16x4 l2 = tr_read<v_rd_off(D0, 2, 0)>(vb), h2 = tr_read<v_rd_off(D0, 2, 1)>(vb), l3 = tr_read<v_rd_off(D0, 3, 0)>(vb), h3 = tr_read<v_rd_off(D0, 3, 1)>(vb);
    asm volatile("s_waitcnt lgkmcnt(0)" ::: "memory"); SBAR();
#define PK(L, H) (bf16x8){L[0], L[1], L[2], L[3], H[0], H[1], H[2], H[3]}
    od = __builtin_amdgcn_mfma_f32_32x32x16_bf16(pa0, PK(l0, h0), od, 0, 0, 0);
    od = __builtin_amdgcn_mfma_f32_32x32x16_bf16(pa1, PK(l1, h1), od, 0, 0, 0);
    od = __builtin_amdgcn_mfma_f32_32x32x16_bf16(pa2, PK(l2, h2), od, 0, 0, 0);
    od = __builtin_amdgcn_mfma_f32_32x32x16_bf16(pa3, PK(l3, h3), od, 0, 0, 0);
#undef PK
}
__device__ __forceinline__ void pv_d0(f32x16* o, int vb, bf16x8 pa0, bf16x8 pa1, bf16x8 pa2, bf16x8 pa3) {
    pv_one<0>(o[0], vb, pa0, pa1, pa2, pa3); pv_one<1>(o[1], vb, pa0, pa1, pa2, pa3); pv_one<2>(o[2], vb, pa0, pa1, pa2, pa3); pv_one<3>(o[3], vb, pa0, pa1, pa2, pa3);
}

template <int MODE, int SDEPTH>
__device__ __forceinline__ void attn_body(const bf16_t* Qb, const int ldq, const bf16_t* Kn, const bf16_t* Krp, const bf16_t* Vh,
                                          bf16_t* Ob, const int ldo, const int NT, const int last_tile, char* lds) {
    constexpr int NQ = (MODE == 0) ? 12 : 8;
    constexpr int NLD = (MODE == 0) ? 5 : 4;
    int tid = threadIdx.x; asm volatile("" : "+v"(tid));
    const int wid = tid >> 6, lane = tid & 63, r32 = lane & 31, hi = lane >> 5;
    char* V_lds = lds + OFF_V; char* K_lds = lds + OFF_K; char* Kr_lds = lds + OFF_KR;
    float* ws = (float*)(lds + OFF_WS) + wid * 64; float* li_l = ws; float* al_l = ws + 32;
    constexpr int NQREG = (MODE == 0) ? 8 : 8;
    float m_reg = -1e30f, l_reg = 0; f32x16 o[4] = {}; bf16x8 qr[NQREG];
    const bf16_t* Qw = Qb + (size_t)(wid * 32 + r32) * ldq + hi * 8;
#pragma unroll
    for (int d0 = 0; d0 < NQREG; ++d0) qr[d0] = *reinterpret_cast<const bf16x8*>(Qw + d0 * 16);
    char* qrl = lds + OFF_QR + wid * 9216 + lane * 16;
#pragma unroll
    for (int d1 = NQREG; d1 < NQ; ++d1) *reinterpret_cast<bf16x8*>(qrl + (d1 - NQREG) * 1024) = *reinterpret_cast<const bf16x8*>(Qw + d1 * 16);
    float Cl;
    if constexpr (MODE == 0) Cl = 0.07216878364870322f * LOG2E;
    else {
        float ss = 0.f;
#pragma unroll
        for (int d0 = 0; d0 < 8; ++d0)
#pragma unroll
            for (int j = 0; j < 8; ++j) { const float x = bf2f((unsigned short)qr[d0][j]); ss = fmaf(x, x, ss); }
        { auto rr = __builtin_amdgcn_permlane32_swap(__float_as_uint(ss), __float_as_uint(ss), false, false);
          ss = __uint_as_float(rr[0]) + __uint_as_float(rr[1]); }
        Cl = 0.08838834764831845f * LOG2E * __builtin_amdgcn_rsqf(ss * (1.0f / 128.0f) + EPS);
    }
    const int sr = tid >> 4, sc = (tid & 15) * 8, vst0 = v_st(sr, sc), vst1 = v_st(32 + sr, sc);
    const int krr = tid >> 3, krc = (tid & 7) * 8;
    const int vb0 = (int)(uintptr_t)V_lds + v_rd_base(lane);
    struct { bf16x8 vs0, vs1, ks0, ks1, kr; } sr_[SDEPTH];
#define SLOAD(i, k0) do { sr_[i].vs0 = *(const bf16x8*)(Vh + (size_t)((k0) + sr) * 128 + sc); sr_[i].vs1 = *(const bf16x8*)(Vh + (size_t)((k0) + 32 + sr) * 128 + sc); \
    sr_[i].ks0 = *(const bf16x8*)(Kn + (size_t)((k0) + sr) * 128 + sc); sr_[i].ks1 = *(const bf16x8*)(Kn + (size_t)((k0) + 32 + sr) * 128 + sc); \
    if constexpr (MODE == 0) sr_[i].kr = *(const bf16x8*)(Krp + (size_t)((k0) + krr) * 64 + krc); } while (0)
#define SWRITE(b, i) do { *(bf16x8*)(V_lds + (b) * SHM_V + vst0) = sr_[i].vs0;          \
    *(bf16x8*)(V_lds + (b) * SHM_V + vst1) = sr_[i].vs1; const int kc = sc * 2;               \
    *(bf16x8*)(K_lds + (b) * SHM_K + KSWZ(sr, kc)) = sr_[i].ks0;                       \
    *(bf16x8*)(K_lds + (b) * SHM_K + KSWZ(32 + sr, kc)) = sr_[i].ks1;                  \
    if constexpr (MODE == 0) *(bf16x8*)(Kr_lds + (b) * SHM_KR + KRSWZ(krr, krc * 2)) = sr_[i].kr; } while (0)
#define SWAIT() do { if constexpr (SDEPTH == 1) asm volatile("s_waitcnt vmcnt(0)" ::: "memory"); else if constexpr (NLD == 5) asm volatile("s_waitcnt vmcnt(5)" ::: "memory"); else asm volatile("s_waitcnt vmcnt(4)" ::: "memory"); } while (0)
#define RESC(a) do { if (__any((a) < 1.f)) { if (hi == 0) al_l[r32] = (a); asm volatile("s_waitcnt lgkmcnt(0)" ::: "memory"); \
    _Pragma("unroll") for (int d = 0; d < 4; ++d) _Pragma("unroll") for (int r = 0; r < 16; ++r) o[d][r] *= al_l[crow(r, hi)]; } } while (0)
    f32x16 pA0, pA1, pB0, pB1; float mnA, mnB, alA, alB; bf16x8 pa0, pa1, pa2, pa3;
    constexpr int SE = 0, SO = SDEPTH - 1;
    SLOAD(SE, 0); asm volatile("s_waitcnt vmcnt(0)" ::: "memory"); SWRITE(0, SE); __syncthreads();
    qkt<NQ, NQREG>(pA0, pA1, K_lds, Kr_lds, qr, qrl, r32, hi); partialSM(pA0, pA1, m_reg, mnA, alA, Cl, false);
    SLOAD(SO, KVBLK); if constexpr (SDEPTH == 2) { if (2 < NT) SLOAD(SE, 2 * KVBLK); }
    SWAIT(); SWRITE(1, SO); __syncthreads();
    for (int j = 1; j + 1 < NT; j += 2) {
        SBAR(); qkt<NQ, NQREG>(pB0, pB1, K_lds + SHM_K, Kr_lds + SHM_KR, qr, qrl, r32, hi);
        finishSM(pA0, pA1, alA, l_reg, pa0, pa1, pa2, pa3); SBAR();
        SLOAD(SO, (j + SDEPTH) * KVBLK); SBAR();
        pv_d0(o, vb0, pa0, pa1, pa2, pa3); partialSM(pB0, pB1, m_reg, mnB, alB, Cl, j > last_tile);
        __syncthreads(); SWAIT(); SWRITE(0, SE);
        RESC(alB); __syncthreads();
        SBAR(); qkt<NQ, NQREG>(pA0, pA1, K_lds, Kr_lds, qr, qrl, r32, hi);
        finishSM(pB0, pB1, alB, l_reg, pa0, pa1, pa2, pa3); SBAR();
        if (SDEPTH == 1 || j + 3 < NT) SLOAD(SE, (j + 1 + SDEPTH) * KVBLK); SBAR();
        pv_d0(o, vb0 + (int)SHM_V, pa0, pa1, pa2, pa3); partialSM(pA0, pA1, m_reg, mnA, alA, Cl, (j + 1) > last_tile);
        __syncthreads(); SWAIT(); SWRITE(1, SO);
        RESC(alA); __syncthreads();
    }
    SBAR(); qkt<NQ, NQREG>(pB0, pB1, K_lds + SHM_K, Kr_lds + SHM_KR, qr, qrl, r32, hi);
    finishSM(pA0, pA1, alA, l_reg, pa0, pa1, pa2, pa3); SBAR();
    pv_d0(o, vb0, pa0, pa1, pa2, pa3); partialSM(pB0, pB1, m_reg, mnB, alB, Cl, (NT - 1) > last_tile);
    __syncthreads(); RESC(alB);
    finishSM(pB0, pB1, alB, l_reg, pa0, pa1, pa2, pa3); SBAR();
    pv_d0(o, vb0 + (int)SHM_V, pa0, pa1, pa2, pa3);
    if (hi == 0) li_l[r32] = l_reg; asm volatile("s_waitcnt lgkmcnt(0)" ::: "memory");
    float rli[16];
#pragma unroll
    for (int r = 0; r < 16; ++r) rli[r] = __builtin_amdgcn_rcpf(li_l[crow(r, hi)]);
    bf16_t* Ow = Ob + (size_t)(wid * 32) * ldo;
#pragma unroll
    for (int r = 0; r < 16; ++r) { const int orow = crow(r, hi);
#pragma unroll
        for (int d0 = 0; d0 < 4; ++d0) Ow[(size_t)orow * ldo + d0 * 32 + r32] = f2bf(o[d0][r] * rli[r]); }
#undef SLOAD
#undef SWRITE
#undef SWAIT
#undef RESC
}

__device__ __forceinline__ void qkt12(f32x16& p0, f32x16& p1, const char* Ks, const char* Krs, const bf16x8* qr, int r32, int hi) {
    p0 = f32x16{}; p1 = f32x16{};
    const int x7 = (r32 & 7) << 4, xr = ((r32 >> 1) & 7) << 4;
    const int kb = (int)(uintptr_t)Ks + r32 * 256, krb = (int)(uintptr_t)Krs + r32 * 128;
    bf16x8 f0[2], f1[2];
#define QK_RD(slot, d) do { if ((d) < 8) { const int ad_ = kb + ((((d) * 32) + hi * 16) ^ x7); \
            asm volatile("ds_read_b128 %0, %1" : "=&v"(f0[slot]) : "v"(ad_) : "memory"); asm volatile("ds_read_b128 %0, %1 offset:8192" : "=&v"(f1[slot]) : "v"(ad_) : "memory"); } \
        else { const int ad_ = krb + (((((d) - 8) * 32) + hi * 16) ^ xr); \
            asm volatile("ds_read_b128 %0, %1" : "=&v"(f0[slot]) : "v"(ad_) : "memory"); asm volatile("ds_read_b128 %0, %1 offset:4096" : "=&v"(f1[slot]) : "v"(ad_) : "memory"); } } while (0)
    QK_RD(0, 0);
#pragma unroll
    for (int d = 0; d < 12; ++d) { const int sl = d & 1;
        if (d + 1 < 12) { QK_RD(sl ^ 1, d + 1); asm volatile("s_waitcnt lgkmcnt(2)" : "+v"(f0[sl]), "+v"(f1[sl]) :: "memory"); }
        else asm volatile("s_waitcnt lgkmcnt(0)" : "+v"(f0[sl]), "+v"(f1[sl]) :: "memory");
        p0 = __builtin_amdgcn_mfma_f32_32x32x16_bf16(f0[sl], qr[d], p0, 0, 0, 0);
        p1 = __builtin_amdgcn_mfma_f32_32x32x16_bf16(f1[sl], qr[d], p1, 0, 0, 0);
    }
#undef QK_RD
}

constexpr size_t D_OFF_V = 0, D_OFF_K = 3 * SHM_V, D_OFF_KR = D_OFF_K + 3 * SHM_K, D_OFF_WS = D_OFF_KR + 3 * SHM_KR, SHM_ATTN_DMA = D_OFF_WS + 8 * 64 * 4;
__device__ __forceinline__ void attn_body_dma(const bf16_t* Qb, const int ldq, const bf16_t* Kn, const bf16_t* Krp, const bf16_t* Vh,
                                              bf16_t* Ob, const int ldo, const int NT, const int last_tile, char* lds, LAS unsigned char* ldsl) {
    int tid = threadIdx.x; asm volatile("" : "+v"(tid));
    const int wid = __builtin_amdgcn_readfirstlane(tid >> 6), lane = tid & 63, r32 = lane & 31, hi = lane >> 5;
    char* K_lds = lds + D_OFF_K; char* Kr_lds = lds + D_OFF_KR;
    float* ws = (float*)(lds + D_OFF_WS) + wid * 64; float* li_l = ws; float* al_l = ws + 32;
    float m_reg = -1e30f, l_reg = 0; f32x16 o[4] = {}; bf16x8 qr[12];
    const bf16_t* Qw = Qb + (size_t)(wid * 32 + r32) * ldq + hi * 8;
#pragma unroll
    for (int d0 = 0; d0 < 12; ++d0) qr[d0] = *reinterpret_cast<const bf16x8*>(Qw + d0 * 16);
    const float Cl = 0.07216878364870322f * LOG2E;
    unsigned ko[2], vo[2], kro;
#pragma unroll
    for (int i = 0; i < 2; ++i) { const int sb = (i * 8 + wid) * 1024 + lane * 16;
        { const int row = sb >> 8, cb = (sb & 255) ^ ((row & 7) << 4); ko[i] = (unsigned)(row * 128 + (cb >> 1)); }
        { const int sub = sb >> 9, wi = sb & 511, kk = (sub >> 2) * 8 + (wi >> 6), c = (sub & 3) * 32 + ((wi & 63) >> 1), k = (kk & ~0xC) | ((kk & 4) << 1) | ((kk & 8) >> 1);
          vo[i] = (unsigned)(k * 128 + c); } }
    { const int sb = wid * 1024 + lane * 16; const int row = sb >> 7, cb = (sb & 127) ^ (((row >> 1) & 7) << 4); kro = (unsigned)(row * 64 + (cb >> 1)); }
    const int vbb = (int)(uintptr_t)(lds + D_OFF_V) + v_rd_base(lane);
#define ADMA(st, k0) do { _Pragma("unroll") for (int i_ = 0; i_ < 2; ++i_) { \
        __builtin_amdgcn_global_load_lds((const unsigned*)(Kn + (size_t)(k0) * 128 + ko[i_]), (LAS unsigned*)(ldsl + D_OFF_K + (st) * SHM_K + (i_ * 8 + wid) * 1024), 16, 0, 0); \
        __builtin_amdgcn_global_load_lds((const unsigned*)(Vh + (size_t)(k0) * 128 + vo[i_]), (LAS unsigned*)(ldsl + D_OFF_V + (st) * SHM_V + (i_ * 8 + wid) * 1024), 16, 0, 0); } \
        __builtin_amdgcn_global_load_lds((const unsigned*)(Krp + (size_t)(k0) * 64 + kro), (LAS unsigned*)(ldsl + D_OFF_KR + (st) * SHM_KR + wid * 1024), 16, 0, 0); } while (0)
#define AWAIT() asm volatile("s_waitcnt vmcnt(0)" ::: "memory")
#define RESC(a) do { if (__any((a) < 1.f)) { if (hi == 0) al_l[r32] = (a); asm volatile("s_waitcnt lgkmcnt(0)" ::: "memory"); \
    _Pragma("unroll") for (int d = 0; d < 4; ++d) _Pragma("unroll") for (int r = 0; r < 16; ++r) o[d][r] *= al_l[crow(r, hi)]; } } while (0)
    f32x16 pA0, pA1, pB0, pB1; float mnA, mnB, alA, alB; bf16x8 pa0, pa1, pa2, pa3;
    __syncthreads();
    ADMA(0, 0); ADMA(1, KVBLK);
    AWAIT(); __syncthreads();
    qkt12(pA0, pA1, K_lds, Kr_lds, qr, r32, hi); partialSM(pA0, pA1, m_reg, mnA, alA, Cl, false);
    int sa = 0, sb_ = 1, sc = 2;
#pragma unroll 1
    for (int j = 1; j + 1 < NT; j += 2) {
        ADMA(sc, (j + 1) * KVBLK);
        SBAR(); qkt12(pB0, pB1, K_lds + sb_ * SHM_K, Kr_lds + sb_ * SHM_KR, qr, r32, hi);
        finishSM(pA0, pA1, alA, l_reg, pa0, pa1, pa2, pa3); SBAR();
        pv_d0(o, vbb + sa * (int)SHM_V, pa0, pa1, pa2, pa3); partialSM(pB0, pB1, m_reg, mnB, alB, Cl, j > last_tile);
        RESC(alB); AWAIT(); __syncthreads();
        if (j + 2 < NT) ADMA(sa, (j + 2) * KVBLK);
        SBAR(); qkt12(pA0, pA1, K_lds + sc * SHM_K, Kr_lds + sc * SHM_KR, qr, r32, hi);
        finishSM(pB0, pB1, alB, l_reg, pa0, pa1, pa2, pa3); SBAR();
        pv_d0(o, vbb + sb_ * (int)SHM_V, pa0, pa1, pa2, pa3); partialSM(pA0, pA1, m_reg, mnA, alA, Cl, (j + 1) > last_tile);
        RESC(alA); AWAIT(); __syncthreads();
        const int t_ = sa; sa = sc; sc = sb_; sb_ = t_;
    }
    SBAR(); qkt12(pB0, pB1, K_lds + sb_ * SHM_K, Kr_lds + sb_ * SHM_KR, qr, r32, hi);
    finishSM(pA0, pA1, alA, l_reg, pa0, pa1, pa2, pa3); SBAR();
    pv_d0(o, vbb + sa * (int)SHM_V, pa0, pa1, pa2, pa3); partialSM(pB0, pB1, m_reg, mnB, alB, Cl, (NT - 1) > last_tile);
    RESC(alB);
    finishSM(pB0, pB1, alB, l_reg, pa0, pa1, pa2, pa3); SBAR();
    pv_d0(o, vbb + sb_ * (int)SHM_V, pa0, pa1, pa2, pa3);
    if (hi == 0) li_l[r32] = l_reg; asm volatile("s_waitcnt lgkmcnt(0)" ::: "memory");
    float rli[16];
#pragma unroll
    for (int r = 0; r < 16; ++r) rli[r] = __builtin_amdgcn_rcpf(li_l[crow(r, hi)]);
    bf16_t* Ow = Ob + (size_t)(wid * 32) * ldo;
#pragma unroll
    for (int r = 0; r < 16; ++r) { const int orow = crow(r, hi);
#pragma unroll
        for (int d0 = 0; d0 < 4; ++d0) Ow[(size_t)orow * ldo + d0 * 32 + r32] = f2bf(o[d0][r] * rli[r]); }
#undef ADMA
#undef AWAIT
#undef RESC
}
}

static_assert(att::SHM_ATTN <= LDS_MISC && att::SHM_ATTN_DMA <= LDS_MISC, "attention LDS");

struct Params {
    const float* in[29];
    float* out; unsigned char* ws;
    int ph_lo, ph_hi;
};

__device__ const double INVF[32] = {1.0, 0.7498942093324559, 0.5623413251903491, 0.4216965034285822, 0.31622776601683794, 0.23713737056616552, 0.1778279410038923, 0.1333521432163324, 0.1, 0.07498942093324558, 0.05623413251903491, 0.042169650342858224, 0.03162277660168379, 0.023713737056616554, 0.01778279410038923, 0.01333521432163324, 0.01, 0.007498942093324558, 0.005623413251903491, 0.004216965034285823, 0.0031622776601683794, 0.0023713737056616554, 0.0017782794100389228, 0.001333521432163324, 0.001, 0.0007498942093324559, 0.0005623413251903491, 0.00042169650342858224, 0.00031622776601683794, 0.00023713737056616554, 0.00017782794100389227, 0.0001333521432163324};

template <bool F16, class F>
__device__ __forceinline__ void build_bt(bf16_t* Bt0, const int N, const int K, const float* W0, const size_t wstride, const int ldw, const float* gain0, const int gstride, F srcmap,
                                         size_t& g, size_t& base, const size_t ngt) {
    const size_t per = (size_t)(N / 4) * (K / 8), total = per * DEPTH;
    for (; g < base + total; g += ngt) {
        const size_t b = g - base; const int l = (int)(b / per), r = (int)(b % per);
        const int n0 = (r % (N / 4)) * 4, k0 = (r / (N / 4)) * 8;
        float sc; const int src = srcmap(n0, sc);
        if (src == -2) continue;
        const float* W = W0 + (size_t)l * wstride;
        f32x4 v[8];
#pragma unroll
        for (int j = 0; j < 8; ++j) v[j] = (src >= 0) ? *(const f32x4*)(W + (size_t)(k0 + j) * ldw + src) : (f32x4){0.f, 0.f, 0.f, 0.f};
        if (gain0) {
#pragma unroll
            for (int j = 0; j < 8; ++j) v[j] *= gain0[(size_t)l * gstride + k0 + j] * sc;
        } else {
#pragma unroll
            for (int j = 0; j < 8; ++j) v[j] *= sc;
        }
        bf16_t* Bt = Bt0 + (size_t)l * W_LAYER + (size_t)n0 * K + k0;
#pragma unroll
        for (int e = 0; e < 4; ++e) {
            u32x4 w;
            if constexpr (F16) { w.x = cvt_pk_f16(v[0][e], v[1][e]); w.y = cvt_pk_f16(v[2][e], v[3][e]); w.z = cvt_pk_f16(v[4][e], v[5][e]); w.w = cvt_pk_f16(v[6][e], v[7][e]); }
            else { w.x = cvt_pk_bf16(v[0][e], v[1][e]); w.y = cvt_pk_bf16(v[2][e], v[3][e]); w.z = cvt_pk_bf16(v[4][e], v[5][e]); w.w = cvt_pk_bf16(v[6][e], v[7][e]); }
            *(u32x4*)(Bt + (size_t)e * K) = w;
        }
    }
    base += total;
}

__device__ __forceinline__ void sincos_d(double a, float& c, float& s) {
    const double k = __builtin_rint(a * 0.6366197723675814);
    double r = __builtin_fma(-k, 1.5707963267948966, a); r = __builtin_fma(-k, 6.123233995736766e-17, r);
    const double r2 = r * r;
    double sp = -7.647163731819816e-13; sp = sp * r2 + 1.6059043836821613e-10; sp = sp * r2 - 2.505210838544172e-08; sp = sp * r2 + 2.7557319223985893e-06;
    sp = sp * r2 - 1.984126984126984e-04; sp = sp * r2 + 8.333333333333333e-03; sp = sp * r2 - 1.6666666666666666e-01; sp = r + r * r2 * sp;
    double cp = 4.779477332387385e-14; cp = cp * r2 - 1.1470745597729725e-11; cp = cp * r2 + 2.08767569878681e-09; cp = cp * r2 - 2.755731922398589e-07;
    cp = cp * r2 + 2.48015873015873e-05; cp = cp * r2 - 1.388888888888889e-03; cp = cp * r2 + 4.1666666666666664e-02; cp = cp * r2 - 0.5; cp = 1.0 + r2 * cp;
    const int q = ((int)k) & 3;
    const double sv = (q == 0) ? sp : (q == 1) ? cp : (q == 2) ? -sp : -cp;
    const double cv = (q == 0) ? cp : (q == 1) ? -sp : (q == 2) ? -cp : sp;
    s = (float)sv; c = (float)cv;
}

constexpr int SEGL = 256, NSEG = SEQ / SEGL;

namespace scan {
typedef short bf16x4 __attribute__((ext_vector_type(4)));
constexpr int QT = 0, KT = 2048, KH = 4096, VT = 6144, DC = 8192, WREG = 8448;
template <int OFF> __device__ __forceinline__ bf16x4 trd(int addr) { bf16x4 r; asm volatile("ds_read_b64_tr_b16 %0, %1 offset:%2" : "=&v"(r) : "v"(addr), "i"(OFF) : "memory"); return r; }
__device__ __forceinline__ u32x4 pk8(const float* x) { u32x4 w; w.x = cvt_pk_bf16(x[0], x[1]); w.y = cvt_pk_bf16(x[2], x[3]); w.z = cvt_pk_bf16(x[4], x[5]); w.w = cvt_pk_bf16(x[6], x[7]); return w; }

template <int DK, bool OUT>
__device__ __forceinline__ void seg(const _Float16* la_base, const int la_stride, const bf16_t* q_base, const bf16_t* k_base, const bf16_t* v_base, const bf16_t* g_base,
                                    float* Sio, float* Pout, const float* gain, bf16_t* y_base, char* wl, const int lane_in) {
    constexpr int NM = DK / 16, NS = DK / 32;
    int lane = lane_in; asm volatile("" : "+v"(lane));
    const int l16 = lane & 15, g4 = lane >> 4, ch = lane & (DK - 1);
    const int wla = (int)(uintptr_t)wl;
    float* sbase = Sio + (4 * g4) * 64 + l16;
    f32x4 S[NM][4];
#pragma unroll
    for (int m = 0; m < NM; ++m)
#pragma unroll
        for (int n = 0; n < 4; ++n) {
            if constexpr (OUT) {
#pragma unroll
                for (int r = 0; r < 4; ++r) S[m][n][r] = sbase[(16 * m + r) * 64 + 16 * n];
            } else S[m][n] = (f32x4){0.f, 0.f, 0.f, 0.f};
        }
    float gn[4] = {1.f, 1.f, 1.f, 1.f};
    if constexpr (OUT) {
#pragma unroll
        for (int n = 0; n < 4; ++n) gn[n] = gain[16 * n + l16];
        asm volatile("s_waitcnt vmcnt(0)" ::: "memory");
    }
    float btot = 0.f;
    constexpr bool HALF = (DK == 32); constexpr int TT = HALF ? 8 : 16;
    const int hf = HALF ? (lane >> 5) : 0, tb = hf * 8;
    float la_n[TT]; unsigned short q_n[TT], k_n[TT], v_n[16];
#pragma unroll
    for (int t = 0; t < 16; ++t) v_n[t] = v_base[(size_t)t * 256 + lane];
#pragma unroll
    for (int t = 0; t < TT; ++t) { la_n[t] = (float)la_base[(size_t)(tb + t) * la_stride + ch]; k_n[t] = k_base[(size_t)(tb + t) * 256 + ch];
        if constexpr (OUT) q_n[t] = q_base[(size_t)(tb + t) * 256 + ch]; }
#pragma unroll 1
    for (int c = 0; c < SEGL / 16; ++c) {
        unsigned short gt16[4][4];
        if constexpr (OUT) {
#pragma unroll
            for (int r = 0; r < 4; ++r)
#pragma unroll
                for (int n = 0; n < 4; ++n) gt16[r][n] = g_base[((size_t)c * 16 + 4 * g4 + r) * 256 + 16 * n + l16];
        }
        unsigned qw[TT / 2], ktw[TT / 2], khw[TT / 2]; float bL;
        float pre = 0.f, post = 0.f, tot2 = 0.f;
        if constexpr (HALF) { float tot = 0.f;
#pragma unroll
            for (int t = 0; t < TT; ++t) tot += la_n[t];
            auto rr = __builtin_amdgcn_permlane32_swap(__float_as_uint(tot), __float_as_uint(tot), false, false);
            tot2 = __uint_as_float(rr[0]) + __uint_as_float(rr[1]);
            const float oth = tot2 - tot; pre = hf ? oth : 0.f; post = hf ? 0.f : oth; }
        if constexpr (OUT) { float b = pre;
#pragma unroll
            for (int tp = 0; tp < TT / 2; ++tp) {
                b += la_n[2 * tp]; const float e0 = b; b += la_n[2 * tp + 1]; const float e1 = b;
                qw[tp] = cvt_pk_bf16(bf2f(q_n[2 * tp]) * __expf(e0), bf2f(q_n[2 * tp + 1]) * __expf(e1));
                ktw[tp] = cvt_pk_bf16(bf2f(k_n[2 * tp]) * __expf(fminf(-e0, 80.f)), bf2f(k_n[2 * tp + 1]) * __expf(fminf(-e1, 80.f)));
            } }
        { float cs = post;
#pragma unroll
            for (int tp = TT / 2 - 1; tp >= 0; --tp) {
                const float h1 = bf2f(k_n[2 * tp + 1]) * __expf(cs); cs += la_n[2 * tp + 1];
                const float h0 = bf2f(k_n[2 * tp]) * __expf(cs); cs += la_n[2 * tp];
                khw[tp] = cvt_pk_bf16(h0, h1);
            }
            bL = HALF ? tot2 : cs; }
        btot += bL;
        u32x4 vv0, vv1;
        vv0.x = (unsigned)v_n[0] | ((unsigned)v_n[1] << 16); vv0.y = (unsigned)v_n[2] | ((unsigned)v_n[3] << 16); vv0.z = (unsigned)v_n[4] | ((unsigned)v_n[5] << 16); vv0.w = (unsigned)v_n[6] | ((unsigned)v_n[7] << 16);
        vv1.x = (unsigned)v_n[8] | ((unsigned)v_n[9] << 16); vv1.y = (unsigned)v_n[10] | ((unsigned)v_n[11] << 16); vv1.z = (unsigned)v_n[12] | ((unsigned)v_n[13] << 16); vv1.w = (unsigned)v_n[14] | ((unsigned)v_n[15] << 16);
        if (c + 1 < SEGL / 16) {
#pragma unroll
            for (int t = 0; t < 16; ++t) v_n[t] = v_base[((size_t)(c + 1) * 16 + t) * 256 + lane];
#pragma unroll
            for (int t = 0; t < TT; ++t) { const size_t tt = (size_t)(c + 1) * 16 + tb + t;
                la_n[t] = (float)la_base[tt * la_stride + ch]; k_n[t] = k_base[tt * 256 + ch];
                if constexpr (OUT) q_n[t] = q_base[tt * 256 + ch]; }
        }
        if constexpr (HALF) {
            *(u32x4*)(wl + KH + ch * 32 + hf * 16) = (u32x4){khw[0], khw[1], khw[2], khw[3]};
            if constexpr (OUT) { *(u32x4*)(wl + KT + ch * 32 + hf * 16) = (u32x4){ktw[0], ktw[1], ktw[2], ktw[3]}; *(u32x4*)(wl + QT + ch * 32 + hf * 16) = (u32x4){qw[0], qw[1], qw[2], qw[3]}; }
            if (lane < DK) *(float*)(wl + DC + ch * 4) = __expf(bL);
        } else if (lane < DK) {
            *(u32x4*)(wl + KH + ch * 32) = (u32x4){khw[0], khw[1], khw[2], khw[3]}; *(u32x4*)(wl + KH + ch * 32 + 16) = (u32x4){khw[4 % (TT / 2)], khw[5 % (TT / 2)], khw[6 % (TT / 2)], khw[7 % (TT / 2)]};
            if constexpr (OUT) { *(u32x4*)(wl + KT + ch * 32) = (u32x4){ktw[0], ktw[1], ktw[2], ktw[3]}; *(u32x4*)(wl + KT + ch * 32 + 16) = (u32x4){ktw[4 % (TT / 2)], ktw[5 % (TT / 2)], ktw[6 % (TT / 2)], ktw[7 % (TT / 2)]};
                                 *(u32x4*)(wl + QT + ch * 32) = (u32x4){qw[0], qw[1], qw[2], qw[3]}; *(u32x4*)(wl + QT + ch * 32 + 16) = (u32x4){qw[4 % (TT / 2)], qw[5 % (TT / 2)], qw[6 % (TT / 2)], qw[7 % (TT / 2)]}; }
            *(float*)(wl + DC + ch * 4) = __expf(bL);
        }
        *(u32x4*)(wl + VT + lane * 32) = vv0; *(u32x4*)(wl + VT + lane * 32 + 16) = vv1;
        asm volatile("s_waitcnt lgkmcnt(0)" ::: "memory");
        bf16x4 vf[4];
#pragma unroll
        for (int n = 0; n < 4; ++n) vf[n] = *(const bf16x4*)(wl + VT + (16 * n + l16) * 32 + g4 * 8);
        f32x4 O[4];
        if constexpr (OUT) {
            bf16x8 qf[NS], kf8[NS];
#pragma unroll
            for (int s2 = 0; s2 < NS; ++s2) {
                const int a0 = wla + (32 * s2 + 4 * g4) * 32 + l16 * 8;
                bf16x4 q0 = trd<QT>(a0), q1 = trd<QT + 512>(a0), k0 = trd<KT>(a0), k1 = trd<KT + 512>(a0);
                asm volatile("s_waitcnt lgkmcnt(0)" : "+v"(q0), "+v"(q1), "+v"(k0), "+v"(k1) :: "memory");
                qf[s2] = (bf16x8){q0[0], q0[1], q0[2], q0[3], q1[0], q1[1], q1[2], q1[3]};
                kf8[s2] = (bf16x8){k0[0], k0[1], k0[2], k0[3], k1[0], k1[1], k1[2], k1[3]};
            }
            __builtin_amdgcn_sched_barrier(0);
#pragma unroll
            for (int n = 0; n < 4; ++n) { O[n] = (f32x4){0.f, 0.f, 0.f, 0.f};
#pragma unroll
                for (int s2 = 0; s2 < NS; ++s2) {
                    u32x4 w; w.x = cvt_pk_bf16(S[2 * s2][n][0], S[2 * s2][n][1]); w.y = cvt_pk_bf16(S[2 * s2][n][2], S[2 * s2][n][3]);
                    w.z = cvt_pk_bf16(S[2 * s2 + 1][n][0], S[2 * s2 + 1][n][1]); w.w = cvt_pk_bf16(S[2 * s2 + 1][n][2], S[2 * s2 + 1][n][3]);
                    O[n] = __builtin_amdgcn_mfma_f32_16x16x32_bf16(qf[s2], *reinterpret_cast<bf16x8*>(&w), O[n], 0, 0, 0); } }
            f32x4 P = (f32x4){0.f, 0.f, 0.f, 0.f};
#pragma unroll
            for (int s2 = 0; s2 < NS; ++s2) P = __builtin_amdgcn_mfma_f32_16x16x32_bf16(kf8[s2], qf[s2], P, 0, 0, 0);
#pragma unroll
            for (int r = 0; r < 4; ++r) P[r] = (4 * g4 + r <= l16) ? P[r] : 0.f;
            u32x2 pw; pw.x = cvt_pk_bf16(P[0], P[1]); pw.y = cvt_pk_bf16(P[2], P[3]);
            const bf16x4 pf = *reinterpret_cast<bf16x4*>(&pw);
#pragma unroll
            for (int n = 0; n < 4; ++n) O[n] = __builtin_amdgcn_mfma_f32_16x16x16bf16_1k(pf, vf[n], O[n], 0, 0, 0);
        }
#pragma unroll
        for (int m = 0; m < NM; ++m) {
            const f32x4 dc = *(const f32x4*)(wl + DC + (16 * m + 4 * g4) * 4);
            const bf16x4 khf = *(const bf16x4*)(wl + KH + (16 * m + l16) * 32 + g4 * 8);
#pragma unroll
            for (int n = 0; n < 4; ++n) S[m][n] = __builtin_amdgcn_mfma_f32_16x16x16bf16_1k(khf, vf[n], S[m][n] * dc, 0, 0, 0);
        }
        if constexpr (OUT) {
            float ss[4];
#pragma unroll
            for (int r = 0; r < 4; ++r) { ss[r] = (O[0][r] * O[0][r] + O[1][r] * O[1][r]) + (O[2][r] * O[2][r] + O[3][r] * O[3][r]); ss[r] = sum16(ss[r]); }
#pragma unroll
            for (int r = 0; r < 4; ++r) { const float rs = __builtin_amdgcn_rsqf(ss[r] * (1.0f / 64.0f) + EPS); const size_t tt = (size_t)c * 16 + 4 * g4 + r;
#pragma unroll
                for (int n = 0; n < 4; ++n) { const float gt_ = bf2f(gt16[r][n]);
                    y_base[tt * 1024 + 16 * n + l16] = f2bf(O[n][r] * rs * gn[n] * gt_); } }
        }
    }
    if constexpr (!OUT) {
#pragma unroll
        for (int m = 0; m < NM; ++m)
#pragma unroll
            for (int n = 0; n < 4; ++n)
#pragma unroll
                for (int r = 0; r < 4; ++r) sbase[(16 * m + r) * 64 + 16 * n] = S[m][n][r];
        if (lane < DK) Pout[ch] = __expf(btot);
    }
}
}

__device__ __forceinline__ int opq(int i) { asm volatile("" : "+s"(i)); return i; }

constexpr int NPH = 18, NPRE = 3, NPHASES = NPRE + DEPTH * NPH;

template <int SEL>
__global__ void __launch_bounds__(NTHREADS, 2) mk_fwd(Params p) {
    extern __shared__ __attribute__((aligned(16))) unsigned char lds[];
    const int bx = blockIdx.x, G = gridDim.x;
    const size_t ngt = (size_t)G * NTHREADS;
    const int ngw = G * NWAVES;
    PG8_LAS unsigned char* glds = (PG8_LAS unsigned char*)lds;
#define PHASE_BEGIN \
    int tid = threadIdx.x; asm volatile("" : "+v"(tid)); \
    const int lane = tid & 63, wave = __builtin_amdgcn_readfirstlane(tid >> 6); \
    const size_t gt = (size_t)bx * NTHREADS + tid; const int gw = bx * NWAVES + wave; \
    size_t wsz_ = 0; asm volatile("" : "+s"(wsz_)); unsigned char* ws = p.ws + wsz_;     \
    (void)lane; (void)wave; (void)gt; (void)gw;
#define PIN(i) (p.in[opq(i)])
#if MK_FUSED
    volatile LAS unsigned* misc = (volatile LAS unsigned*)((LAS unsigned char*)lds + LDS_MISC);
    if (threadIdx.x < 4) misc[threadIdx.x] = 0u;
    __syncthreads();
    XcdBarrier bar = xcd_barrier_post((unsigned*)(p.ws + WS_CTL), misc);
#define GRID_BAR() xcd_barrier(bar)
#else
#define GRID_BAR() do { } while (0)
#endif
    const int lo = p.ph_lo, hi = p.ph_hi;
#define PHSEL(i) (SEL < 0 || (i) + 1 == SEL)
#define INR(k) (lo <= (k) && (k) < hi)
#define IN(k) (PHSEL(-1) && INR(k))
#define SEAM(k) do { if (INR(k) && INR((k) + 1)) { GRID_BAR(); if ((PROBE_MASK >> 29) & 1) GRID_BAR(); } } while (0)
#define INP(i) (PHSEL(i) && INR(pb + (i)))
#define SEAMP(i) SEAM(pb + (i))

#define x_in (PIN(0))
#define hout (p.out)
#define lbt ((float*)(ws + WS_LB))
#define rstd ((float*)(ws + WS_RSTD))
#define part ((float*)(ws + WS_PART))
#define latpb ((float*)(ws + WS_LATP))
#define cq ((float*)(ws + WS_CQ))
#define ckv ((float*)(ws + WS_CKV))
#define memrstd ((float*)(ws + WS_MEMRSTD))
#define memb ((bf16_t*)(ws + WS_MEMB))
#define kvraw_ca ((float*)(ws + WS_R))
#define kca ((bf16_t*)(ws + WS_KCA))
#define vca ((bf16_t*)(ws + WS_VCA))
#define rot ((f32x2*)(ws + WS_ROT))
#define wall ((bf16_t*)(ws + WS_W))
#define hb ((bf16_t*)(ws + WS_HB))
#define gqk ((bf16_t*)(ws + R_GQK))
#define gv ((bf16_t*)(ws + R_GV))
#define gr ((bf16_t*)(ws + R_GR))
#define hq ((bf16_t*)(ws + R_HQ))
#define hi_ ((bf16_t*)(ws + R_HI))
#define hg ((bf16_t*)(ws + R_HG))
#define hk ((bf16_t*)(ws + R_HK))
#define ga ((const _Float16*)(ws + R_GA))
#define ha ((const _Float16*)(ws + R_HA))
#define qlat ((bf16_t*)(ws + R_QLAT))
#define kvlat ((bf16_t*)(ws + R_KVLAT))
#define krope ((bf16_t*)(ws + R_KROPE))
#define ybuf ((bf16_t*)(ws + R_Y))
#define sg ((float*)(ws + R_SG))
#define sh ((float*)(ws + R_SH))
#define pg ((float*)(ws + R_PG))
#define ph ((float*)(ws + R_PH))
#define qb ((bf16_t*)(ws + R_Q))
#define krh ((bf16_t*)(ws + R_KRH))
#define qraw ((bf16_t*)(ws + R_QRAW))
#define kvraw ((bf16_t*)(ws + R_KVRAW))
#define kn ((bf16_t*)(ws + R_KN))
#define vb ((bf16_t*)(ws + R_V))
#define qca ((bf16_t*)(ws + R_QCA))
#define oca ((bf16_t*)(ws + R_OCA))
#define ghb ((float*)(ws + R_GH))
#define uhb ((float*)(ws + R_UH))
#define uraw ((bf16_t*)(ws + R_URAW))

#define NORM_PHASE(SRC) do {   \
        for (int r0 = gw * 4; r0 < T; r0 += ngw * 4) { \
            f32x4 v[4][4]; float s[4]; \
            _Pragma("unroll") for (int q = 0; q < 4; ++q) { const f32x4* xr = (const f32x4*)((SRC) + (size_t)(r0 + q) * DM) + lane; \
                _Pragma("unroll") for (int j = 0; j < 4; ++j) v[q][j] = xr[64 * j]; } \
            _Pragma("unroll") for (int q = 0; q < 4; ++q) { float a = 0.f; \
                _Pragma("unroll") for (int j = 0; j < 4; ++j) a += (v[q][j][0] * v[q][j][0] + v[q][j][1] * v[q][j][1]) + (v[q][j][2] * v[q][j][2] + v[q][j][3] * v[q][j][3]); \
                s[q] = wave_sum_dpp(a); } \
            _Pragma("unroll") for (int q = 0; q < 4; ++q) { \
                if (lane < 16) part[(size_t)(r0 + q) * 16 + lane] = (lane == 0) ? s[q] : 0.f; \
                u32x2* o8 = (u32x2*)(hb + (size_t)(r0 + q) * DM) + lane; \
                _Pragma("unroll") for (int j = 0; j < 4; ++j) o8[64 * j] = (u32x2){cvt_pk_f16(v[q][j][0], v[q][j][1]), cvt_pk_f16(v[q][j][2], v[q][j][3])}; } \
        } } while (0)
    if (IN(0)) { for (int rep0_ = 0; rep0_ < (((PROBE_MASK >> 30) & 1) ? 2 : 1); ++rep0_) {
        PHASE_BEGIN
        {
            size_t g = gt, base = 0;
            build_bt<true>(wall + W_IN, 2560, 1024, PIN(4), (size_t)DM * P_IN, P_IN, PIN(3), DM, [](int n, float& sc) -> int { sc = 1.f;
                if (n < 512) return n;
                if (n < 640) { sc = 0.17677669529663687f; return 576 + (n - 512); }
                if (n < 768) return 704 + (n - 640);
                if (n < 896) return -2;
                if (n < 960) return 512 + (n - 896);
                if (n < 1024) return -1;
                if (n < 1280) return 832 + (n - 1024);
                if (n < 1536) return 1104 + (n - 1280);
                return 1360 + (n - 1536); }, g, base, ngt);
            build_bt<false>(wall + W_Q, 1024, 256, PIN(6), (size_t)256 * 768, 768, PIN(5), 256, [](int n, float& sc) -> int { sc = 1.f; const int h = n >> 8, c = n & 255;
                if (c < 128) return h * 192 + c;
                if (c >= 192) return -1;
                const int cc = c - 128, jb = 4 * (4 * (cc >> 5) + ((cc >> 3) & 3)), i8 = cc & 7;
                return h * 192 + (i8 < 4 ? 128 + jb + i8 : 160 + jb + (i8 - 4)); }, g, base, ngt);
            build_bt<false>(wall + W_KV, 1024, 256, PIN(8), (size_t)256 * 1024, 1024, PIN(7), 256, [](int n, float& sc) -> int { sc = 1.f; return n; }, g, base, ngt);
            build_bt<false>(wall + W_MIX, 1024, 1024, PIN(16), (size_t)1024 * 1024, 1024, nullptr, 0, [](int n, float& sc) -> int { sc = 1.f; return n; }, g, base, ngt);
            build_bt<true>(wall + W_CAQ, 512, 1024, PIN(19), (size_t)1024 * 512, 512, PIN(17), DM, [](int n, float& sc) -> int { sc = 1.f; return n; }, g, base, ngt);
            build_bt<false>(wall + W_CAKV, 1024, 1024, PIN(20), (size_t)1024 * 1024, 1024, PIN(18), DM, [](int n, float& sc) -> int { sc = 1.f; return n; }, g, base, ngt);
            build_bt<false>(wall + W_CAO, 1024, 512, PIN(23), (size_t)512 * 1024, 1024, nullptr, 0, [](int n, float& sc) -> int { sc = 1.f; return n; }, g, base, ngt);
            build_bt<true>(wall + W_FFI, 5632, 1024, PIN(25), (size_t)1024 * 5632, 5632, PIN(24), DM, [](int n, float& sc) -> int { sc = 1.f; const int j = n >> 8, c = n & 255; return c < 128 ? 128 * j + c : 2816 + 128 * j + (c - 128); }, g, base, ngt);
            build_bt<true>(wall + W_FFO, 1024, 2816, PIN(28), (size_t)2816 * 1024, 1024, nullptr, 0, [](int n, float& sc) -> int { sc = 1.f; return n; }, g, base, ngt);
            for (size_t it = gt; it < (size_t)DEPTH * 128 * 128; it += ngt) {
                const int l = (int)(it >> 14), j = (int)(it & 127), k0 = (int)((it >> 7) & 127) * 8;
                const float* w_in = PIN(4) + (size_t)l * DM * P_IN; const float* wg = PIN(11) + (size_t)l * 16 * 128; const float* gain = PIN(3) + l * DM;
                float v[8];
#pragma unroll
                for (int e = 0; e < 8; ++e) { float s = 0.f;
#pragma unroll
                    for (int r = 0; r < 16; ++r) s = fmaf(w_in[(size_t)(k0 + e) * P_IN + 1088 + r], wg[r * 128 + j], s);
                    v[e] = s * gain[k0 + e]; }
                u32x4 w; w.x = cvt_pk_f16(v[0], v[1]); w.y = cvt_pk_f16(v[2], v[3]); w.z = cvt_pk_f16(v[4], v[5]); w.w = cvt_pk_f16(v[6], v[7]);
                *(u32x4*)(wall + (size_t)l * W_LAYER + W_IN + (size_t)(768 + j) * 1024 + k0) = w;
            }
        }
        for (size_t it = gt; it < (size_t)T * 32; it += ngt) {
            const int j = (int)(it & 31); const size_t t = it >> 5;
            const int pos = ((const int*)PIN(2))[t];
            float c, s; sincos_d((double)pos * INVF[j], c, s);
            rot[it] = (f32x2){c, s};
        }
        if (gt < 256) {
            const float* lg = PIN(14);
            const float a0 = lg[gt], a1 = lg[256 + gt], a2 = lg[512 + gt], a3 = lg[768 + gt];
            const float mx = fmaxf(fmaxf(a0, a1), fmaxf(a2, a3));
            const float e0 = expf(a0 - mx), e1 = expf(a1 - mx), e2 = expf(a2 - mx), e3 = expf(a3 - mx), inv = 1.0f / (e0 + e1 + e2 + e3);
            lbt[gt] = 0.f; lbt[256 + gt] = e1 * inv; lbt[512 + gt] = (e1 + e2) * inv; lbt[768 + gt] = (e1 + e2 + e3) * inv;
        }
        for (int r = gw; r < NB * NMEM; r += ngw) {
            const f32x4* xr = (const f32x4*)(PIN(1) + (size_t)r * DM) + lane;
            f32x4 v[4]; float s = 0.f;
#pragma unroll
            for (int j = 0; j < 4; ++j) { v[j] = xr[64 * j]; s += (v[j][0] * v[j][0] + v[j][1] * v[j][1]) + (v[j][2] * v[j][2] + v[j][3] * v[j][3]); }
            s = wave_sum(s);
            if (lane == 0) memrstd[r] = 1.0f / sqrtf(s * (1.0f / DM) + EPS);
            u32x2* o8 = (u32x2*)(memb + (size_t)r * DM) + lane;
#pragma unroll
            for (int j = 0; j < 4; ++j) o8[64 * j] = (u32x2){cvt_pk_bf16(v[j][0], v[j][1]), cvt_pk_bf16(v[j][2], v[j][3])};
        }
        NORM_PHASE(x_in);
    } }
    SEAM(0);
    if (IN(1)) { PHASE_BEGIN
#pragma unroll 1
        for (int l = 0; l < DEPTH; ++l) {
            pg8::Gemm g{memb, wall + (size_t)l * W_LAYER + W_CAKV, NB * NMEM, 1024, 1024}; pg8::StaticOrder S; S.init(NB * NMEM, 1024, G, (bx + G - 32 * l) % G);
            EpiScaleF32 E{memrstd, kvraw_ca + (size_t)l * 2048 * 1024, 1024};
            pg8::gemm_phase<EpiScaleF32, pg8::StaticOrder>(glds, g, S, E);
            __syncthreads();
        }
    }
    SEAM(1);
    if (IN(2)) { PHASE_BEGIN
#pragma unroll 1
        for (int l = 0; l < DEPTH; ++l) {
            const float* kvraw_l = kvraw_ca + (size_t)l * 2048 * 1024; bf16_t* kca_l = kca + (size_t)l * 2048 * 512; bf16_t* vca_l = vca + (size_t)l * 2048 * 512;

            const float* qg = PIN(21) + l * 128; const float* kg = PIN(22) + l * 128;
            const int h = lane >> 4, i = lane & 15;
            for (int r = gw; r < NB * NMEM; r += ngw) {
                const int b = r >> 8, m = r & 255;
                const float* src = kvraw_l + (size_t)r * 1024 + h * 256;
                const f32x4 k0 = *(const f32x4*)(src + 8 * i), k1 = *(const f32x4*)(src + 8 * i + 4), v0 = *(const f32x4*)(src + 128 + 8 * i), v1 = *(const f32x4*)(src + 128 + 8 * i + 4);
                float ss = (k0[0] * k0[0] + k0[1] * k0[1]) + (k0[2] * k0[2] + k0[3] * k0[3]) + (k1[0] * k1[0] + k1[1] * k1[1]) + (k1[2] * k1[2] + k1[3] * k1[3]);
                ss = sum16(ss);
                const float rs = 1.0f / sqrtf(ss * (1.0f / 128.0f) + EPS);
                const f32x4 g0 = *(const f32x4*)(kg + 8 * i) * *(const f32x4*)(qg + 8 * i), g1 = *(const f32x4*)(kg + 8 * i + 4) * *(const f32x4*)(qg + 8 * i + 4);
                const size_t o = ((size_t)(b * 4 + h) * NMEM + m) * 128 + 8 * i;
                *(u32x4*)(kca_l + o) = pack8(k0 * rs * g0, k1 * rs * g1);
                *(u32x4*)(vca_l + o) = pack8(v0, v1);
            }
        }
    }
    SEAM(2);

    for (int l = 0; l < DEPTH; ++l) {
        const int pb = NPRE + l * NPH;
#define wl (wall + (size_t)l * W_LAYER)
#define hsrc0 ((l == 0) ? x_in : (const float*)hout)


        if (INP(1)) { _Pragma("unroll 1") for (int rep_ = 0; rep_ < (((PROBE_MASK >> 1) & 1) ? 2 : 1); ++rep_) { PHASE_BEGIN
            pg8::Gemm g{hb, wl + W_IN, T, 2560, 1024}; pg8::StaticOrderG1 S; S.init(T, 2560, G, bx);
            EpiInProj E{ws, PIN(12) + l * 128, lbt + l * 256, (PG8_LAS float*)(glds + LDS_STAGE)};
            pg8::gemm_phase<EpiInProj, pg8::StaticOrderG1, true>(glds, g, S, E);
        } }
        SEAMP(1);

        if (INP(2)) { _Pragma("unroll 1") for (int rep_ = 0; rep_ < (((PROBE_MASK >> 2) & 1) ? 2 : 1); ++rep_) { PHASE_BEGIN
            for (int uu = bx; uu < 256; uu += G) {
                const int j = uu * 4 + (wave & 3), head = j & 3, seg = (j >> 2) & 31, b = j >> 7;
                const size_t t0 = (size_t)b * SEQ + (size_t)seg * SEGL; const int un = (b * 4 + head) * NSEG + seg;
                char* wlp = (char*)lds + wave * scan::WREG;
                if (wave < 4) scan::seg<32, false>(ga + t0 * 128 + head * 32, 128, nullptr, gqk + t0 * 256 + 128 + head * 32, gv + t0 * 256 + head * 64, nullptr, sg + (size_t)un * 2048, pg + (size_t)un * 32, nullptr, nullptr, wlp, lane);
                else          scan::seg<64, false>(ha + t0 * 256 + head * 64, 256, nullptr, hk + t0 * 256 + head * 64, hi_ + t0 * 256 + head * 64, nullptr, sh + (size_t)un * 4096, ph + (size_t)un * 64, nullptr, nullptr, wlp, lane);
            }
        } }
        SEAMP(2);

        if (INP(3)) { _Pragma("unroll 1") for (int rep_ = 0; rep_ < (((PROBE_MASK >> 3) & 1) ? 2 : 1); ++rep_) { PHASE_BEGIN
            for (size_t c = gt; c < (size_t)32 * 32 * 64; c += ngt) {
                const int bh = (int)(c >> 11), d = (int)(c >> 6) & 31, e = (int)c & 63;
                float* a0 = sg + (size_t)bh * NSEG * 2048 + d * 64 + e; const float* p0 = pg + (size_t)bh * NSEG * 32 + d;
                float sv[NSEG], pv[NSEG];
#pragma unroll
                for (int q = 0; q < NSEG; ++q) { sv[q] = a0[(size_t)q * 2048]; pv[q] = p0[q * 32]; }
                float carry = 0.f;
#pragma unroll
                for (int q = 0; q < NSEG; ++q) { const float tmp = sv[q]; a0[(size_t)q * 2048] = carry; carry = fmaf(pv[q], carry, tmp); }
            }
            for (size_t c = gt; c < (size_t)32 * 64 * 64; c += ngt) {
                const int bh = (int)(c >> 12), d = (int)(c >> 6) & 63, e = (int)c & 63;
                float* a0 = sh + (size_t)bh * NSEG * 4096 + d * 64 + e; const float* p0 = ph + (size_t)bh * NSEG * 64 + d;
                float sv[NSEG], pv[NSEG];
#pragma unroll
                for (int q = 0; q < NSEG; ++q) { sv[q] = a0[(size_t)q * 4096]; pv[q] = p0[q * 64]; }
                float carry = 0.f;
#pragma unroll
                for (int q = 0; q < NSEG; ++q) { const float tmp = sv[q]; a0[(size_t)q * 4096] = carry; carry = fmaf(pv[q], carry, tmp); }
            }
        } }
        SEAMP(3);

        if (INP(4)) { _Pragma("unroll 1") for (int rep_ = 0; rep_ < (((PROBE_MASK >> 4) & 1) ? 2 : 1); ++rep_) { PHASE_BEGIN
            for (int uu = bx; uu < 256; uu += G) {
                const int j = uu * 4 + (wave & 3), head = j & 3, seg = (j >> 2) & 31, b = j >> 7;
                const size_t t0 = (size_t)b * SEQ + (size_t)seg * SEGL; const int un = (b * 4 + head) * NSEG + seg;
                char* wlp = (char*)lds + wave * scan::WREG;
                if (wave < 4) scan::seg<32, true>(ga + t0 * 128 + head * 32, 128, gqk + t0 * 256 + head * 32, gqk + t0 * 256 + 128 + head * 32, gv + t0 * 256 + head * 64, gr + t0 * 256 + head * 64,
                                                  sg + (size_t)un * 2048, nullptr, PIN(13) + l * 64, ybuf + t0 * 1024 + 512 + head * 64, wlp, lane);
                else          scan::seg<64, true>(ha + t0 * 256 + head * 64, 256, hq + t0 * 256 + head * 64, hk + t0 * 256 + head * 64, hi_ + t0 * 256 + head * 64, hg + t0 * 256 + head * 64,
                                                  sh + (size_t)un * 4096, nullptr, PIN(15) + l * 64, ybuf + t0 * 1024 + 768 + head * 64, wlp, lane);
            }
        } }
        SEAMP(4);

        if (INP(5)) { _Pragma("unroll 1") for (int rep_ = 0; rep_ < (((PROBE_MASK >> 5) & 1) ? 2 : 1); ++rep_) { PHASE_BEGIN
            { int k256 = 256; asm volatile("" : "+s"(k256)); pg8::Gemm g{qlat, wl + W_Q, T, 1024, k256}; pg8::StaticOrder S; S.init(T, 1024, G, bx);
              EpiQUp E{ws, PIN(9) + l * 192, (PG8_LAS float*)(glds + LDS_STAGE), (PG8_LAS float*)(glds + LDS_STAGE + 4096)};
              pg8::gemm_phase<EpiQUp, pg8::StaticOrder>(glds, g, S, E); }
            __syncthreads();
            { int k256 = 256; asm volatile("" : "+s"(k256)); pg8::Gemm g{kvlat, wl + W_KV, T, 1024, k256}; pg8::StaticOrder S; S.init(T, 1024, G, bx);
              EpiKVUp E{ws, PIN(10) + l * 192, (PG8_LAS float*)(glds + LDS_STAGE), (PG8_LAS float*)(glds + LDS_STAGE + 4096)};
              pg8::gemm_phase<EpiKVUp, pg8::StaticOrder>(glds, g, S, E); }
        } }
        SEAMP(5);

        if (INP(7)) { _Pragma("unroll 1") for (int rep_ = 0; rep_ < (((PROBE_MASK >> 7) & 1) ? 2 : 1); ++rep_) { PHASE_BEGIN
#pragma unroll 1
            for (int uid = bx * 4; uid < 1024; uid += G * 4) {
            const int vbx = uid >> 2;
            const int bh = (vbx & 7) * 4 + ((vbx >> 3) & 3), gg = (vbx >> 5) & 7, b = bh >> 2, h = bh & 3;
#pragma unroll 1
            for (int ui = 0; ui < 3; ++ui) {
                const int qblk = (ui == 0) ? 31 - gg : (ui == 1) ? 16 + gg : 15 - gg;
                att::attn_body_dma(qb + ((size_t)bh * SEQ + (size_t)qblk * 256) * 192, 192, kn + (size_t)bh * SEQ * 128, krh + (size_t)bh * SEQ * 64, vb + (size_t)bh * SEQ * 128,
                                  ybuf + ((size_t)b * SEQ + (size_t)qblk * 256) * 1024 + h * 128, 1024, 4 * qblk + 4, 4 * qblk + (wave >> 1), (char*)lds, (LAS unsigned char*)lds);
            }
            }
            {
                volatile LAS int* slot = (volatile LAS int*)((LAS unsigned char*)lds + LDS_MISC + 128);
                int* ctr = (int*)(ws + WS_CTL + 16384 + l * 64);
#pragma unroll 1
                for (;;) {
                    __syncthreads();
                    if (tid == 0) *slot = atomicAdd(ctr, 1);
                    __syncthreads();
                    const int u = __builtin_amdgcn_readfirstlane(*slot);
                    if (u >= 256) break;
                    const int qblk = 7 - (u >> 5), bh = u & 31, b = bh >> 2, h = bh & 3;
                    att::attn_body_dma(qb + ((size_t)bh * SEQ + (size_t)qblk * 256) * 192, 192, kn + (size_t)bh * SEQ * 128, krh + (size_t)bh * SEQ * 64, vb + (size_t)bh * SEQ * 128,
                                      ybuf + ((size_t)b * SEQ + (size_t)qblk * 256) * 1024 + h * 128, 1024, 4 * qblk + 4, 4 * qblk + (wave >> 1), (char*)lds, (LAS unsigned char*)lds);
                }
            }
        } }
        SEAMP(7);

        if (INP(8)) { _Pragma("unroll 1") for (int rep_ = 0; rep_ < (((PROBE_MASK >> 8) & 1) ? 2 : 1); ++rep_) { PHASE_BEGIN
#pragma unroll 1
            for (int pm = bx; pm < T / 256; pm += G) {
                { pg8::Gemm g{ybuf, wl + W_MIX, T, 1024, 1024}; pg8::PanelOrder S{pm, 4}; EpiResid E{hb, hb, hout, part, 0};
                  pg8::gemm_phase<EpiResid, pg8::PanelOrder>(glds, g, S, E); }
                __syncthreads();
                { pg8::Gemm g{hb, wl + W_CAQ, T, 512, 1024}; pg8::PanelOrder S{pm, 2}; EpiScaleBf16<true> E{part, qca, 512, (PG8_LAS float*)(glds + LDS_STAGE)};
                  pg8::gemm_phase<EpiScaleBf16<true>, pg8::PanelOrder, true>(glds, g, S, E); }
                __syncthreads();
                { const int b = pm >> 5, qblk = pm & 31;
#pragma unroll 1
                  for (int h = 0; h < 4; ++h) { const int bh = b * 4 + h;
                      att::attn_body<1, 2>(qca + ((size_t)b * SEQ + (size_t)qblk * 256) * 512 + h * 128, 512, kca + (size_t)l * 2048 * 512 + (size_t)bh * NMEM * 128, nullptr, vca + (size_t)l * 2048 * 512 + (size_t)bh * NMEM * 128,
                                        oca + ((size_t)b * SEQ + (size_t)qblk * 256) * 512 + h * 128, 512, 4, 1 << 30, (char*)lds); } }
                __syncthreads();
                { pg8::Gemm g{oca, wl + W_CAO, T, 1024, 512}; pg8::PanelOrder S{pm, 4}; EpiResid E{hb, hb, hout, part, 0};
                  pg8::gemm_phase<EpiResid, pg8::PanelOrder>(glds, g, S, E); }
                __syncthreads();
            }
        } }
        SEAMP(8);

        if (false) { }

        if (INP(15)) { _Pragma("unroll 1") for (int rep_ = 0; rep_ < (((PROBE_MASK >> 15) & 1) ? 2 : 1); ++rep_) { PHASE_BEGIN
            pg8::Gemm g{hb, wl + W_FFI, T, 5632, 1024}; pg8::StaticOrder S; S.init(T, 5632, G, bx);
            EpiGateUpConv E{part, uraw, ghb, uhb, PIN(26) + (size_t)l * 3 * D_FF, PIN(27) + (size_t)l * D_FF, (PG8_LAS float*)(glds + LDS_STAGE), (PG8_LAS float*)(glds + LDS_STAGE + 4096)};
            pg8::gemm_phase<EpiGateUpConv, pg8::StaticOrder, true>(glds, g, S, E);
        } }
        SEAMP(15);

        if (INP(16)) { _Pragma("unroll 1") for (int rep_ = 0; rep_ < (((PROBE_MASK >> 16) & 1) ? 2 : 1); ++rep_) { PHASE_BEGIN
            const float* cw = PIN(26) + (size_t)l * 3 * D_FF; const float* cbias = PIN(27) + (size_t)l * D_FF;
            for (size_t it = gt; it < (size_t)256 * (D_FF / 8); it += ngt) {
                const int c = (int)(it % (D_FF / 8)) * 8, pm = (int)(it / (D_FF / 8));
                if ((pm & 31) == 0) continue;
                f32x4 gm2[2], gm1[2], g0[2], g1[2], w0[2], w1[2], w2[2], bb[2], u0[2], u1[2];
#pragma unroll
                for (int hh = 0; hh < 2; ++hh) { const int cc = c + 4 * hh;
                    gm2[hh] = *(const f32x4*)(ghb + ((size_t)(pm - 1) * 4 + 0) * D_FF + cc); gm1[hh] = *(const f32x4*)(ghb + ((size_t)(pm - 1) * 4 + 1) * D_FF + cc);
                    g0[hh] = *(const f32x4*)(ghb + ((size_t)pm * 4 + 2) * D_FF + cc); g1[hh] = *(const f32x4*)(ghb + ((size_t)pm * 4 + 3) * D_FF + cc);
                    u0[hh] = *(const f32x4*)(uhb + ((size_t)pm * 2) * D_FF + cc); u1[hh] = *(const f32x4*)(uhb + ((size_t)pm * 2 + 1) * D_FF + cc);
                    w0[hh] = *(const f32x4*)(cw + cc); w1[hh] = *(const f32x4*)(cw + D_FF + cc); w2[hh] = *(const f32x4*)(cw + 2 * D_FF + cc); bb[hh] = *(const f32x4*)(cbias + cc); }
                float o0[8], o1[8];
#pragma unroll
                for (int hh = 0; hh < 2; ++hh)
#pragma unroll
                    for (int e = 0; e < 4; ++e) {
                        const float c0v = bb[hh][e] + gm2[hh][e] * w0[hh][e] + gm1[hh][e] * w1[hh][e] + g0[hh][e] * w2[hh][e], c1v = bb[hh][e] + gm1[hh][e] * w0[hh][e] + g0[hh][e] * w1[hh][e] + g1[hh][e] * w2[hh][e];
                        o0[4 * hh + e] = fast_silu(c0v) * u0[hh][e]; o1[4 * hh + e] = fast_silu(c1v) * u1[hh][e]; }
                *(u32x4*)(uraw + ((size_t)pm * 256) * D_FF + c) = (u32x4){cvt_pk_f16(o0[0], o0[1]), cvt_pk_f16(o0[2], o0[3]), cvt_pk_f16(o0[4], o0[5]), cvt_pk_f16(o0[6], o0[7])};
                *(u32x4*)(uraw + ((size_t)pm * 256 + 1) * D_FF + c) = (u32x4){cvt_pk_f16(o1[0], o1[1]), cvt_pk_f16(o1[2], o1[3]), cvt_pk_f16(o1[4], o1[5]), cvt_pk_f16(o1[6], o1[7])};
            }
        } }
        SEAMP(16);

        if (INP(17)) { _Pragma("unroll 1") for (int rep_ = 0; rep_ < (((PROBE_MASK >> 17) & 1) ? 2 : 1); ++rep_) { PHASE_BEGIN
            pg8::Gemm g{uraw, wl + W_FFO, T, 1024, 2816}; pg8::StaticOrder S; S.init(T, 1024, G, bx); EpiResid E{hb, (((PROBE_MASK >> 17) & 1) && rep_ == 0) ? (bf16_t*)(ws + WS_R + 32 * MiB) : hb, hout, part, ((l == DEPTH - 1) && !(((PROBE_MASK >> 17) & 1) && rep_ == 0)) ? 1 : 0};
            pg8::gemm_phase<EpiResid, pg8::StaticOrder, true>(glds, g, S, E);
        } }
        SEAMP(17);
    }
#undef IN
#undef SEAM
#undef INP
#undef SEAMP
#undef INR
#undef PHSEL
#undef PHASE_BEGIN
#undef PIN
#undef x_in
#undef hout
#undef lbt
#undef rstd
#undef part
#undef latpb
#undef cq
#undef ckv
#undef memrstd
#undef memb
#undef kvraw_ca
#undef kca
#undef vca
#undef rot
#undef wall
#undef hb
#undef gqk
#undef gv
#undef gr
#undef hq
#undef hi_
#undef hg
#undef hk
#undef ga
#undef ha
#undef qlat
#undef kvlat
#undef krope
#undef ybuf
#undef sg
#undef sh
#undef pg
#undef ph
#undef qb
#undef krh
#undef qraw
#undef kvraw
#undef kn
#undef vb
#undef qca
#undef oca
#undef ghb
#undef uhb
#undef uraw
#undef wl
#undef hsrc0
}

typedef void (*kern_t)(Params);
extern "C" void kernel_launch(void* const* d_in, const int* in_sizes, int n_in, void* d_out, int out_size, void* d_ws, size_t ws_size, hipStream_t stream) {
#if MK_FUSED
    static const kern_t kt[1] = {mk_fwd<-1>};
    constexpr int NK = 1;
#else
    static const kern_t kt[19] = {mk_fwd<0>, mk_fwd<1>, mk_fwd<2>, mk_fwd<3>, mk_fwd<4>, mk_fwd<5>, mk_fwd<6>, mk_fwd<7>, mk_fwd<8>, mk_fwd<9>, mk_fwd<10>, mk_fwd<11>, mk_fwd<12>, mk_fwd<13>, mk_fwd<14>,
                                  mk_fwd<15>, mk_fwd<16>, mk_fwd<17>, mk_fwd<18>};
    constexpr int NK = 19;
#endif
    static int grid = 0;
    if (grid == 0) {
        if (n_in != 29 || out_size != T * DM || ws_size < WS_END) { fprintf(stderr, "kernel_launch: unexpected shapes (n_in %d out %d ws %zu need %zu)\n", n_in, out_size, ws_size, (size_t)WS_END); grid = -1; return; }
        int dev = 0, cus = 0, per_cu = 0;
        if (hipGetDevice(&dev) != hipSuccess || hipDeviceGetAttribute(&cus, hipDeviceAttributeMultiprocessorCount, dev) != hipSuccess) { grid = -1; return; }
        for (int i = 0; i < NK; ++i)
            if (hipFuncSetAttribute((const void*)kt[i], hipFuncAttributeMaxDynamicSharedMemorySize, (int)LDS_BYTES) != hipSuccess) { fprintf(stderr, "kernel_launch: hipFuncSetAttribute failed\n"); grid = -1; return; }
        if (hipOccupancyMaxActiveBlocksPerMultiprocessor(&per_cu, (const void*)kt[0], NTHREADS, LDS_BYTES) != hipSuccess || per_cu < 1) fprintf(stderr, "kernel_launch: occupancy query says %d\n", per_cu);
        (void)hipGetLastError();
        grid = cus;
    }
    if (grid < 0) return;
    (void)hipMemsetAsync((char*)d_ws + WS_CTL, 0, CTL_BYTES, stream);
    Params p{};
    for (int i = 0; i < 29; ++i) p.in[i] = (const float*)d_in[i];
    p.out = (float*)d_out; p.ws = (unsigned char*)d_ws;
#if MK_FUSED
    p.ph_lo = 0; p.ph_hi = NPHASES;
    hipLaunchKernelGGL(kt[0], dim3(grid), dim3(NTHREADS), LDS_BYTES, stream, p);
#else
    for (int k = 0; k < NPHASES; ++k) { p.ph_lo = k; p.ph_hi = k + 1; const int sel = (k < NPRE) ? 0 : ((k - NPRE) % NPH) + 1;
        hipLaunchKernelGGL(kt[sel], dim3(grid), dim3(NTHREADS), LDS_BYTES, stream, p); }
#endif
    const hipError_t le = hipPeekAtLastError();
    if (le != hipSuccess) fprintf(stderr, "kernel_launch: launch failed: %s\n", hipGetErrorName(le));
}
```

```cpp
#include <hip/hip_runtime.h>
#include <cstdio>
#include <cstdint>

#ifndef PROBE_MASK
#define PROBE_MASK 0
#endif
#ifndef MK_FUSED
#define MK_FUSED 1
#endif

#define LAS __attribute__((address_space(3)))
typedef unsigned short bf16_t;
typedef short bf16x8 __attribute__((ext_vector_type(8)));
typedef short s16x4 __attribute__((ext_vector_type(4)));
typedef float f32x2 __attribute__((ext_vector_type(2)));
typedef float f32x4 __attribute__((ext_vector_type(4)));
typedef float f32x16 __attribute__((ext_vector_type(16)));
typedef unsigned u32x2 __attribute__((ext_vector_type(2)));
typedef unsigned u32x4 __attribute__((ext_vector_type(4)));

constexpr int NB = 8, SEQ = 8192, DM = 1024, DEPTH = 4, T = NB * SEQ;
constexpr int NMEM = 256, P_IN = 2384, D_FF = 2816;
constexpr float EPS = 1e-6f, LOG2E = 1.4426950408889634f;
constexpr int NWAVES = 8, NTHREADS = 512;

typedef __bf16 bf16x2_t __attribute__((ext_vector_type(2)));
__device__ __forceinline__ unsigned cvt_pk_bf16(float lo, float hi) { const f32x2 v = {lo, hi}; return __builtin_bit_cast(unsigned, __builtin_convertvector(v, bf16x2_t)); }
__device__ __forceinline__ float bf2f(unsigned short b) { return __uint_as_float(((unsigned)b) << 16); }
__device__ __forceinline__ float bflo(unsigned w) { return __uint_as_float(w << 16); }
__device__ __forceinline__ float bfhi(unsigned w) { return __uint_as_float(w & 0xffff0000u); }
__device__ __forceinline__ bf16_t f2bf(float f) { return (bf16_t)(cvt_pk_bf16(f, 0.f) & 0xffffu); }
__device__ __forceinline__ float wave_sum(float v) {
#pragma unroll
    for (int o = 1; o < 64; o <<= 1) v += __shfl_xor(v, o);
    return v;
}

__device__ __forceinline__ float wave_sum_dpp(float v) {
#define DPPF(x, ctrl, rm, bc) __builtin_bit_cast(float, __builtin_amdgcn_update_dpp(0, __builtin_bit_cast(int, (x)), (ctrl), (rm), 0xf, (bc)))
    v += DPPF(v, 0x111, 0xf, true); v += DPPF(v, 0x112, 0xf, true); v += DPPF(v, 0x114, 0xf, true); v += DPPF(v, 0x118, 0xf, true);
    v += DPPF(v, 0x142, 0xa, false); v += DPPF(v, 0x143, 0xc, false);
#undef DPPF
    return __uint_as_float((unsigned)__builtin_amdgcn_readlane((int)__float_as_uint(v), 63));
}
__device__ __forceinline__ float sum16(float v) {
    v += __shfl_xor(v, 1); v += __shfl_xor(v, 2); v += __shfl_xor(v, 4); v += __shfl_xor(v, 8); return v;
}
__device__ __forceinline__ float fast_sigmoid(float x) { return __builtin_amdgcn_rcpf(1.0f + __expf(-x)); }
__device__ __forceinline__ float fast_silu(float x) { return x * fast_sigmoid(x); }
__device__ __forceinline__ void exp2_8(f32x4& a, f32x4& b) {
#pragma unroll
    for (int j = 0; j < 4; ++j) { a[j] = __builtin_amdgcn_exp2f(a[j]); b[j] = __builtin_amdgcn_exp2f(b[j]); } }
__device__ __forceinline__ void rcp_8(f32x4& a, f32x4& b) {
#pragma unroll
    for (int j = 0; j < 4; ++j) { a[j] = __builtin_amdgcn_rcpf(a[j]); b[j] = __builtin_amdgcn_rcpf(b[j]); } }
__device__ __forceinline__ void log2_8(f32x4& a, f32x4& b) {
#pragma unroll
    for (int j = 0; j < 4; ++j) { a[j] = __builtin_amdgcn_logf(a[j]); b[j] = __builtin_amdgcn_logf(b[j]); } }
__device__ __forceinline__ void sigmoid_8(const f32x4& x0, const f32x4& x1, f32x4& s0, f32x4& s1) {
    s0 = x0 * -1.4426950408889634f; s1 = x1 * -1.4426950408889634f; exp2_8(s0, s1); s0 = s0 + 1.0f; s1 = s1 + 1.0f; rcp_8(s0, s1); }
__device__ __forceinline__ u32x4 pack8(f32x4 a, f32x4 b) { u32x4 w; w.x = cvt_pk_bf16(a[0], a[1]); w.y = cvt_pk_bf16(a[2], a[3]); w.z = cvt_pk_bf16(b[0], b[1]); w.w = cvt_pk_bf16(b[2], b[3]); return w; }


typedef _Float16 f16x2_t __attribute__((ext_vector_type(2)));
typedef _Float16 f16x8_t __attribute__((ext_vector_type(8)));
__device__ __forceinline__ unsigned cvt_pk_f16(float lo, float hi) { const f32x2 v = {lo, hi}; return __builtin_bit_cast(unsigned, __builtin_convertvector(v, f16x2_t)); }
__device__ __forceinline__ u32x4 pack8h(f32x4 a, f32x4 b) { u32x4 w; w.x = cvt_pk_f16(a[0], a[1]); w.y = cvt_pk_f16(a[2], a[3]); w.z = cvt_pk_f16(b[0], b[1]); w.w = cvt_pk_f16(b[2], b[3]); return w; }
__device__ __forceinline__ f32x2 unpk_f16(unsigned w) { return __builtin_convertvector(__builtin_bit_cast(f16x2_t, w), f32x2); }

#define XB_TMO      128
#define XB_XCNT(j)  (256  + 64 * (j))
#define XB_XSUB(j)  (1280 + 64 * (j))
#define XB_XGEN(j)  (2304 + 64 * (j))
#define XB_TOP      3328
#define XB_TOPGEN   3392
#define XCD_BAR_WORDS 3456
#define XB_SPIN_CAP (1u << 20)

__device__ __forceinline__ unsigned xb_ld(unsigned* p)              { return __hip_atomic_load(p, __ATOMIC_RELAXED, __HIP_MEMORY_SCOPE_AGENT); }
__device__ __forceinline__ unsigned xb_add(unsigned* p, unsigned v) { return __hip_atomic_fetch_add(p, v, __ATOMIC_RELAXED, __HIP_MEMORY_SCOPE_AGENT); }
__device__ __forceinline__ unsigned xb_xcc_id() { return (unsigned)__builtin_amdgcn_s_getreg((3 << 11) | 20) & 0xFu; }
#define XB_SPIN(cond, bar) do { unsigned _sp = 0; while (cond) { __builtin_amdgcn_s_sleep(1); \
    if ((++_sp & 255u) == 0u) { if (xb_ld(&(bar)[XB_TMO])) break; if (_sp > XB_SPIN_CAP) { atomicAdd(&(bar)[XB_TMO], 1u); break; } } } } while (0)

struct XcdBarrier { unsigned* bar; unsigned x; volatile LAS unsigned* st; };

__device__ __forceinline__ XcdBarrier xcd_barrier_post(unsigned* bar, volatile LAS unsigned* st) {
    XcdBarrier b; b.bar = bar; b.x = xb_xcc_id(); b.st = st;
    if (threadIdx.x == 0) (void)xb_add(&bar[XB_XCNT(b.x)], 1u);
    return b;
}
__device__ __forceinline__ void xcd_barrier_complete(unsigned* bar, unsigned x, unsigned& nloc, unsigned& nx) {
    const unsigned G = gridDim.x * gridDim.y * gridDim.z;
    unsigned sum, cnt, mine, sp = 0u;
    for (;;) {
        sum = 0u; cnt = 0u; mine = 0u;
#pragma unroll
        for (unsigned j = 0; j < 16; ++j) { const unsigned c = xb_ld(&bar[XB_XCNT(j)]); sum += c; cnt += (c > 0u) ? 1u : 0u; mine = (j == x) ? c : mine; }
        if (sum == G) break;
        __builtin_amdgcn_s_sleep(1);
        if ((++sp & 255u) == 0u) { if (xb_ld(&bar[XB_TMO])) break; if (sp > XB_SPIN_CAP) { atomicAdd(&bar[XB_TMO], 1u); break; } }
    }
    nloc = mine > 0u ? mine : 1u; nx = cnt > 0u ? cnt : 1u;
}
__device__ __forceinline__ void xcd_barrier(const XcdBarrier& b) {
    asm volatile("s_waitcnt vmcnt(0)" ::: "memory");
    __syncthreads();
    if (threadIdx.x == 0) {
        unsigned* bar = b.bar;
        __builtin_amdgcn_s_waitcnt(0);
        unsigned nloc = b.st[0], nx = b.st[1];
        if (nloc == 0u) { xcd_barrier_complete(bar, b.x, nloc, nx); b.st[0] = nloc; b.st[1] = nx; }
        const unsigned old = xb_add(&bar[XB_XSUB(b.x)], 1u);
        const unsigned gen = old / nloc;
        if (old + 1u == (gen + 1u) * nloc) {
            __builtin_amdgcn_fence(__ATOMIC_RELEASE, "agent");
            asm volatile("s_waitcnt vmcnt(0)" ::: "memory");
            const unsigned og = xb_add(&bar[XB_TOP], 1u);
            const unsigned tg = og / nx;
            if (og + 1u == (tg + 1u) * nx) xb_add(&bar[XB_TOPGEN], 1u);
            else XB_SPIN(xb_ld(&bar[XB_TOPGEN]) == tg, bar);
            __builtin_amdgcn_fence(__ATOMIC_ACQUIRE, "agent");
            xb_add(&bar[XB_XGEN(b.x)], 1u);
            asm volatile("s_waitcnt vmcnt(0)" ::: "memory");
        } else {
            XB_SPIN(xb_ld(&bar[XB_XGEN(b.x)]) == gen, bar);
            __builtin_amdgcn_fence(__ATOMIC_ACQUIRE, "agent");
            asm volatile("s_waitcnt vmcnt(0)" ::: "memory");
        }
    }
    __syncthreads();
}

namespace pg8 {
#define PG8_LAS __attribute__((address_space(3)))
constexpr int BM = 256, BK = 64, HALF = 128, HTB = HALF * BK * 2, STAGE_BYTES = 8 * HTB, NXCD = 8, WGM = 8;
__host__ __device__ __forceinline__ int lds_byte(int r, int c) { const int st = (r >> 4) * 2 + (c >> 5), rr = r & 15, cc = c & 31, ob = rr * 64 + cc * 2; return st * 1024 + (ob ^ (((ob >> 9) & 1) << 5)); }
__host__ __device__ __forceinline__ void stage_rc(int b, int& R, int& C) { const int st = b / 1024, sb = b % 1024, swz = sb ^ (((sb >> 9) & 1) << 5); R = (st >> 1) * 16 + swz / 64; C = (st & 1) * 32 + (swz % 64) / 2; }
__host__ __device__ __forceinline__ int perm32(int rho) { const int n = rho >> 4, i = rho & 15; return 8 * (i >> 2) + 4 * n + (i & 3); }
struct Unit { int pm, pn; };
struct Gemm { const bf16_t* A; const bf16_t* Bt; int M, N, K; };
struct StaticOrder {
    int nM, nN, nwg, G, c;
    __host__ __device__ void init(int M, int N, int G_, int c_) { nM = M / BM; nN = N / BM; nwg = nM * nN; G = G_; c = c_; }
    __host__ __device__ bool next(int i, Unit& u) const {
        const long L = (long)i * G + c; if (L >= nwg) return false;
        int wgid = (int)L; { const int q = nwg / NXCD, r = nwg % NXCD, xcd = wgid % NXCD, off = wgid / NXCD; wgid = (xcd < r ? xcd * (q + 1) : r * (q + 1) + (xcd - r) * q) + off; }
        const int nig = WGM * nN, gid = wgid / nig, fm = gid * WGM, gsz = (nM - fm) < WGM ? (nM - fm) : WGM;
        u.pm = fm + ((wgid % nig) % gsz); u.pn = (wgid % nig) / gsz; return true;
    }
    __device__ __forceinline__ void a_ready(const Unit&) const {}
    __device__ __forceinline__ void done(const Unit&) const {}
};
struct StaticOrderG1 : StaticOrder {
    __device__ __forceinline__ bool next(int i, Unit& u) const {
        const bool r = StaticOrder::next(i, u);
        if (r) { const int q = u.pn; u.pn = (q == 3) ? 4 : (q == 4) ? 3 : (q == 8) ? 9 : (q == 9) ? 8 : q; }
        return r; }
};
struct PanelOrder {
    int pm, n;
    __device__ __forceinline__ bool next(int i, Unit& u) const { if (i >= n) return false; u.pm = pm; u.pn = i; return true; }
    __device__ __forceinline__ void a_ready(const Unit&) const {}
    __device__ __forceinline__ void done(const Unit&) const {}
};

template <class Epi, class Sched, bool F16 = false, bool ALIGN_EPI = true, bool SP2 = true>
__device__ __forceinline__ void gemm_phase(PG8_LAS unsigned char* lds, const Gemm g, const Sched& S, const Epi& E) {
    int tid = threadIdx.x; asm volatile("" : "+v"(tid));
    const int wid = __builtin_amdgcn_readfirstlane(tid >> 6), lane = tid & 63, wr = wid >> 2, wc = wid & 3, fr = lane & 15, fq = lane >> 4;
    const int K = g.K, nt = K / BK;
    unsigned voffA[2], voffB[2];
#pragma unroll
    for (int i = 0; i < 2; ++i) { int R, C; stage_rc(tid * 16 + i * 8192, R, C); const int Rb = Epi::PERM ? ((R & ~31) + perm32(R & 31)) : R;
        voffA[i] = (unsigned)(R * K + C) * 2u; voffB[i] = (unsigned)(Rb * K + C) * 2u; }
    const size_t kstep = (size_t)(BK * 2);
    const size_t hstep = (size_t)HALF * K * 2;
    const size_t tstep = 2 * hstep;
    const unsigned ldsw = (unsigned)wid * 1024u;
    const int aoff = lds_byte(wr * 64 + fr, fq * 8), boff = lds_byte(wc * 32 + fr, fq * 8);
#define PG8_SA(b, h) (((b) * 2 + (h)) * HTB)
#define PG8_SB(b, h) ((4 + (b) * 2 + (h)) * HTB)
#define PG8_STAGE(bufoff, gbase, voff) do { _Pragma("unroll") for (int _i = 0; _i < 2; ++_i) \
        __builtin_amdgcn_global_load_lds((const unsigned*)((const char*)(gbase) + (voff)[_i]), (PG8_LAS unsigned*)(lds + (bufoff) + ldsw + _i * 8192), 16, 0, 0); } while (0)
#define PG8_LDA(dst, b, h) do { _Pragma("unroll") for (int m = 0; m < 4; ++m) _Pragma("unroll") for (int k = 0; k < 2; ++k) dst[m][k] = *(const PG8_LAS bf16x8*)(lds + PG8_SA(b, h) + aoff + m * 2048 + k * 1024); } while (0)
#define PG8_LDB(dst, b, h) do { _Pragma("unroll") for (int n = 0; n < 2; ++n) _Pragma("unroll") for (int k = 0; k < 2; ++k) dst[n][k] = *(const PG8_LAS bf16x8*)(lds + PG8_SB(b, h) + boff + n * 2048 + k * 1024); } while (0)
#define PG8_MMA(ai, bj, At, Bt) do { __builtin_amdgcn_s_setprio(1); _Pragma("unroll") for (int m = 0; m < 4; ++m) _Pragma("unroll") for (int n = 0; n < 2; ++n) _Pragma("unroll") for (int k = 0; k < 2; ++k) \
        acc[ai][bj][m][n] = F16 ? __builtin_amdgcn_mfma_f32_16x16x32_f16(__builtin_bit_cast(f16x8_t, Bt[n][k]), __builtin_bit_cast(f16x8_t, At[m][k]), acc[ai][bj][m][n], 0, 0, 0) \
                                : __builtin_amdgcn_mfma_f32_16x16x32_bf16(Bt[n][k], At[m][k], acc[ai][bj][m][n], 0, 0, 0); __builtin_amdgcn_s_setprio(0); } while (0)
#define PG8_WAIT_V(n) asm volatile("s_waitcnt vmcnt(" #n ")" ::: "memory")
#define PG8_WAIT_L(n) asm volatile("s_waitcnt lgkmcnt(" #n ")" ::: "memory")
#define PG8_BAR __builtin_amdgcn_s_barrier()
#define PG8_SCHED __builtin_amdgcn_sched_barrier(0)
    Unit cur, nxt; int ui = 0;
    if (!S.next(0, cur)) return;
    f32x4 acc[2][2][4][2];
#pragma unroll
    for (int a = 0; a < 2; ++a)
#pragma unroll
        for (int b = 0; b < 2; ++b)
#pragma unroll
            for (int m = 0; m < 4; ++m)
#pragma unroll
                for (int n = 0; n < 2; ++n) acc[a][b][m][n] = (f32x4){0.f, 0.f, 0.f, 0.f};
    bf16x8 At[4][2], B0[2][2], B1[2][2];
    const char* cA = (const char*)g.A + (size_t)cur.pm * tstep; const char* cB = (const char*)g.Bt + (size_t)cur.pn * tstep;
    S.a_ready(cur);
    E.prefetch(cur, wid, lane);
    if constexpr (SP2) {
        PG8_STAGE(PG8_SB(0, 0), cB, voffB); PG8_STAGE(PG8_SB(0, 1), cB + hstep, voffB); PG8_STAGE(PG8_SA(0, 0), cA, voffA); PG8_STAGE(PG8_SA(0, 1), cA + hstep, voffA);
        if (wr == 1) PG8_BAR;
        PG8_WAIT_V(2); PG8_BAR;
        PG8_STAGE(PG8_SB(1, 0), cB + kstep, voffB); PG8_STAGE(PG8_SA(1, 0), cA + kstep, voffA); PG8_STAGE(PG8_SB(1, 1), cB + hstep + kstep, voffB);
        PG8_WAIT_V(6); PG8_BAR;
    } else {
        PG8_STAGE(PG8_SB(0, 0), cB, voffB); PG8_STAGE(PG8_SA(0, 0), cA, voffA); PG8_STAGE(PG8_SB(0, 1), cB + hstep, voffB); PG8_STAGE(PG8_SA(0, 1), cA + hstep, voffA);
        if (wr == 1) PG8_BAR;
        PG8_WAIT_V(4); PG8_BAR;
        PG8_STAGE(PG8_SB(1, 0), cB + kstep, voffB); PG8_STAGE(PG8_SA(1, 0), cA + kstep, voffA); PG8_STAGE(PG8_SB(1, 1), cB + hstep + kstep, voffB);
        PG8_WAIT_V(6); PG8_BAR;
    }
    for (;;) {
        const bool has_next = S.next(ui + 1, nxt);
        const char* nA = has_next ? (const char*)g.A + (size_t)nxt.pm * tstep : cA; const char* nB = has_next ? (const char*)g.Bt + (size_t)nxt.pn * tstep : cB;
        for (int t = 0; t < nt; t += 2) {
            const bool last = (t == nt - 2);
            const char* a1 = cA + (size_t)(t + 1) * kstep;
            const char* a2 = last ? nA : cA + (size_t)(t + 2) * kstep; const char* b2 = last ? nB : cB + (size_t)(t + 2) * kstep;
            const char* a3 = a2 + kstep; const char* b3 = b2 + kstep;
            if (last && has_next) S.a_ready(nxt);
            if constexpr (SP2) {
            PG8_LDB(B0, 0, 0); PG8_LDB(B1, 0, 1); PG8_SCHED; PG8_LDA(At, 0, 0); PG8_STAGE(PG8_SA(1, 1), a1 + hstep, voffA);
            PG8_WAIT_V(8); PG8_WAIT_L(0); PG8_BAR; PG8_MMA(0, 0, At, B0); PG8_MMA(0, 1, At, B1); PG8_BAR; PG8_SCHED;
            PG8_LDA(At, 0, 1); PG8_STAGE(PG8_SB(0, 0), b2, voffB); PG8_STAGE(PG8_SB(0, 1), b2 + hstep, voffB); PG8_STAGE(PG8_SA(0, 0), a2, voffA);
            PG8_WAIT_V(8); PG8_WAIT_L(0); PG8_BAR; PG8_MMA(1, 0, At, B0); PG8_MMA(1, 1, At, B1); PG8_BAR; PG8_SCHED;
            PG8_LDB(B0, 1, 0); PG8_LDB(B1, 1, 1); PG8_SCHED; PG8_LDA(At, 1, 0); PG8_STAGE(PG8_SA(0, 1), a2 + hstep, voffA);
            PG8_WAIT_V(8); PG8_WAIT_L(0); PG8_BAR; PG8_MMA(0, 0, At, B0); PG8_MMA(0, 1, At, B1); PG8_BAR; PG8_SCHED;
            PG8_LDA(At, 1, 1); PG8_STAGE(PG8_SB(1, 0), b3, voffB); PG8_STAGE(PG8_SB(1, 1), b3 + hstep, voffB); PG8_STAGE(PG8_SA(1, 0), a3, voffA);
            PG8_WAIT_V(8); PG8_WAIT_L(0); PG8_BAR; PG8_MMA(1, 0, At, B0); PG8_MMA(1, 1, At, B1); PG8_BAR; PG8_SCHED;
            } else {
            PG8_LDB(B0, 0, 0); PG8_SCHED; PG8_LDA(At, 0, 0); PG8_STAGE(PG8_SA(1, 1), a1 + hstep, voffA);
            PG8_WAIT_L(8); PG8_BAR; PG8_WAIT_L(0); PG8_MMA(0, 0, At, B0); PG8_BAR; PG8_SCHED;
            PG8_LDB(B1, 0, 1); PG8_STAGE(PG8_SB(0, 0), b2, voffB);
            PG8_BAR; PG8_WAIT_L(0); PG8_MMA(0, 1, At, B1); PG8_BAR;
            PG8_LDA(At, 0, 1); PG8_STAGE(PG8_SA(0, 0), a2, voffA);
            PG8_BAR; PG8_WAIT_L(0); PG8_MMA(1, 0, At, B0); PG8_BAR; PG8_SCHED;
            PG8_STAGE(PG8_SB(0, 1), b2 + hstep, voffB);
            PG8_WAIT_V(6); PG8_BAR; PG8_MMA(1, 1, At, B1); PG8_BAR;
            PG8_LDB(B0, 1, 0); PG8_SCHED; PG8_LDA(At, 1, 0); PG8_STAGE(PG8_SA(0, 1), a2 + hstep, voffA);
            PG8_WAIT_L(8); PG8_BAR; PG8_WAIT_L(0); PG8_MMA(0, 0, At, B0); PG8_BAR; PG8_SCHED;
            PG8_LDB(B1, 1, 1); PG8_STAGE(PG8_SB(1, 0), b3, voffB);
            PG8_BAR; PG8_WAIT_L(0); PG8_MMA(0, 1, At, B1); PG8_BAR;
            PG8_LDA(At, 1, 1); PG8_STAGE(PG8_SA(1, 0), a3, voffA);
            PG8_BAR; PG8_WAIT_L(0); PG8_MMA(1, 0, At, B0); PG8_BAR; PG8_SCHED;
            PG8_STAGE(PG8_SB(1, 1), b3 + hstep, voffB);
            PG8_WAIT_V(6); PG8_BAR; PG8_MMA(1, 1, At, B1); PG8_BAR;
            }
        }
        if constexpr (ALIGN_EPI) { if (wr == 0) PG8_BAR; }
        E(acc, cur, wr, wc, fr, fq);
        if (!has_next) break;
        E.prefetch(nxt, wid, lane);
#pragma unroll
        for (int a = 0; a < 2; ++a)
#pragma unroll
            for (int b = 0; b < 2; ++b)
#pragma unroll
                for (int m = 0; m < 4; ++m)
#pragma unroll
                    for (int n = 0; n < 2; ++n) acc[a][b][m][n] = (f32x4){0.f, 0.f, 0.f, 0.f};
        cur = nxt; cA = nA; cB = nB; ++ui;
        if constexpr (ALIGN_EPI) { if (wr == 1) PG8_BAR; }
    }
    PG8_WAIT_V(0);
    if constexpr (!ALIGN_EPI) { if (wr == 0) PG8_BAR; }
    PG8_BAR;
#undef PG8_SA
#undef PG8_SB
#undef PG8_STAGE
#undef PG8_LDA
#undef PG8_LDB
#undef PG8_MMA
#undef PG8_WAIT_V
#undef PG8_WAIT_L
#undef PG8_BAR
#undef PG8_SCHED
}
}


constexpr size_t MiB = 1024 * 1024;
constexpr size_t al256(size_t x) { return (x + 255) / 256 * 256; }
constexpr size_t W_IN = 0, W_Q = W_IN + (size_t)2560 * 1024, W_KV = W_Q + (size_t)1024 * 256, W_MIX = W_KV + (size_t)1024 * 256, W_CAQ = W_MIX + (size_t)1024 * 1024,
                 W_CAKV = W_CAQ + (size_t)512 * 1024, W_CAO = W_CAKV + (size_t)1024 * 1024, W_FFI = W_CAO + (size_t)1024 * 512, W_FFO = W_FFI + (size_t)5632 * 1024,
                 W_LAYER = W_FFO + (size_t)1024 * 2816;
constexpr size_t WS_CTL = 0, CTL_BYTES = 65536;
constexpr size_t WS_LB = WS_CTL + CTL_BYTES;
constexpr size_t WS_RSTD = WS_LB + 4096;
constexpr size_t WS_CQ = WS_RSTD + (size_t)T * 4, WS_CKV = WS_CQ + (size_t)T * 4;
constexpr size_t WS_MEMRSTD = WS_CKV + (size_t)T * 4;
constexpr size_t WS_MEMB = WS_MEMRSTD + 8192;
constexpr size_t WS_KVRAW = WS_MEMB + (size_t)2048 * 1024 * 2;
constexpr size_t WS_KCA = WS_KVRAW + (size_t)2048 * 1024 * 4;
constexpr size_t WS_VCA = WS_KCA + (size_t)4 * 2048 * 512 * 2;
constexpr size_t WS_ROT = WS_VCA + (size_t)4 * 2048 * 512 * 2;
constexpr size_t WS_PART = WS_ROT + (size_t)T * 32 * 8;
constexpr size_t WS_LATP = WS_PART + (size_t)T * 16 * 4;
constexpr size_t WS_W = WS_LATP + (size_t)T * 16 * 4;
constexpr size_t WS_HB = al256(WS_W + 4 * W_LAYER * 2);
constexpr size_t WS_R = WS_HB + (size_t)T * 1024 * 2;
constexpr size_t R_GQK = WS_R, R_GA = R_GQK + 32 * MiB, R_GV = R_GA + 32 * MiB, R_GR = R_GV + 32 * MiB, R_HQ = R_GR + 32 * MiB, R_HA = R_HQ + 32 * MiB, R_HI = R_HA + 64 * MiB,
                 R_HG = R_HI + 32 * MiB, R_QLAT = R_HG + 32 * MiB  , R_KVLAT = R_QLAT + 32 * MiB, R_KROPE = R_KVLAT + 32 * MiB, R_Y = R_KROPE + 8 * MiB  ,
                 R_SG = R_Y + 128 * MiB, R_SH = R_SG + 8 * MiB, R_PG = R_SH + 16 * MiB, R_PH = R_PG + 1 * MiB, R_Q = R_PH + 1 * MiB  , R_KRH = R_Q + 96 * MiB, R_HK = R_KRH + 32 * MiB, R_END1 = R_HK + 32 * MiB;
constexpr size_t R_QRAW = WS_R, R_KVRAW = WS_R + 128 * MiB;
constexpr size_t R_KN = WS_R, R_V = WS_R + 64 * MiB;
constexpr size_t R_QCA = WS_R, R_OCA = WS_R + 64 * MiB;
constexpr size_t R_GH = WS_R, R_UH = WS_R + 16 * MiB, R_URAW = WS_R + 352 * MiB, R_END3 = R_URAW + 352 * MiB;
constexpr size_t WS_END = R_END3;
static_assert(R_END1 <= R_END3, "mixer window must fit the region");
static_assert(WS_END <= (size_t)1024 * MiB, "workspace map exceeds 1 GiB");

constexpr size_t LDS_STAGE = 131072, LDS_MISC = 163840 - 256, LDS_BYTES = 163840;


__device__ __forceinline__ void stat_dma(const float* tab, PG8_LAS float* st, const int pm, const int wid, const int lane) {
#pragma unroll
    for (int i = 0; i < 2; ++i)
        __builtin_amdgcn_global_load_lds((const unsigned*)(tab + ((size_t)pm * 256 + 32 * wid) * 16 + (i * 64 + lane) * 4), (PG8_LAS unsigned*)((PG8_LAS unsigned char*)st + wid * 2048 + i * 1024), 16, 0, 0);
}
__device__ __forceinline__ float rstd_from_lds(const PG8_LAS float* strow) {
    const f32x4 v = *(const PG8_LAS f32x4*)strow;
    float sq = (v[0] + v[1]) + (v[2] + v[3]); sq += __shfl_xor(sq, 16); sq += __shfl_xor(sq, 32);
    return __builtin_amdgcn_rsqf(sq * (1.0f / DM) + EPS);
}
__device__ __forceinline__ float rstd_from_part(const float* part, const size_t row, const int fq) {
    const f32x4 v = *(const f32x4*)(part + row * 16 + 4 * fq);
    float s = (v[0] + v[1]) + (v[2] + v[3]);
    s += __shfl_xor(s, 16); s += __shfl_xor(s, 32);
    return __builtin_amdgcn_rsqf(s * (1.0f / DM) + EPS);
}
struct EpiInProj {
    static constexpr bool PERM = true, AFTER_DRAIN = false;
    unsigned char* wsb;
    const float* bgate; const float* lb;
    PG8_LAS float* st;
    template <int MODE>
    __device__ __forceinline__ void run(const f32x4 (&acc)[2][2][4][2], const int row0, const int cw, const int wc, bf16_t* dst, const float sc, const int lslot, const PG8_LAS float* strow) const {
        const int fq = (cw >> 3) & 3;
#pragma unroll
        for (int ai = 0; ai < 2; ++ai)
#pragma unroll
            for (int m = 0; m < 4; ++m) {
                const size_t row = (size_t)(row0 + ai * 128 + m * 16);
                const float rs = rstd_from_lds(strow + (ai * 128 + m * 16) * 16);
                float lss = 0.f;
#pragma unroll
                for (int bj = 0; bj < 2; ++bj) {
                    f32x4 v0 = acc[ai][bj][m][0] * rs, v1 = acc[ai][bj][m][1] * rs;
                    const int c = bj * 128 + cw;
                    if constexpr (MODE == 0 || MODE == 4) { *(u32x4*)(dst + row * 256 + c) = pack8(v0, v1);
                        if constexpr (MODE == 4) lss += (v0[0] * v0[0] + v0[1] * v0[1]) + (v0[2] * v0[2] + v0[3] * v0[3]) + (v1[0] * v1[0] + v1[1] * v1[1]) + (v1[2] * v1[2] + v1[3] * v1[3]); }
                    else if constexpr (MODE == 1) {
                        f32x4 s0, s1; sigmoid_8(v0, v1, s0, s1);
                        v0 = v0 * s0 * sc; v1 = v1 * s1 * sc;
                        *(u32x4*)(dst + row * 256 + c) = pack8(v0, v1);
                    } else if constexpr (MODE == 2) {
                        const f32x4 l0 = *(const f32x4*)(lb + c), l1 = *(const f32x4*)(lb + c + 4);
                        f32x4 s0, s1; sigmoid_8(v0, v1, s0, s1);
                        f32x4 a0 = l0 + (1.0f - l0) * s0, a1 = l1 + (1.0f - l1) * s1;
                        const f32x4 k0 = 1.0f - a0, k1 = 1.0f - a1;
                        log2_8(a0, a1);
#pragma unroll
                        for (int j = 0; j < 4; ++j) { v0[j] = fminf(a0[j] * 0.6931471805599453f, 0.f); v1[j] = fminf(a1[j] * 0.6931471805599453f, 0.f); }
                        *(u32x4*)((bf16_t*)(wsb + R_HA) + row * 256 + c) = pack8h(v0, v1);
                        *(u32x4*)((bf16_t*)(wsb + R_HK) + row * 256 + c) = pack8(k0, k1);
                    } else {
                        if (bj == 0) {
                            const f32x4 b0 = *(const f32x4*)(bgate + cw), b1 = *(const f32x4*)(bgate + cw + 4);
                            const f32x4 z0 = v0 + b0, z1 = v1 + b1;
                            f32x4 t0, t1;
#pragma unroll
                            for (int j = 0; j < 4; ++j) { t0[j] = fabsf(z0[j]) * -1.4426950408889634f; t1[j] = fabsf(z1[j]) * -1.4426950408889634f; }
                            exp2_8(t0, t1); t0 = t0 + 1.0f; t1 = t1 + 1.0f; log2_8(t0, t1);
#pragma unroll
                            for (int j = 0; j < 4; ++j) { v0[j] = (fminf(z0[j], 0.f) - t0[j] * 0.6931471805599453f) * 0.0625f; v1[j] = (fminf(z1[j], 0.f) - t1[j] * 0.6931471805599453f) * 0.0625f; }
                            *(u32x4*)((bf16_t*)(wsb + R_GA) + row * 128 + cw) = pack8h(v0, v1);
                        } else if (wc < 2) {
                            *(u32x4*)((bf16_t*)(wsb + R_KROPE) + row * 64 + cw) = pack8(v0, v1);
                            float ks = (v0[0] * v0[0] + v0[1] * v0[1]) + (v0[2] * v0[2] + v0[3] * v0[3]) + (v1[0] * v1[0] + v1[1] * v1[1]) + (v1[2] * v1[2] + v1[3] * v1[3]);
                            ks += __shfl_xor(ks, 16); ks += __shfl_xor(ks, 32);
                            if (fq == 0) ((float*)(wsb + WS_LATP))[row * 16 + 8 + wc] = ks;
                        }
                    }
                }
                if constexpr (MODE == 4) { lss += __shfl_xor(lss, 16); lss += __shfl_xor(lss, 32); if (fq == 0) ((float*)(wsb + WS_LATP))[row * 16 + lslot + wc] = lss; }
            }
    }
    __device__ __forceinline__ void prefetch(const pg8::Unit& u, int wid, int lane) const { __builtin_amdgcn_s_barrier(); stat_dma((const float*)(wsb + WS_PART), st, u.pm, wid, lane); }
    __device__ __forceinline__ void operator()(const f32x4 (&acc)[2][2][4][2], const pg8::Unit& u, int wr, int wc, int fr, int fq) const {
        asm volatile("" : "+v"(fr), "+v"(fq));
        const int row0 = u.pm * 256 + wr * 64 + fr, cw = wc * 32 + 8 * fq, pn = u.pn;
        const PG8_LAS float* strow = st + (wr * 64 + fr) * 16 + 4 * fq;
        if (pn == 3) run<3>(acc, row0, cw, wc, nullptr, 1.f, 0, strow);
        else if (pn == 7) run<2>(acc, row0, cw, wc, nullptr, 1.f, 0, strow);
        else if (pn == 5 || pn == 6 || pn == 9) run<1>(acc, row0, cw, wc, (bf16_t*)(wsb + ((pn == 5) ? R_GR : ((pn == 9) ? R_HG : R_HQ))), (pn == 6) ? 0.125f : 1.0f, 0, strow);
        else if (pn < 2) run<4>(acc, row0, cw, wc, (bf16_t*)(wsb + ((pn == 0) ? R_QLAT : R_KVLAT)), 1.f, pn * 4, strow);
        else run<0>(acc, row0, cw, wc, (bf16_t*)(wsb + ((pn == 2) ? R_GQK : (pn == 4) ? R_GV : R_HI)), 1.f, 0, strow);
    }
};
template <bool PARTS>
struct EpiScaleBf16 {
    static constexpr bool PERM = true, AFTER_DRAIN = false;
    const float* rs; bf16_t* O; int ldc;
    PG8_LAS float* st;
    __device__ __forceinline__ void prefetch(const pg8::Unit& u, int wid, int lane) const { if constexpr (PARTS) { __builtin_amdgcn_s_barrier(); stat_dma(rs, st, u.pm, wid, lane); } }
    __device__ __forceinline__ void operator()(const f32x4 (&acc)[2][2][4][2], const pg8::Unit& u, int wr, int wc, int fr, int fq) const {
        asm volatile("" : "+v"(fr), "+v"(fq));
        const int row0 = u.pm * 256 + wr * 64 + fr, c0 = u.pn * 256 + wc * 32 + 8 * fq;
        const PG8_LAS float* strow = st + (wr * 64 + fr) * 16 + 4 * fq;
#pragma unroll
        for (int ai = 0; ai < 2; ++ai)
#pragma unroll
            for (int m = 0; m < 4; ++m) {
                const size_t row = (size_t)(row0 + ai * 128 + m * 16); const float s = PARTS ? rstd_from_lds(strow + (ai * 128 + m * 16) * 16) : rs[row];
#pragma unroll
                for (int bj = 0; bj < 2; ++bj) *(u32x4*)(O + row * ldc + c0 + bj * 128) = pack8(acc[ai][bj][m][0] * s, acc[ai][bj][m][1] * s);
            }
    }
};
struct EpiScaleF32 {
    static constexpr bool PERM = true, AFTER_DRAIN = false;
    const float* rs; float* O; int ldc;
    __device__ __forceinline__ void prefetch(const pg8::Unit&, int, int) const {}
    __device__ __forceinline__ void operator()(const f32x4 (&acc)[2][2][4][2], const pg8::Unit& u, int wr, int wc, int fr, int fq) const {
        asm volatile("" : "+v"(fr), "+v"(fq));
        const int row0 = u.pm * 256 + wr * 64 + fr, c0 = u.pn * 256 + wc * 32 + 8 * fq;
#pragma unroll
        for (int ai = 0; ai < 2; ++ai)
#pragma unroll
            for (int m = 0; m < 4; ++m) {
                const size_t row = (size_t)(row0 + ai * 128 + m * 16); const float s = rs[row];
#pragma unroll
                for (int bj = 0; bj < 2; ++bj) { float* p = O + row * ldc + c0 + bj * 128; *(f32x4*)p = acc[ai][bj][m][0] * s; *(f32x4*)(p + 4) = acc[ai][bj][m][1] * s; }
            }
    }
};
struct EpiResid {
    static constexpr bool PERM = true, AFTER_DRAIN = false;
    bf16_t* h16; bf16_t* h16o; float* out; float* parts; int last;
    __device__ __forceinline__ void prefetch(const pg8::Unit&, int, int) const {}
    __device__ __forceinline__ void operator()(const f32x4 (&acc)[2][2][4][2], const pg8::Unit& u, int wr, int wc, int fr, int fq) const {
        asm volatile("" : "+v"(fr), "+v"(fq));
        const int row0 = u.pm * 256 + wr * 64 + fr, c0 = u.pn * 256 + wc * 32 + 8 * fq;
#pragma unroll
        for (int ai = 0; ai < 2; ++ai) {
            u32x4 hw[4][2];
#pragma unroll
            for (int m = 0; m < 4; ++m)
#pragma unroll
                for (int bj = 0; bj < 2; ++bj) hw[m][bj] = *(const u32x4*)(h16 + (size_t)(row0 + ai * 128 + m * 16) * DM + c0 + bj * 128);
#pragma unroll
            for (int m = 0; m < 4; ++m) {
                const size_t row = (size_t)(row0 + ai * 128 + m * 16);
                float ss = 0.f;
#pragma unroll
                for (int bj = 0; bj < 2; ++bj) { const size_t o = row * DM + c0 + bj * 128;
                    const f32x2 a0 = unpk_f16(hw[m][bj].x), a1 = unpk_f16(hw[m][bj].y), a2 = unpk_f16(hw[m][bj].z), a3 = unpk_f16(hw[m][bj].w);
                    const f32x4 h0 = (f32x4){a0[0], a0[1], a1[0], a1[1]} + acc[ai][bj][m][0], h1 = (f32x4){a2[0], a2[1], a3[0], a3[1]} + acc[ai][bj][m][1];
                    if (last) { *(f32x4*)(out + o) = h0; *(f32x4*)(out + o + 4) = h1; }
                    else { *(u32x4*)(h16o + o) = pack8h(h0, h1);
                        ss += (h0[0] * h0[0] + h0[1] * h0[1]) + (h0[2] * h0[2] + h0[3] * h0[3]) + (h1[0] * h1[0] + h1[1] * h1[1]) + (h1[2] * h1[2] + h1[3] * h1[3]); } }
                if (!last) { ss += __shfl_xor(ss, 16); ss += __shfl_xor(ss, 32); if (fq == 0) parts[row * 16 + u.pn * 4 + wc] = ss; }
            }
        }
    }
};
struct EpiQUp {
    static constexpr bool PERM = true, AFTER_DRAIN = false;
    unsigned char* wsb; const float* qg; PG8_LAS float* sx; PG8_LAS float* st;
    __device__ __forceinline__ void prefetch(const pg8::Unit& u, int wid, int lane) const { __builtin_amdgcn_s_barrier(); stat_dma((const float*)(wsb + WS_LATP), st, u.pm, wid, lane); }
    __device__ __forceinline__ void operator()(const f32x4 (&acc)[2][2][4][2], const pg8::Unit& u, int wr, int wc, int fr, int fq) const {
        asm volatile("" : "+v"(fr), "+v"(fq));
        const int lrow0 = wr * 64 + fr, cw = wc * 32 + 8 * fq, h = u.pn, jb = 4 * (4 * wc + fq);
#pragma unroll
        for (int ai = 0; ai < 2; ++ai)
#pragma unroll
            for (int m = 0; m < 4; ++m) { const int lrow = lrow0 + ai * 128 + m * 16; const size_t row = (size_t)u.pm * 256 + lrow;
                const f32x4 lp = *(const PG8_LAS f32x4*)(st + lrow * 16);
                const float cl1 = __builtin_amdgcn_rsqf(((lp[0] + lp[1]) + (lp[2] + lp[3])) * (1.0f / 256.0f) + EPS);
                float ss = 0.f;
#pragma unroll
                for (int bj = 0; bj < 2; ++bj)
#pragma unroll
                    for (int n = 0; n < 2; ++n) { const f32x4 x = acc[ai][bj][m][n] * cl1; ss += (x[0] * x[0] + x[1] * x[1]) + (x[2] * x[2] + x[3] * x[3]); }
                ss += __shfl_xor(ss, 16); ss += __shfl_xor(ss, 32);
                if (fq == 0) sx[lrow * 4 + wc] = ss; }
        asm volatile("s_waitcnt lgkmcnt(0)" ::: "memory"); __builtin_amdgcn_s_barrier(); asm volatile("" ::: "memory");
        const f32x4 g0 = *(const f32x4*)(qg + cw), g1 = *(const f32x4*)(qg + cw + 4);
        f32x4 gr1 = {0.f, 0.f, 0.f, 0.f}, gr2 = {0.f, 0.f, 0.f, 0.f};
        if (wc < 2) { gr1 = *(const f32x4*)(qg + 128 + jb); gr2 = *(const f32x4*)(qg + 160 + jb); }
#pragma unroll
        for (int ai = 0; ai < 2; ++ai)
#pragma unroll
            for (int m = 0; m < 4; ++m) { const int lrow = lrow0 + ai * 128 + m * 16; const size_t row = (size_t)u.pm * 256 + lrow;
                const f32x4 t4 = *(const PG8_LAS f32x4*)(sx + lrow * 4);
                const f32x4 lp2 = *(const PG8_LAS f32x4*)(st + lrow * 16);
                const float cl2 = __builtin_amdgcn_rsqf(((lp2[0] + lp2[1]) + (lp2[2] + lp2[3])) * (1.0f / 256.0f) + EPS);
                const float sc = cl2 * __builtin_amdgcn_rsqf(((t4[0] + t4[1]) + (t4[2] + t4[3])) * (1.0f / 192.0f) + EPS);
                bf16_t* qrow = (bf16_t*)(wsb + R_Q) + (((size_t)(row >> 13) * 4 + h) * SEQ + (row & (SEQ - 1))) * 192;
                *(u32x4*)(qrow + cw) = pack8(acc[ai][0][m][0] * sc * g0, acc[ai][0][m][1] * sc * g1);
                if (wc < 2) {
                    const f32x4 x1 = acc[ai][1][m][0] * sc * gr1, x2 = acc[ai][1][m][1] * sc * gr2;
                    const f32x4 csa = *(const f32x4*)((const f32x2*)(wsb + WS_ROT) + row * 32 + jb), csb = *(const f32x4*)((const f32x2*)(wsb + WS_ROT) + row * 32 + jb + 2);
                    const float o10 = x1[0] * csa[0] - x2[0] * csa[1], o11 = x1[1] * csa[2] - x2[1] * csa[3], o12 = x1[2] * csb[0] - x2[2] * csb[1], o13 = x1[3] * csb[2] - x2[3] * csb[3];
                    const float o20 = x2[0] * csa[0] + x1[0] * csa[1], o21 = x2[1] * csa[2] + x1[1] * csa[3], o22 = x2[2] * csb[0] + x1[2] * csb[1], o23 = x2[3] * csb[2] + x1[3] * csb[3];
                    *(u32x2*)(qrow + 128 + jb) = (u32x2){cvt_pk_bf16(o10, o11), cvt_pk_bf16(o12, o13)};
                    *(u32x2*)(qrow + 160 + jb) = (u32x2){cvt_pk_bf16(o20, o21), cvt_pk_bf16(o22, o23)};
                } }
    }
};
struct EpiKVUp {
    static constexpr bool PERM = true, AFTER_DRAIN = false;
    unsigned char* wsb; const float* kg; PG8_LAS float* sx; PG8_LAS float* st;
    __device__ __forceinline__ void prefetch(const pg8::Unit& u, int wid, int lane) const { __builtin_amdgcn_s_barrier(); stat_dma((const float*)(wsb + WS_LATP), st, u.pm, wid, lane); }
    __device__ __forceinline__ void operator()(const f32x4 (&acc)[2][2][4][2], const pg8::Unit& u, int wr, int wc, int fr, int fq) const {
        asm volatile("" : "+v"(fr), "+v"(fq));
        const int lrow0 = wr * 64 + fr, cw = wc * 32 + 8 * fq, h = u.pn, j2 = 2 * (4 * wc + fq);
#pragma unroll
        for (int ai = 0; ai < 2; ++ai)
#pragma unroll
            for (int m = 0; m < 4; ++m) { const int lrow = lrow0 + ai * 128 + m * 16; const size_t row = (size_t)u.pm * 256 + lrow;
                const f32x4 lp = *(const PG8_LAS f32x4*)(st + lrow * 16 + 4);
                const float cl1 = __builtin_amdgcn_rsqf(((lp[0] + lp[1]) + (lp[2] + lp[3])) * (1.0f / 256.0f) + EPS);
                float ss = 0.f;
#pragma unroll
                for (int n = 0; n < 2; ++n) { const f32x4 x = acc[ai][0][m][n] * cl1; ss += (x[0] * x[0] + x[1] * x[1]) + (x[2] * x[2] + x[3] * x[3]); }
                ss += __shfl_xor(ss, 16); ss += __shfl_xor(ss, 32);
                if (fq == 0) sx[lrow * 4 + wc] = ss; }
        asm volatile("s_waitcnt lgkmcnt(0)" ::: "memory"); __builtin_amdgcn_s_barrier(); asm volatile("" ::: "memory");
        const f32x4 g0 = *(const f32x4*)(kg + cw), g1 = *(const f32x4*)(kg + cw + 4);
        const f32x2 gk1 = *(const f32x2*)(kg + 128 + j2), gk2 = *(const f32x2*)(kg + 160 + j2);
#pragma unroll
        for (int ai = 0; ai < 2; ++ai)
#pragma unroll
            for (int m = 0; m < 4; ++m) { const int lrow = lrow0 + ai * 128 + m * 16; const size_t row = (size_t)u.pm * 256 + lrow;
                const f32x4 t4 = *(const PG8_LAS f32x4*)(sx + lrow * 4);
                const f32x2 kr = *(const PG8_LAS f32x2*)(st + lrow * 16 + 8);
                const float rk = __builtin_amdgcn_rsqf((((t4[0] + t4[1]) + (t4[2] + t4[3])) + (kr[0] + kr[1])) * (1.0f / 192.0f) + EPS);
                const size_t bhs = ((size_t)(row >> 13) * 4 + h) * SEQ + (row & (SEQ - 1));
                const f32x4 lp2 = *(const PG8_LAS f32x4*)(st + lrow * 16 + 4);
                const float cl2 = __builtin_amdgcn_rsqf(((lp2[0] + lp2[1]) + (lp2[2] + lp2[3])) * (1.0f / 256.0f) + EPS);
                const float sc = cl2 * rk;
                *(u32x4*)((bf16_t*)(wsb + R_KN) + bhs * 128 + cw) = pack8(acc[ai][0][m][0] * sc * g0, acc[ai][0][m][1] * sc * g1);
                *(u32x4*)((bf16_t*)(wsb + R_V) + bhs * 128 + cw) = pack8(acc[ai][1][m][0] * cl2, acc[ai][1][m][1] * cl2);
                const unsigned x1w = *(const unsigned*)((const bf16_t*)(wsb + R_KROPE) + row * 64 + j2), x2w = *(const unsigned*)((const bf16_t*)(wsb + R_KROPE) + row * 64 + 32 + j2);
                const f32x4 cs = *(const f32x4*)((const f32x2*)(wsb + WS_ROT) + row * 32 + j2);
                const float a0 = bflo(x1w) * rk * gk1[0], a1 = bfhi(x1w) * rk * gk1[1], b0 = bflo(x2w) * rk * gk2[0], b1 = bfhi(x2w) * rk * gk2[1];
                *(unsigned*)((bf16_t*)(wsb + R_KRH) + bhs * 64 + j2) = cvt_pk_bf16(a0 * cs[0] - b0 * cs[1], a1 * cs[2] - b1 * cs[3]);
                *(unsigned*)((bf16_t*)(wsb + R_KRH) + bhs * 64 + 32 + j2) = cvt_pk_bf16(b0 * cs[0] + a0 * cs[1], b1 * cs[2] + a1 * cs[3]); }
    }
};

#define DPPU_(old, x, ctrl) ((unsigned)__builtin_amdgcn_update_dpp((int)(old), (int)(x), (ctrl), 0xf, 0xf, false))
__device__ __forceinline__ f16x2_t f2h2(float a, float b) { const f32x2 v = {a, b}; return __builtin_convertvector(v, f16x2_t); }
__device__ __forceinline__ f16x2_t silu_mul_h2(f16x2_t cv, f16x2_t up) {
    const f16x2_t nl = {(_Float16)-1.4426950408889634f, (_Float16)-1.4426950408889634f}, one = {(_Float16)1.0f, (_Float16)1.0f};
    const f16x2_t d = one + __builtin_elementwise_exp2(cv * nl);
    f16x2_t r; r.x = __builtin_amdgcn_rcph(d.x); r.y = __builtin_amdgcn_rcph(d.y);
    return cv * r * up;
}
#define TRANS_PK4(OP, r, x) asm(OP "_e32 %0, %4\n\t" OP "_e32 %1, %5\n\t" OP "_e32 %2, %6\n\t" OP "_e32 %3, %7\n\t" \
        OP "_sdwa %0, %4 dst_sel:WORD_1 dst_unused:UNUSED_PRESERVE src0_sel:WORD_1\n\t" OP "_sdwa %1, %5 dst_sel:WORD_1 dst_unused:UNUSED_PRESERVE src0_sel:WORD_1\n\t" \
        OP "_sdwa %2, %6 dst_sel:WORD_1 dst_unused:UNUSED_PRESERVE src0_sel:WORD_1\n\t" OP "_sdwa %3, %7 dst_sel:WORD_1 dst_unused:UNUSED_PRESERVE src0_sel:WORD_1\n\ts_nop 0" \
        : "=&v"(r[0]), "=&v"(r[1]), "=&v"(r[2]), "=&v"(r[3]) : "v"(x[0]), "v"(x[1]), "v"(x[2]), "v"(x[3]))
struct EpiGateUpConv {
    static constexpr bool PERM = true, AFTER_DRAIN = false;
    const float* parts; bf16_t* act; float* gh; float* uh;
    const float* cw_; const float* cb_;
    PG8_LAS float* hx;
    PG8_LAS float* st;
    __device__ __forceinline__ void prefetch(const pg8::Unit& u, int wid, int lane) const {
        stat_dma(parts, st, u.pm, wid, lane);
    }
    __device__ __forceinline__ void operator()(const f32x4 (&acc)[2][2][4][2], const pg8::Unit& u, int wr, int wc, int fr, int fq) const {
        asm volatile("" : "+v"(fr), "+v"(fq));
        const int row0 = u.pm * 256 + wr * 64 + fr, cw = wc * 32 + 8 * fq, c0 = u.pn * 128 + cw;
        f16x2_t w0p[4], w1p[4], w2p[4], bbp[4];
#pragma unroll
        for (int n = 0; n < 2; ++n) { const f32x4 a = *(const f32x4*)(cw_ + c0 + 4 * n), b = *(const f32x4*)(cw_ + D_FF + c0 + 4 * n), c = *(const f32x4*)(cw_ + 2 * D_FF + c0 + 4 * n), d = *(const f32x4*)(cb_ + c0 + 4 * n);
            w0p[2 * n] = f2h2(a[0], a[1]); w0p[2 * n + 1] = f2h2(a[2], a[3]); w1p[2 * n] = f2h2(b[0], b[1]); w1p[2 * n + 1] = f2h2(b[2], b[3]);
            w2p[2 * n] = f2h2(c[0], c[1]); w2p[2 * n + 1] = f2h2(c[2], c[3]); bbp[2 * n] = f2h2(d[0], d[1]); bbp[2 * n + 1] = f2h2(d[2], d[3]); }
        float rs[2][4];
#pragma unroll
        for (int ai = 0; ai < 2; ++ai)
#pragma unroll
            for (int m = 0; m < 4; ++m) { const f32x4 v = *(const PG8_LAS f32x4*)(st + (wr * 64 + fr + ai * 128 + m * 16) * 16 + 4 * fq);
                float sq = (v[0] + v[1]) + (v[2] + v[3]); sq += __shfl_xor(sq, 16); sq += __shfl_xor(sq, 32);
                rs[ai][m] = __builtin_amdgcn_rsqf(sq * (1.0f / DM) + EPS); }
        if (fr >= 14) {
#pragma unroll
            for (int ai = 0; ai < 2; ++ai)
#pragma unroll
                for (int n = 0; n < 2; ++n) { const f32x4 g = acc[ai][0][3][n] * rs[ai][3];
                    *(PG8_LAS f32x4*)(hx + ((ai * 2 + wr) * 2 + (fr - 14)) * 128 + cw + 4 * n) = g;
                    if (ai == 1 && wr == 1) *(f32x4*)(gh + ((size_t)u.pm * 4 + (fr - 14)) * D_FF + c0 + 4 * n) = g; }
        }
        if (wr == 0 && fr < 2) {
#pragma unroll
            for (int n = 0; n < 2; ++n) { *(f32x4*)(gh + ((size_t)u.pm * 4 + 2 + fr) * D_FF + c0 + 4 * n) = acc[0][0][0][n] * rs[0][0];
                                          *(f32x4*)(uh + ((size_t)u.pm * 2 + fr) * D_FF + c0 + 4 * n) = acc[0][1][0][n] * rs[0][0]; }
        }
        asm volatile("s_waitcnt lgkmcnt(0)" ::: "memory"); __builtin_amdgcn_s_barrier(); asm volatile("" ::: "memory");
#pragma unroll
        for (int ai = 0; ai < 2; ++ai) {
            const int pblk = ai * 2 + wr - 1;
            unsigned prv[4];
#pragma unroll
            for (int n = 0; n < 2; ++n) { const f32x4 pv4 = (pblk >= 0) ? *(const PG8_LAS f32x4*)(hx + (pblk * 2 + (fr & 1)) * 128 + cw + 4 * n) : (f32x4){0.f, 0.f, 0.f, 0.f};
                prv[2 * n] = __builtin_bit_cast(unsigned, f2h2(pv4[0], pv4[1])); prv[2 * n + 1] = __builtin_bit_cast(unsigned, f2h2(pv4[2], pv4[3])); }
#pragma unroll
            for (int m = 0; m < 4; ++m) {
                const size_t row = (size_t)(row0 + ai * 128 + m * 16);
                unsigned gg[4], upk[4], t1[4], t2[4], g1[4], g2[4], xe[4], ee[4], dd[4], rr[4], ow[4]; f16x2_t cv[4];
#pragma unroll
                for (int n = 0; n < 2; ++n) { const f32x4 g0 = acc[ai][0][m][n] * rs[ai][m], up = acc[ai][1][m][n] * rs[ai][m];
                    gg[2 * n] = __builtin_bit_cast(unsigned, f2h2(g0[0], g0[1])); gg[2 * n + 1] = __builtin_bit_cast(unsigned, f2h2(g0[2], g0[3]));
                    upk[2 * n] = __builtin_bit_cast(unsigned, f2h2(up[0], up[1])); upk[2 * n + 1] = __builtin_bit_cast(unsigned, f2h2(up[2], up[3])); }
                asm volatile("" : "+v"(gg[0]), "+v"(gg[1]), "+v"(gg[2]), "+v"(gg[3]), "+v"(prv[0]), "+v"(prv[1]), "+v"(prv[2]), "+v"(prv[3]));
                asm volatile("" : "=v"(t1[0]), "=v"(t1[1]), "=v"(t1[2]), "=v"(t1[3]), "=v"(t2[0]), "=v"(t2[1]), "=v"(t2[2]), "=v"(t2[3]));
#pragma unroll
                for (int q = 0; q < 4; ++q) t1[q] = DPPU_(t1[q], prv[q], 0x15F);
#pragma unroll
                for (int q = 0; q < 4; ++q) g1[q] = DPPU_(t1[q], gg[q], 0x111);
#pragma unroll
                for (int q = 0; q < 4; ++q) t2[q] = DPPU_(t2[q], prv[q], 0x15E);
#pragma unroll
                for (int q = 0; q < 4; ++q) g2[q] = DPPU_(t2[q], g1[q], 0x111);
                const f16x2_t nl = {(_Float16)-1.4426950408889634f, (_Float16)-1.4426950408889634f}, one = {(_Float16)1.0f, (_Float16)1.0f};
#pragma unroll
                for (int q = 0; q < 4; ++q) { cv[q] = bbp[q] + __builtin_bit_cast(f16x2_t, g2[q]) * w0p[q] + __builtin_bit_cast(f16x2_t, g1[q]) * w1p[q] + __builtin_bit_cast(f16x2_t, gg[q]) * w2p[q];
                    xe[q] = __builtin_bit_cast(unsigned, cv[q] * nl); }
                TRANS_PK4("v_exp_f16", ee, xe);
#pragma unroll
                for (int q = 0; q < 4; ++q) dd[q] = __builtin_bit_cast(unsigned, one + __builtin_bit_cast(f16x2_t, ee[q]));
                TRANS_PK4("v_rcp_f16", rr, dd);
#pragma unroll
                for (int q = 0; q < 4; ++q) { ow[q] = __builtin_bit_cast(unsigned, cv[q] * __builtin_bit_cast(f16x2_t, rr[q]) * __builtin_bit_cast(f16x2_t, upk[q])); prv[q] = gg[q]; }
                *(u32x4*)(act + row * D_FF + c0) = (u32x4){ow[0], ow[1], ow[2], ow[3]};
            }
        }
    }
};

namespace att {
constexpr int KVBLK = 64;
constexpr float THR = 8.f;
constexpr size_t SHM_V = 64 * 128 * 2, SHM_K = 64 * 128 * 2, SHM_KR = 64 * 64 * 2;
constexpr size_t OFF_V = 0, OFF_K = 2 * SHM_V, OFF_KR = OFF_K + 2 * SHM_K, OFF_WS = OFF_KR + 2 * SHM_KR, OFF_QR = OFF_WS + 8 * 64 * 4, SHM_ATTN = OFF_QR + 8 * 9216;
#define KSWZ(row, colB) ((row) * 256 + ((colB) ^ (((row) & 7) << 4)))
#define KRSWZ(row, colB) ((row) * 128 + ((colB) ^ ((((row) >> 1) & 7) << 4)))
#define SBAR() __builtin_amdgcn_sched_barrier(0)
__device__ __forceinline__ int crow(int r, int hi) { return (r & 3) + 8 * (r >> 2) + 4 * hi; }

__device__ __forceinline__ void partialSM(f32x16& p0, f32x16& p1, float& m_reg, float& mn, float& alpha, const float Cl, const bool masked) {
    float pmax = p0[0];
#pragma unroll
    for (int r = 1; r < 16; ++r) pmax = fmaxf(pmax, p0[r]);
#pragma unroll
    for (int r = 0; r < 16; ++r) pmax = fmaxf(pmax, p1[r]);
    { auto rr = __builtin_amdgcn_permlane32_swap(__float_as_uint(pmax), __float_as_uint(pmax), false, false);
      pmax = fmaxf(__uint_as_float(rr[0]), __uint_as_float(rr[1])); }
    pmax = masked ? -1e30f : pmax;
    if (__builtin_expect(__all((pmax - m_reg) * Cl <= THR * LOG2E), 1)) { mn = m_reg; alpha = 1.f; }
    else { mn = fmaxf(m_reg, pmax); alpha = __builtin_amdgcn_exp2f((m_reg - mn) * Cl); m_reg = mn; }
    const float mnC = -mn * Cl - (masked ? 1e30f : 0.f);
#pragma unroll
    for (int r = 0; r < 16; ++r) p0[r] = fmaf(p0[r], Cl, mnC);
#pragma unroll
    for (int r = 0; r < 16; ++r) p1[r] = fmaf(p1[r], Cl, mnC);
#pragma unroll
    for (int r = 0; r < 16; ++r) p0[r] = __builtin_amdgcn_exp2f(p0[r]);
}
__device__ __forceinline__ void finishSM(f32x16& p0, f32x16& p1, float alpha, float& l_reg, bf16x8& pa0, bf16x8& pa1, bf16x8& pa2, bf16x8& pa3) {
#pragma unroll
    for (int r = 0; r < 16; ++r) p1[r] = __builtin_amdgcn_exp2f(p1[r]);
    float ps = 0;
#pragma unroll
    for (int r = 0; r < 16; ++r) ps += p0[r];
#pragma unroll
    for (int r = 0; r < 16; ++r) ps += p1[r];
    { auto rr = __builtin_amdgcn_permlane32_swap(__float_as_uint(ps), __float_as_uint(ps), false, false);
      ps = __uint_as_float(rr[0]) + __uint_as_float(rr[1]); }
    l_reg = l_reg * alpha + ps;
#define PK4(P, BASE, OUT) do { unsigned a0 = cvt_pk_bf16(P[BASE + 0], P[BASE + 1]), a1 = cvt_pk_bf16(P[BASE + 2], P[BASE + 3]);   \
    unsigned b0 = cvt_pk_bf16(P[BASE + 4], P[BASE + 5]), b1 = cvt_pk_bf16(P[BASE + 6], P[BASE + 7]);                              \
    auto r0 = __builtin_amdgcn_permlane32_swap(a0, b0, false, false); auto r1 = __builtin_amdgcn_permlane32_swap(a1, b1, false, false); \
    u32x4 w = {r0[0], r1[0], r0[1], r1[1]}; OUT = *reinterpret_cast<bf16x8*>(&w); } while (0)
    PK4(p0, 0, pa0); PK4(p0, 8, pa1); PK4(p1, 0, pa2); PK4(p1, 8, pa3);
#undef PK4
}
template <int NQ, int NQREG>
__device__ __forceinline__ void qkt(f32x16& p0, f32x16& p1, const char* Ks, const char* Krs, const bf16x8* qr, const char* qrl, int r32, int hi) {
    p0 = f32x16{}; p1 = f32x16{};
#pragma unroll
    for (int d0 = 0; d0 < 8; ++d0) { const int cb = (d0 * 16 + hi * 8) * 2;
        bf16x8 b0 = *reinterpret_cast<const bf16x8*>(Ks + KSWZ(r32, cb));
        bf16x8 b1 = *reinterpret_cast<const bf16x8*>(Ks + KSWZ(32 + r32, cb));
        bf16x8 qf; if (d0 < NQREG) qf = qr[d0 < NQREG ? d0 : 0]; else qf = *reinterpret_cast<const bf16x8*>(qrl + (d0 - NQREG) * 1024);
        p0 = __builtin_amdgcn_mfma_f32_32x32x16_bf16(b0, qf, p0, 0, 0, 0);
        p1 = __builtin_amdgcn_mfma_f32_32x32x16_bf16(b1, qf, p1, 0, 0, 0); }
    if constexpr (NQ == 12) {
        SBAR();
#pragma unroll
        for (int d1 = 0; d1 < 4; ++d1) { const int cb = (d1 * 16 + hi * 8) * 2;
            bf16x8 b0 = *reinterpret_cast<const bf16x8*>(Krs + KRSWZ(r32, cb));
            bf16x8 b1 = *reinterpret_cast<const bf16x8*>(Krs + KRSWZ(32 + r32, cb));
            bf16x8 qf; if (8 + d1 < NQREG) qf = qr[8 + d1 < NQREG ? 8 + d1 : 0]; else qf = *reinterpret_cast<const bf16x8*>(qrl + (8 + d1 - NQREG) * 1024);
            p0 = __builtin_amdgcn_mfma_f32_32x32x16_bf16(b0, qf, p0, 0, 0, 0);
            p1 = __builtin_amdgcn_mfma_f32_32x32x16_bf16(b1, qf, p1, 0, 0, 0); }
    }
}
__device__ __forceinline__ int v_st(int k, int c) { const int kk = (k & ~0xC) | ((k & 4) << 1) | ((k & 8) >> 1); return ((kk >> 3) * 4 + (c >> 5)) * 512 + ((kk & 7) * 32 + (c & 31)) * 2; }
__device__ __forceinline__ int v_rd_base(int lane) { return ((lane & 3) << 3) | (((lane >> 2) & 3) << 6) | (((lane >> 4) & 1) << 5) | (((lane >> 5) & 1) << 8); }
constexpr int v_rd_off(int d0, int ks, int half) { return d0 * 512 + ks * 4096 + half * 2048; }
template <int OFF> __device__ __forceinline__ s16x4 tr_read(int vb) {
    s16x4 r; asm volatile("ds_read_b64_tr_b16 %0, %1 offset:%2" : "=&v"(r) : "v"(vb), "i"(OFF) : "memory"); return r;
}
template <int D0> __device__ __forceinline__ void pv_one(f32x16& od, int vb, bf16x8 pa0, bf16x8 pa1, bf16x8 pa2, bf16x8 pa3) {
    const s16x4 l0 = tr_read<v_rd_off(D0, 0, 0)>(vb), h0 = tr_read<v_rd_off(D0, 0, 1)>(vb), l1 = tr_read<v_rd_off(D0, 1, 0)>(vb), h1 = tr_read<v_rd_off(D0, 1, 1)>(vb);
    const s16x4 l2 = tr_read<v_rd_off(D0, 2, 0)>(vb), h2 = tr_read<v_rd_off(D0, 2, 1)>(vb), l3 = tr_read<v_rd_off(D0, 3, 0)>(vb), h3 = tr_read<v_rd_off(D0, 3, 1)>(vb);
    asm volatile("s_waitcnt lgkmcnt(0)" ::: "memory"); SBAR();
#define PK(L, H) (bf16x8){L[0], L[1], L[2], L[3], H[0], H[1], H[2], H[3]}
    od = __builtin_amdgcn_mfma_f32_32x32x16_bf16(pa0, PK(l0, h0), od, 0, 0, 0);
    od = __builtin_amdgcn_mfma_f32_32x32x16_bf16(pa1, PK(l1, h1), od, 0, 0, 0);
    od = __builtin_amdgcn_mfma_f32_32x32x16_bf16(pa2, PK(l2, h2), od, 0, 0, 0);
    od = __builtin_amdgcn_mfma_f32_32x32x16_bf16(pa3, PK(l3, h3), od, 0, 0, 0);
#undef PK
}
__device__ __forceinline__ void pv_d0(f32x16* o, int vb, bf16x8 pa0, bf16x8 pa1, bf16x8 pa2, bf16x8 pa3) {
    pv_one<0>(o[0], vb, pa0, pa1, pa2, pa3); pv_one<1>(o[1], vb, pa0, pa1, pa2, pa3); pv_one<2>(o[2], vb, pa0, pa1, pa2, pa3); pv_one<3>(o[3], vb, pa0, pa1, pa2, pa3);
}

template <int MODE, int SDEPTH>
__device__ __forceinline__ void attn_body(const bf16_t* Qb, const int ldq, const bf16_t* Kn, const bf16_t* Krp, const bf16_t* Vh,
                                          bf16_t* Ob, const int ldo, const int NT, const int last_tile, char* lds) {
    constexpr int NQ = (MODE == 0) ? 12 : 8;
    constexpr int NLD = (MODE == 0) ? 5 : 4;
    int tid = threadIdx.x; asm volatile("" : "+v"(tid));
    const int wid = tid >> 6, lane = tid & 63, r32 = lane & 31, hi = lane >> 5;
    char* V_lds = lds + OFF_V; char* K_lds = lds + OFF_K; char* Kr_lds = lds + OFF_KR;
    float* ws = (float*)(lds + OFF_WS) + wid * 64; float* li_l = ws; float* al_l = ws + 32;
    constexpr int NQREG = (MODE == 0) ? 8 : 8;
    float m_reg = -1e30f, l_reg = 0; f32x16 o[4] = {}; bf16x8 qr[NQREG];
    const bf16_t* Qw = Qb + (size_t)(wid * 32 + r32) * ldq + hi * 8;
#pragma unroll
    for (int d0 = 0; d0 < NQREG; ++d0) qr[d0] = *reinterpret_cast<const bf16x8*>(Qw + d0 * 16);
    char* qrl = lds + OFF_QR + wid * 9216 + lane * 16;
#pragma unroll
    for (int d1 = NQREG; d1 < NQ; ++d1) *reinterpret_cast<bf16x8*>(qrl + (d1 - NQREG) * 1024) = *reinterpret_cast<const bf16x8*>(Qw + d1 * 16);
    float Cl;
    if constexpr (MODE == 0) Cl = 0.07216878364870322f * LOG2E;
    else {
        float ss = 0.f;
#pragma unroll
        for (int d0 = 0; d0 < 8; ++d0)
#pragma unroll
            for (int j = 0; j < 8; ++j) { const float x = bf2f((unsigned short)qr[d0][j]); ss = fmaf(x, x, ss); }
        { auto rr = __builtin_amdgcn_permlane32_swap(__float_as_uint(ss), __float_as_uint(ss), false, false);
          ss = __uint_as_float(rr[0]) + __uint_as_float(rr[1]); }
        Cl = 0.08838834764831845f * LOG2E * __builtin_amdgcn_rsqf(ss * (1.0f / 128.0f) + EPS);
    }
    const int sr = tid >> 4, sc = (tid & 15) * 8, vst0 = v_st(sr, sc), vst1 = v_st(32 + sr, sc);
    const int krr = tid >> 3, krc = (tid & 7) * 8;
    const int vb0 = (int)(uintptr_t)V_lds + v_rd_base(lane);
    struct { bf16x8 vs0, vs1, ks0, ks1, kr; } sr_[SDEPTH];
#define SLOAD(i, k0) do { sr_[i].vs0 = *(const bf16x8*)(Vh + (size_t)((k0) + sr) * 128 + sc); sr_[i].vs1 = *(const bf16x8*)(Vh + (size_t)((k0) + 32 + sr) * 128 + sc); \
    sr_[i].ks0 = *(const bf16x8*)(Kn + (size_t)((k0) + sr) * 128 + sc); sr_[i].ks1 = *(const bf16x8*)(Kn + (size_t)((k0) + 32 + sr) * 128 + sc); \
    if constexpr (MODE == 0) sr_[i].kr = *(const bf16x8*)(Krp + (size_t)((k0) + krr) * 64 + krc); } while (0)
#define SWRITE(b, i) do { *(bf16x8*)(V_lds + (b) * SHM_V + vst0) = sr_[i].vs0;          \
    *(bf16x8*)(V_lds + (b) * SHM_V + vst1) = sr_[i].vs1; const int kc = sc * 2;               \
    *(bf16x8*)(K_lds + (b) * SHM_K + KSWZ(sr, kc)) = sr_[i].ks0;                       \
    *(bf16x8*)(K_lds + (b) * SHM_K + KSWZ(32 + sr, kc)) = sr_[i].ks1;                  \
    if constexpr (MODE == 0) *(bf16x8*)(Kr_lds + (b) * SHM_KR + KRSWZ(krr, krc * 2)) = sr_[i].kr; } while (0)
#define SWAIT() do { if constexpr (SDEPTH == 1) asm volatile("s_waitcnt vmcnt(0)" ::: "memory"); else if constexpr (NLD == 5) asm volatile("s_waitcnt vmcnt(5)" ::: "memory"); else asm volatile("s_waitcnt vmcnt(4)" ::: "memory"); } while (0)
#define RESC(a) do { if (__any((a) < 1.f)) { if (hi == 0) al_l[r32] = (a); asm volatile("s_waitcnt lgkmcnt(0)" ::: "memory"); \
    _Pragma("unroll") for (int d = 0; d < 4; ++d) _Pragma("unroll") for (int r = 0; r < 16; ++r) o[d][r] *= al_l[crow(r, hi)]; } } while (0)
    f32x16 pA0, pA1, pB0, pB1; float mnA, mnB, alA, alB; bf16x8 pa0, pa1, pa2, pa3;
    constexpr int SE = 0, SO = SDEPTH - 1;
    SLOAD(SE, 0); asm volatile("s_waitcnt vmcnt(0)" ::: "memory"); SWRITE(0, SE); __syncthreads();
    qkt<NQ, NQREG>(pA0, pA1, K_lds, Kr_lds, qr, qrl, r32, hi); partialSM(pA0, pA1, m_reg, mnA, alA, Cl, false);
    SLOAD(SO, KVBLK); if constexpr (SDEPTH == 2) { if (2 < NT) SLOAD(SE, 2 * KVBLK); }
    SWAIT(); SWRITE(1, SO); __syncthreads();
    for (int j = 1; j + 1 < NT; j += 2) {
        SBAR(); qkt<NQ, NQREG>(pB0, pB1, K_lds + SHM_K, Kr_lds + SHM_KR, qr, qrl, r32, hi);
        finishSM(pA0, pA1, alA, l_reg, pa0, pa1, pa2, pa3); SBAR();
        SLOAD(SO, (j + SDEPTH) * KVBLK); SBAR();
        pv_d0(o, vb0, pa0, pa1, pa2, pa3); partialSM(pB0, pB1, m_reg, mnB, alB, Cl, j > last_tile);
        __syncthreads(); SWAIT(); SWRITE(0, SE);
        RESC(alB); __syncthreads();
        SBAR(); qkt<NQ, NQREG>(pA0, pA1, K_lds, Kr_lds, qr, qrl, r32, hi);
        finishSM(pB0, pB1, alB, l_reg, pa0, pa1, pa2, pa3); SBAR();
        if (SDEPTH == 1 || j + 3 < NT) SLOAD(SE, (j + 1 + SDEPTH) * KVBLK); SBAR();
        pv_d0(o, vb0 + (int)SHM_V, pa0, pa1, pa2, pa3); partialSM(pA0, pA1, m_reg, mnA, alA, Cl, (j + 1) > last_tile);
        __syncthreads(); SWAIT(); SWRITE(1, SO);
        RESC(alA); __syncthreads();
    }
    SBAR(); qkt<NQ, NQREG>(pB0, pB1, K_lds + SHM_K, Kr_lds + SHM_KR, qr, qrl, r32, hi);
    finishSM(pA0, pA1, alA, l_reg, pa0, pa1, pa2, pa3); SBAR();
    pv_d0(o, vb0, pa0, pa1, pa2, pa3); partialSM(pB0, pB1, m_reg, mnB, alB, Cl, (NT - 1) > last_tile);
    __syncthreads(); RESC(alB);
    finishSM(pB0, pB1, alB, l_reg, pa0, pa1, pa2, pa3); SBAR();
    pv_d0(o, vb0 + (int)SHM_V, pa0, pa1, pa2, pa3);
    if (hi == 0) li_l[r32] = l_reg; asm volatile("s_waitcnt lgkmcnt(0)" ::: "memory");
    float rli[16];
#pragma unroll
    for (int r = 0; r < 16; ++r) rli[r] = __builtin_amdgcn_rcpf(li_l[crow(r, hi)]);
    bf16_t* Ow = Ob + (size_t)(wid * 32) * ldo;
#pragma unroll
    for (int r = 0; r < 16; ++r) { const int orow = crow(r, hi);
#pragma unroll
        for (int d0 = 0; d0 < 4; ++d0) Ow[(size_t)orow * ldo + d0 * 32 + r32] = f2bf(o[d0][r] * rli[r]); }
#undef SLOAD
#undef SWRITE
#undef SWAIT
#undef RESC
}

__device__ __forceinline__ void qkt12(f32x16& p0, f32x16& p1, const char* Ks, const char* Krs, const bf16x8* qr, int r32, int hi) {
    p0 = f32x16{}; p1 = f32x16{};
    const int x7 = (r32 & 7) << 4, xr = ((r32 >> 1) & 7) << 4;
    const int kb = (int)(uintptr_t)Ks + r32 * 256, krb = (int)(uintptr_t)Krs + r32 * 128;
    bf16x8 f0[2], f1[2];
#define QK_RD(slot, d) do { if ((d) < 8) { const int ad_ = kb + ((((d) * 32) + hi * 16) ^ x7); \
            asm volatile("ds_read_b128 %0, %1" : "=&v"(f0[slot]) : "v"(ad_) : "memory"); asm volatile("ds_read_b128 %0, %1 offset:8192" : "=&v"(f1[slot]) : "v"(ad_) : "memory"); } \
        else { const int ad_ = krb + (((((d) - 8) * 32) + hi * 16) ^ xr); \
            asm volatile("ds_read_b128 %0, %1" : "=&v"(f0[slot]) : "v"(ad_) : "memory"); asm volatile("ds_read_b128 %0, %1 offset:4096" : "=&v"(f1[slot]) : "v"(ad_) : "memory"); } } while (0)
    QK_RD(0, 0);
#pragma unroll
    for (int d = 0; d < 12; ++d) { const int sl = d & 1;
        if (d + 1 < 12) { QK_RD(sl ^ 1, d + 1); asm volatile("s_waitcnt lgkmcnt(2)" : "+v"(f0[sl]), "+v"(f1[sl]) :: "memory"); }
        else asm volatile("s_waitcnt lgkmcnt(0)" : "+v"(f0[sl]), "+v"(f1[sl]) :: "memory");
        p0 = __builtin_amdgcn_mfma_f32_32x32x16_bf16(f0[sl], qr[d], p0, 0, 0, 0);
        p1 = __builtin_amdgcn_mfma_f32_32x32x16_bf16(f1[sl], qr[d], p1, 0, 0, 0);
    }
#undef QK_RD
}

constexpr size_t D_OFF_V = 0, D_OFF_K = 3 * SHM_V, D_OFF_KR = D_OFF_K + 3 * SHM_K, D_OFF_WS = D_OFF_KR + 3 * SHM_KR, SHM_ATTN_DMA = D_OFF_WS + 8 * 64 * 4;
__device__ __forceinline__ void attn_body_dma(const bf16_t* Qb, const int ldq, const bf16_t* Kn, const bf16_t* Krp, const bf16_t* Vh,
                                              bf16_t* Ob, const int ldo, const int NT, const int last_tile, char* lds, LAS unsigned char* ldsl) {
    int tid = threadIdx.x; asm volatile("" : "+v"(tid));
    const int wid = __builtin_amdgcn_readfirstlane(tid >> 6), lane = tid & 63, r32 = lane & 31, hi = lane >> 5;
    char* K_lds = lds + D_OFF_K; char* Kr_lds = lds + D_OFF_KR;
    float* ws = (float*)(lds + D_OFF_WS) + wid * 64; float* li_l = ws; float* al_l = ws + 32;
    float m_reg = -1e30f, l_reg = 0; f32x16 o[4] = {}; bf16x8 qr[12];
    const bf16_t* Qw = Qb + (size_t)(wid * 32 + r32) * ldq + hi * 8;
#pragma unroll
    for (int d0 = 0; d0 < 12; ++d0) qr[d0] = *reinterpret_cast<const bf16x8*>(Qw + d0 * 16);
    const float Cl = 0.07216878364870322f * LOG2E;
    unsigned ko[2], vo[2], kro;
#pragma unroll
    for (int i = 0; i < 2; ++i) { const int sb = (i * 8 + wid) * 1024 + lane * 16;
        { const int row = sb >> 8, cb = (sb & 255) ^ ((row & 7) << 4); ko[i] = (unsigned)(row * 128 + (cb >> 1)); }
        { const int sub = sb >> 9, wi = sb & 511, kk = (sub >> 2) * 8 + (wi >> 6), c = (sub & 3) * 32 + ((wi & 63) >> 1), k = (kk & ~0xC) | ((kk & 4) << 1) | ((kk & 8) >> 1);
          vo[i] = (unsigned)(k * 128 + c); } }
    { const int sb = wid * 1024 + lane * 16; const int row = sb >> 7, cb = (sb & 127) ^ (((row >> 1) & 7) << 4); kro = (unsigned)(row * 64 + (cb >> 1)); }
    const int vbb = (int)(uintptr_t)(lds + D_OFF_V) + v_rd_base(lane);
#define ADMA(st, k0) do { _Pragma("unroll") for (int i_ = 0; i_ < 2; ++i_) { \
        __builtin_amdgcn_global_load_lds((const unsigned*)(Kn + (size_t)(k0) * 128 + ko[i_]), (LAS unsigned*)(ldsl + D_OFF_K + (st) * SHM_K + (i_ * 8 + wid) * 1024), 16, 0, 0); \
        __builtin_amdgcn_global_load_lds((const unsigned*)(Vh + (size_t)(k0) * 128 + vo[i_]), (LAS unsigned*)(ldsl + D_OFF_V + (st) * SHM_V + (i_ * 8 + wid) * 1024), 16, 0, 0); } \
        __builtin_amdgcn_global_load_lds((const unsigned*)(Krp + (size_t)(k0) * 64 + kro), (LAS unsigned*)(ldsl + D_OFF_KR + (st) * SHM_KR + wid * 1024), 16, 0, 0); } while (0)
#define AWAIT() asm volatile("s_waitcnt vmcnt(0)" ::: "memory")
#define RESC(a) do { if (__any((a) < 1.f)) { if (hi == 0) al_l[r32] = (a); asm volatile("s_waitcnt lgkmcnt(0)" ::: "memory"); \
    _Pragma("unroll") for (int d = 0; d < 4; ++d) _Pragma("unroll") for (int r = 0; r < 16; ++r) o[d][r] *= al_l[crow(r, hi)]; } } while (0)
    f32x16 pA0, pA1, pB0, pB1; float mnA, mnB, alA, alB; bf16x8 pa0, pa1, pa2, pa3;
    __syncthreads();
    ADMA(0, 0); ADMA(1, KVBLK);
    AWAIT(); __syncthreads();
    qkt12(pA0, pA1, K_lds, Kr_lds, qr, r32, hi); partialSM(pA0, pA1, m_reg, mnA, alA, Cl, false);
    int sa = 0, sb_ = 1, sc = 2;
#pragma unroll 1
    for (int j = 1; j + 1 < NT; j += 2) {
        ADMA(sc, (j + 1) * KVBLK);
        SBAR(); qkt12(pB0, pB1, K_lds + sb_ * SHM_K, Kr_lds + sb_ * SHM_KR, qr, r32, hi);
        finishSM(pA0, pA1, alA, l_reg, pa0, pa1, pa2, pa3); SBAR();
        pv_d0(o, vbb + sa * (int)SHM_V, pa0, pa1, pa2, pa3); partialSM(pB0, pB1, m_reg, mnB, alB, Cl, j > last_tile);
        RESC(alB); AWAIT(); __syncthreads();
        if (j + 2 < NT) ADMA(sa, (j + 2) * KVBLK);
        SBAR(); qkt12(pA0, pA1, K_lds + sc * SHM_K, Kr_lds + sc * SHM_KR, qr, r32, hi);
        finishSM(pB0, pB1, alB, l_reg, pa0, pa1, pa2, pa3); SBAR();
        pv_d0(o, vbb + sb_ * (int)SHM_V, pa0, pa1, pa2, pa3); partialSM(pA0, pA1, m_reg, mnA, alA, Cl, (j + 1) > last_tile);
        RESC(alA); AWAIT(); __syncthreads();
        const int t_ = sa; sa = sc; sc = sb_; sb_ = t_;
    }
    SBAR(); qkt12(pB0, pB1, K_lds + sb_ * SHM_K, Kr_lds + sb_ * SHM_KR, qr, r32, hi);
    finishSM(pA0, pA1, alA, l_reg, pa0, pa1, pa2, pa3); SBAR();
    pv_d0(o, vbb + sa * (int)SHM_V, pa0, pa1, pa2, pa3); partialSM(pB0, pB1, m_reg, mnB, alB, Cl, (NT - 1) > last_tile);
    RESC(alB);
    finishSM(pB0, pB1, alB, l_reg, pa0, pa1, pa2, pa3); SBAR();
    pv_d0(o, vbb + sb_ * (int)SHM_V, pa0, pa1, pa2, pa3);
    if (hi == 0) li_l[r32] = l_reg; asm volatile("s_waitcnt lgkmcnt(0)" ::: "memory");
    float rli[16];
#pragma unroll
    for (int r = 0; r < 16; ++r) rli[r] = __builtin_amdgcn_rcpf(li_l[crow(r, hi)]);
    bf16_t* Ow = Ob + (size_t)(wid * 32) * ldo;
#pragma unroll
    for (int r = 0; r < 16; ++r) { const int orow = crow(r, hi);
#pragma unroll
        for (int d0 = 0; d0 < 4; ++d0) Ow[(size_t)orow * ldo + d0 * 32 + r32] = f2bf(o[d0][r] * rli[r]); }
#undef ADMA
#undef AWAIT
#undef RESC
}
}

static_assert(att::SHM_ATTN <= LDS_MISC && att::SHM_ATTN_DMA <= LDS_MISC, "attention LDS");

struct Params {
    const float* in[29];
    float* out; unsigned char* ws;
    int ph_lo, ph_hi;
};

__device__ const double INVF[32] = {1.0, 0.7498942093324559, 0.5623413251903491, 0.4216965034285822, 0.31622776601683794, 0.23713737056616552, 0.1778279410038923, 0.1333521432163324, 0.1, 0.07498942093324558, 0.05623413251903491, 0.042169650342858224, 0.03162277660168379, 0.023713737056616554, 0.01778279410038923, 0.01333521432163324, 0.01, 0.007498942093324558, 0.005623413251903491, 0.004216965034285823, 0.0031622776601683794, 0.0023713737056616554, 0.0017782794100389228, 0.001333521432163324, 0.001, 0.0007498942093324559, 0.0005623413251903491, 0.00042169650342858224, 0.00031622776601683794, 0.00023713737056616554, 0.00017782794100389227, 0.0001333521432163324};

template <bool F16, class F>
__device__ __forceinline__ void build_bt(bf16_t* Bt0, const int N, const int K, const float* W0, const size_t wstride, const int ldw, const float* gain0, const int gstride, F srcmap,
                                         size_t& g, size_t& base, const size_t ngt) {
    const size_t per = (size_t)(N / 4) * (K / 8), total = per * DEPTH;
    for (; g < base + total; g += ngt) {
        const size_t b = g - base; const int l = (int)(b / per), r = (int)(b % per);
        const int n0 = (r % (N / 4)) * 4, k0 = (r / (N / 4)) * 8;
        float sc; const int src = srcmap(n0, sc);
        if (src == -2) continue;
        const float* W = W0 + (size_t)l * wstride;
        f32x4 v[8];
#pragma unroll
        for (int j = 0; j < 8; ++j) v[j] = (src >= 0) ? *(const f32x4*)(W + (size_t)(k0 + j) * ldw + src) : (f32x4){0.f, 0.f, 0.f, 0.f};
        if (gain0) {
#pragma unroll
            for (int j = 0; j < 8; ++j) v[j] *= gain0[(size_t)l * gstride + k0 + j] * sc;
        } else {
#pragma unroll
            for (int j = 0; j < 8; ++j) v[j] *= sc;
        }
        bf16_t* Bt = Bt0 + (size_t)l * W_LAYER + (size_t)n0 * K + k0;
#pragma unroll
        for (int e = 0; e < 4; ++e) {
            u32x4 w;
            if constexpr (F16) { w.x = cvt_pk_f16(v[0][e], v[1][e]); w.y = cvt_pk_f16(v[2][e], v[3][e]); w.z = cvt_pk_f16(v[4][e], v[5][e]); w.w = cvt_pk_f16(v[6][e], v[7][e]); }
            else { w.x = cvt_pk_bf16(v[0][e], v[1][e]); w.y = cvt_pk_bf16(v[2][e], v[3][e]); w.z = cvt_pk_bf16(v[4][e], v[5][e]); w.w = cvt_pk_bf16(v[6][e], v[7][e]); }
            *(u32x4*)(Bt + (size_t)e * K) = w;
        }
    }
    base += total;
}

__device__ __forceinline__ void sincos_d(double a, float& c, float& s) {
    const double k = __builtin_rint(a * 0.6366197723675814);
    double r = __builtin_fma(-k, 1.5707963267948966, a); r = __builtin_fma(-k, 6.123233995736766e-17, r);
    const double r2 = r * r;
    double sp = -7.647163731819816e-13; sp = sp * r2 + 1.6059043836821613e-10; sp = sp * r2 - 2.505210838544172e-08; sp = sp * r2 + 2.7557319223985893e-06;
    sp = sp * r2 - 1.984126984126984e-04; sp = sp * r2 + 8.333333333333333e-03; sp = sp * r2 - 1.6666666666666666e-01; sp = r + r * r2 * sp;
    double cp = 4.779477332387385e-14; cp = cp * r2 - 1.1470745597729725e-11; cp = cp * r2 + 2.08767569878681e-09; cp = cp * r2 - 2.755731922398589e-07;
    cp = cp * r2 + 2.48015873015873e-05; cp = cp * r2 - 1.388888888888889e-03; cp = cp * r2 + 4.1666666666666664e-02; cp = cp * r2 - 0.5; cp = 1.0 + r2 * cp;
    const int q = ((int)k) & 3;
    const double sv = (q == 0) ? sp : (q == 1) ? cp : (q == 2) ? -sp : -cp;
    const double cv = (q == 0) ? cp : (q == 1) ? -sp : (q == 2) ? -cp : sp;
    s = (float)sv; c = (float)cv;
}

constexpr int SEGL = 256, NSEG = SEQ / SEGL;

namespace scan {
typedef short bf16x4 __attribute__((ext_vector_type(4)));
constexpr int QT = 0, KT = 2048, KH = 4096, VT = 6144, DC = 8192, WREG = 8448;
template <int OFF> __device__ __forceinline__ bf16x4 trd(int addr) { bf16x4 r; asm volatile("ds_read_b64_tr_b16 %0, %1 offset:%2" : "=&v"(r) : "v"(addr), "i"(OFF) : "memory"); return r; }
__device__ __forceinline__ u32x4 pk8(const float* x) { u32x4 w; w.x = cvt_pk_bf16(x[0], x[1]); w.y = cvt_pk_bf16(x[2], x[3]); w.z = cvt_pk_bf16(x[4], x[5]); w.w = cvt_pk_bf16(x[6], x[7]); return w; }

template <int DK, bool OUT>
__device__ __forceinline__ void seg(const _Float16* la_base, const int la_stride, const bf16_t* q_base, const bf16_t* k_base, const bf16_t* v_base, const bf16_t* g_base,
                                    float* Sio, float* Pout, const float* gain, bf16_t* y_base, char* wl, const int lane_in) {
    constexpr int NM = DK / 16, NS = DK / 32;
    int lane = lane_in; asm volatile("" : "+v"(lane));
    const int l16 = lane & 15, g4 = lane >> 4, ch = lane & (DK - 1);
    const int wla = (int)(uintptr_t)wl;
    float* sbase = Sio + (4 * g4) * 64 + l16;
    f32x4 S[NM][4];
#pragma unroll
    for (int m = 0; m < NM; ++m)
#pragma unroll
        for (int n = 0; n < 4; ++n) {
            if constexpr (OUT) {
#pragma unroll
                for (int r = 0; r < 4; ++r) S[m][n][r] = sbase[(16 * m + r) * 64 + 16 * n];
            } else S[m][n] = (f32x4){0.f, 0.f, 0.f, 0.f};
        }
    float gn[4] = {1.f, 1.f, 1.f, 1.f};
    if constexpr (OUT) {
#pragma unroll
        for (int n = 0; n < 4; ++n) gn[n] = gain[16 * n + l16];
        asm volatile("s_waitcnt vmcnt(0)" ::: "memory");
    }
    float btot = 0.f;
    constexpr bool HALF = (DK == 32); constexpr int TT = HALF ? 8 : 16;
    const int hf = HALF ? (lane >> 5) : 0, tb = hf * 8;
    float la_n[TT]; unsigned short q_n[TT], k_n[TT], v_n[16];
#pragma unroll
    for (int t = 0; t < 16; ++t) v_n[t] = v_base[(size_t)t * 256 + lane];
#pragma unroll
    for (int t = 0; t < TT; ++t) { la_n[t] = (float)la_base[(size_t)(tb + t) * la_stride + ch]; k_n[t] = k_base[(size_t)(tb + t) * 256 + ch];
        if constexpr (OUT) q_n[t] = q_base[(size_t)(tb + t) * 256 + ch]; }
#pragma unroll 1
    for (int c = 0; c < SEGL / 16; ++c) {
        unsigned short gt16[4][4];
        if constexpr (OUT) {
#pragma unroll
            for (int r = 0; r < 4; ++r)
#pragma unroll
                for (int n = 0; n < 4; ++n) gt16[r][n] = g_base[((size_t)c * 16 + 4 * g4 + r) * 256 + 16 * n + l16];
        }
        unsigned qw[TT / 2], ktw[TT / 2], khw[TT / 2]; float bL;
        float pre = 0.f, post = 0.f, tot2 = 0.f;
        if constexpr (HALF) { float tot = 0.f;
#pragma unroll
            for (int t = 0; t < TT; ++t) tot += la_n[t];
            auto rr = __builtin_amdgcn_permlane32_swap(__float_as_uint(tot), __float_as_uint(tot), false, false);
            tot2 = __uint_as_float(rr[0]) + __uint_as_float(rr[1]);
            const float oth = tot2 - tot; pre = hf ? oth : 0.f; post = hf ? 0.f : oth; }
        if constexpr (OUT) { float b = pre;
#pragma unroll
            for (int tp = 0; tp < TT / 2; ++tp) {
                b += la_n[2 * tp]; const float e0 = b; b += la_n[2 * tp + 1]; const float e1 = b;
                qw[tp] = cvt_pk_bf16(bf2f(q_n[2 * tp]) * __expf(e0), bf2f(q_n[2 * tp + 1]) * __expf(e1));
                ktw[tp] = cvt_pk_bf16(bf2f(k_n[2 * tp]) * __expf(fminf(-e0, 80.f)), bf2f(k_n[2 * tp + 1]) * __expf(fminf(-e1, 80.f)));
            } }
        { float cs = post;
#pragma unroll
            for (int tp = TT / 2 - 1; tp >= 0; --tp) {
                const float h1 = bf2f(k_n[2 * tp + 1]) * __expf(cs); cs += la_n[2 * tp + 1];
                const float h0 = bf2f(k_n[2 * tp]) * __expf(cs); cs += la_n[2 * tp];
                khw[tp] = cvt_pk_bf16(h0, h1);
            }
            bL = HALF ? tot2 : cs; }
        btot += bL;
        u32x4 vv0, vv1;
        vv0.x = (unsigned)v_n[0] | ((unsigned)v_n[1] << 16); vv0.y = (unsigned)v_n[2] | ((unsigned)v_n[3] << 16); vv0.z = (unsigned)v_n[4] | ((unsigned)v_n[5] << 16); vv0.w = (unsigned)v_n[6] | ((unsigned)v_n[7] << 16);
        vv1.x = (unsigned)v_n[8] | ((unsigned)v_n[9] << 16); vv1.y = (unsigned)v_n[10] | ((unsigned)v_n[11] << 16); vv1.z = (unsigned)v_n[12] | ((unsigned)v_n[13] << 16); vv1.w = (unsigned)v_n[14] | ((unsigned)v_n[15] << 16);
        if (c + 1 < SEGL / 16) {
#pragma unroll
            for (int t = 0; t < 16; ++t) v_n[t] = v_base[((size_t)(c + 1) * 16 + t) * 256 + lane];
#pragma unroll
            for (int t = 0; t < TT; ++t) { const size_t tt = (size_t)(c + 1) * 16 + tb + t;
                la_n[t] = (float)la_base[tt * la_stride + ch]; k_n[t] = k_base[tt * 256 + ch];
                if constexpr (OUT) q_n[t] = q_base[tt * 256 + ch]; }
        }
        if constexpr (HALF) {
            *(u32x4*)(wl + KH + ch * 32 + hf * 16) = (u32x4){khw[0], khw[1], khw[2], khw[3]};
            if constexpr (OUT) { *(u32x4*)(wl + KT + ch * 32 + hf * 16) = (u32x4){ktw[0], ktw[1], ktw[2], ktw[3]}; *(u32x4*)(wl + QT + ch * 32 + hf * 16) = (u32x4){qw[0], qw[1], qw[2], qw[3]}; }
            if (lane < DK) *(float*)(wl + DC + ch * 4) = __expf(bL);
        } else if (lane < DK) {
            *(u32x4*)(wl + KH + ch * 32) = (u32x4){khw[0], khw[1], khw[2], khw[3]}; *(u32x4*)(wl + KH + ch * 32 + 16) = (u32x4){khw[4 % (TT / 2)], khw[5 % (TT / 2)], khw[6 % (TT / 2)], khw[7 % (TT / 2)]};
            if constexpr (OUT) { *(u32x4*)(wl + KT + ch * 32) = (u32x4){ktw[0], ktw[1], ktw[2], ktw[3]}; *(u32x4*)(wl + KT + ch * 32 + 16) = (u32x4){ktw[4 % (TT / 2)], ktw[5 % (TT / 2)], ktw[6 % (TT / 2)], ktw[7 % (TT / 2)]};
                                 *(u32x4*)(wl + QT + ch * 32) = (u32x4){qw[0], qw[1], qw[2], qw[3]}; *(u32x4*)(wl + QT + ch * 32 + 16) = (u32x4){qw[4 % (TT / 2)], qw[5 % (TT / 2)], qw[6 % (TT / 2)], qw[7 % (TT / 2)]}; }
            *(float*)(wl + DC + ch * 4) = __expf(bL);
        }
        *(u32x4*)(wl + VT + lane * 32) = vv0; *(u32x4*)(wl + VT + lane * 32 + 16) = vv1;
        asm volatile("s_waitcnt lgkmcnt(0)" ::: "memory");
        bf16x4 vf[4];
#pragma unroll
        for (int n = 0; n < 4; ++n) vf[n] = *(const bf16x4*)(wl + VT + (16 * n + l16) * 32 + g4 * 8);
        f32x4 O[4];
        if constexpr (OUT) {
            bf16x8 qf[NS], kf8[NS];
#pragma unroll
            for (int s2 = 0; s2 < NS; ++s2) {
                const int a0 = wla + (32 * s2 + 4 * g4) * 32 + l16 * 8;
                bf16x4 q0 = trd<QT>(a0), q1 = trd<QT + 512>(a0), k0 = trd<KT>(a0), k1 = trd<KT + 512>(a0);
                asm volatile("s_waitcnt lgkmcnt(0)" : "+v"(q0), "+v"(q1), "+v"(k0), "+v"(k1) :: "memory");
                qf[s2] = (bf16x8){q0[0], q0[1], q0[2], q0[3], q1[0], q1[1], q1[2], q1[3]};
                kf8[s2] = (bf16x8){k0[0], k0[1], k0[2], k0[3], k1[0], k1[1], k1[2], k1[3]};
            }
            __builtin_amdgcn_sched_barrier(0);
#pragma unroll
            for (int n = 0; n < 4; ++n) { O[n] = (f32x4){0.f, 0.f, 0.f, 0.f};
#pragma unroll
                for (int s2 = 0; s2 < NS; ++s2) {
                    u32x4 w; w.x = cvt_pk_bf16(S[2 * s2][n][0], S[2 * s2][n][1]); w.y = cvt_pk_bf16(S[2 * s2][n][2], S[2 * s2][n][3]);
                    w.z = cvt_pk_bf16(S[2 * s2 + 1][n][0], S[2 * s2 + 1][n][1]); w.w = cvt_pk_bf16(S[2 * s2 + 1][n][2], S[2 * s2 + 1][n][3]);
                    O[n] = __builtin_amdgcn_mfma_f32_16x16x32_bf16(qf[s2], *reinterpret_cast<bf16x8*>(&w), O[n], 0, 0, 0); } }
            f32x4 P = (f32x4){0.f, 0.f, 0.f, 0.f};
#pragma unroll
            for (int s2 = 0; s2 < NS; ++s2) P = __builtin_amdgcn_mfma_f32_16x16x32_bf16(kf8[s2], qf[s2], P, 0, 0, 0);
#pragma unroll
            for (int r = 0; r < 4; ++r) P[r] = (4 * g4 + r <= l16) ? P[r] : 0.f;
            u32x2 pw; pw.x = cvt_pk_bf16(P[0], P[1]); pw.y = cvt_pk_bf16(P[2], P[3]);
            const bf16x4 pf = *reinterpret_cast<bf16x4*>(&pw);
#pragma unroll
            for (int n = 0; n < 4; ++n) O[n] = __builtin_amdgcn_mfma_f32_16x16x16bf16_1k(pf, vf[n], O[n], 0, 0, 0);
        }
#pragma unroll
        for (int m = 0; m < NM; ++m) {
            const f32x4 dc = *(const f32x4*)(wl + DC + (16 * m + 4 * g4) * 4);
            const bf16x4 khf = *(const bf16x4*)(wl + KH + (16 * m + l16) * 32 + g4 * 8);
#pragma unroll
            for (int n = 0; n < 4; ++n) S[m][n] = __builtin_amdgcn_mfma_f32_16x16x16bf16_1k(khf, vf[n], S[m][n] * dc, 0, 0, 0);
        }
        if constexpr (OUT) {
            float ss[4];
#pragma unroll
            for (int r = 0; r < 4; ++r) { ss[r] = (O[0][r] * O[0][r] + O[1][r] * O[1][r]) + (O[2][r] * O[2][r] + O[3][r] * O[3][r]); ss[r] = sum16(ss[r]); }
#pragma unroll
            for (int r = 0; r < 4; ++r) { const float rs = __builtin_amdgcn_rsqf(ss[r] * (1.0f / 64.0f) + EPS); const size_t tt = (size_t)c * 16 + 4 * g4 + r;
#pragma unroll
                for (int n = 0; n < 4; ++n) { const float gt_ = bf2f(gt16[r][n]);
                    y_base[tt * 1024 + 16 * n + l16] = f2bf(O[n][r] * rs * gn[n] * gt_); } }
        }
    }
    if constexpr (!OUT) {
#pragma unroll
        for (int m = 0; m < NM; ++m)
#pragma unroll
            for (int n = 0; n < 4; ++n)
#pragma unroll
                for (int r = 0; r < 4; ++r) sbase[(16 * m + r) * 64 + 16 * n] = S[m][n][r];
        if (lane < DK) Pout[ch] = __expf(btot);
    }
}
}

__device__ __forceinline__ int opq(int i) { asm volatile("" : "+s"(i)); return i; }

constexpr int NPH = 18, NPRE = 3, NPHASES = NPRE + DEPTH * NPH;

template <int SEL>
__global__ void __launch_bounds__(NTHREADS, 2) mk_fwd(Params p) {
    extern __shared__ __attribute__((aligned(16))) unsigned char lds[];
    const int bx = blockIdx.x, G = gridDim.x;
    const size_t ngt = (size_t)G * NTHREADS;
    const int ngw = G * NWAVES;
    PG8_LAS unsigned char* glds = (PG8_LAS unsigned char*)lds;
#define PHASE_BEGIN \
    int tid = threadIdx.x; asm volatile("" : "+v"(tid)); \
    const int lane = tid & 63, wave = __builtin_amdgcn_readfirstlane(tid >> 6); \
    const size_t gt = (size_t)bx * NTHREADS + tid; const int gw = bx * NWAVES + wave; \
    size_t wsz_ = 0; asm volatile("" : "+s"(wsz_)); unsigned char* ws = p.ws + wsz_;     \
    (void)lane; (void)wave; (void)gt; (void)gw;
#define PIN(i) (p.in[opq(i)])
#if MK_FUSED
    volatile LAS unsigned* misc = (volatile LAS unsigned*)((LAS unsigned char*)lds + LDS_MISC);
    if (threadIdx.x < 4) misc[threadIdx.x] = 0u;
    __syncthreads();
    XcdBarrier bar = xcd_barrier_post((unsigned*)(p.ws + WS_CTL), misc);
#define GRID_BAR() xcd_barrier(bar)
#else
#define GRID_BAR() do { } while (0)
#endif
    const int lo = p.ph_lo, hi = p.ph_hi;
#define PHSEL(i) (SEL < 0 || (i) + 1 == SEL)
#define INR(k) (lo <= (k) && (k) < hi)
#define IN(k) (PHSEL(-1) && INR(k))
#define SEAM(k) do { if (INR(k) && INR((k) + 1)) { GRID_BAR(); if ((PROBE_MASK >> 29) & 1) GRID_BAR(); } } while (0)
#define INP(i) (PHSEL(i) && INR(pb + (i)))
#define SEAMP(i) SEAM(pb + (i))

#define x_in (PIN(0))
#define hout (p.out)
#define lbt ((float*)(ws + WS_LB))
#define rstd ((float*)(ws + WS_RSTD))
#define part ((float*)(ws + WS_PART))
#define latpb ((float*)(ws + WS_LATP))
#define cq ((float*)(ws + WS_CQ))
#define ckv ((float*)(ws + WS_CKV))
#define memrstd ((float*)(ws + WS_MEMRSTD))
#define memb ((bf16_t*)(ws + WS_MEMB))
#define kvraw_ca ((float*)(ws + WS_R))
#define kca ((bf16_t*)(ws + WS_KCA))
#define vca ((bf16_t*)(ws + WS_VCA))
#define rot ((f32x2*)(ws + WS_ROT))
#define wall ((bf16_t*)(ws + WS_W))
#define hb ((bf16_t*)(ws + WS_HB))
#define gqk ((bf16_t*)(ws + R_GQK))
#define gv ((bf16_t*)(ws + R_GV))
#define gr ((bf16_t*)(ws + R_GR))
#define hq ((bf16_t*)(ws + R_HQ))
#define hi_ ((bf16_t*)(ws + R_HI))
#define hg ((bf16_t*)(ws + R_HG))
#define hk ((bf16_t*)(ws + R_HK))
#define ga ((const _Float16*)(ws + R_GA))
#define ha ((const _Float16*)(ws + R_HA))
#define qlat ((bf16_t*)(ws + R_QLAT))
#define kvlat ((bf16_t*)(ws + R_KVLAT))
#define krope ((bf16_t*)(ws + R_KROPE))
#define ybuf ((bf16_t*)(ws + R_Y))
#define sg ((float*)(ws + R_SG))
#define sh ((float*)(ws + R_SH))
#define pg ((float*)(ws + R_PG))
#define ph ((float*)(ws + R_PH))
#define qb ((bf16_t*)(ws + R_Q))
#define krh ((bf16_t*)(ws + R_KRH))
#define qraw ((bf16_t*)(ws + R_QRAW))
#define kvraw ((bf16_t*)(ws + R_KVRAW))
#define kn ((bf16_t*)(ws + R_KN))
#define vb ((bf16_t*)(ws + R_V))
#define qca ((bf16_t*)(ws + R_QCA))
#define oca ((bf16_t*)(ws + R_OCA))
#define ghb ((float*)(ws + R_GH))
#define uhb ((float*)(ws + R_UH))
#define uraw ((bf16_t*)(ws + R_URAW))

#define NORM_PHASE(SRC) do {   \
        for (int r0 = gw * 4; r0 < T; r0 += ngw * 4) { \
            f32x4 v[4][4]; float s[4]; \
            _Pragma("unroll") for (int q = 0; q < 4; ++q) { const f32x4* xr = (const f32x4*)((SRC) + (size_t)(r0 + q) * DM) + lane; \
                _Pragma("unroll") for (int j = 0; j < 4; ++j) v[q][j] = xr[64 * j]; } \
            _Pragma("unroll") for (int q = 0; q < 4; ++q) { float a = 0.f; \
                _Pragma("unroll") for (int j = 0; j < 4; ++j) a += (v[q][j][0] * v[q][j][0] + v[q][j][1] * v[q][j][1]) + (v[q][j][2] * v[q][j][2] + v[q][j][3] * v[q][j][3]); \
                s[q] = wave_sum_dpp(a); } \
            _Pragma("unroll") for (int q = 0; q < 4; ++q) { \
                if (lane < 16) part[(size_t)(r0 + q) * 16 + lane] = (lane == 0) ? s[q] : 0.f; \
                u32x2* o8 = (u32x2*)(hb + (size_t)(r0 + q) * DM) + lane; \
                _Pragma("unroll") for (int j = 0; j < 4; ++j) o8[64 * j] = (u32x2){cvt_pk_f16(v[q][j][0], v[q][j][1]), cvt_pk_f16(v[q][j][2], v[q][j][3])}; } \
        } } while (0)
    if (IN(0)) { for (int rep0_ = 0; rep0_ < (((PROBE_MASK >> 30) & 1) ? 2 : 1); ++rep0_) {
        PHASE_BEGIN
        {
            size_t g = gt, base = 0;
            build_bt<true>(wall + W_IN, 2560, 1024, PIN(4), (size_t)DM * P_IN, P_IN, PIN(3), DM, [](int n, float& sc) -> int { sc = 1.f;
                if (n < 512) return n;
                if (n < 640) { sc = 0.17677669529663687f; return 576 + (n - 512); }
                if (n < 768) return 704 + (n - 640);
                if (n < 896) return -2;
                if (n < 960) return 512 + (n - 896);
                if (n < 1024) return -1;
                if (n < 1280) return 832 + (n - 1024);
                if (n < 1536) return 1104 + (n - 1280);
                return 1360 + (n - 1536); }, g, base, ngt);
            build_bt<false>(wall + W_Q, 1024, 256, PIN(6), (size_t)256 * 768, 768, PIN(5), 256, [](int n, float& sc) -> int { sc = 1.f; const int h = n >> 8, c = n & 255;
                if (c < 128) return h * 192 + c;
                if (c >= 192) return -1;
                const int cc = c - 128, jb = 4 * (4 * (cc >> 5) + ((cc >> 3) & 3)), i8 = cc & 7;
                return h * 192 + (i8 < 4 ? 128 + jb + i8 : 160 + jb + (i8 - 4)); }, g, base, ngt);
            build_bt<false>(wall + W_KV, 1024, 256, PIN(8), (size_t)256 * 1024, 1024, PIN(7), 256, [](int n, float& sc) -> int { sc = 1.f; return n; }, g, base, ngt);
            build_bt<false>(wall + W_MIX, 1024, 1024, PIN(16), (size_t)1024 * 1024, 1024, nullptr, 0, [](int n, float& sc) -> int { sc = 1.f; return n; }, g, base, ngt);
            build_bt<true>(wall + W_CAQ, 512, 1024, PIN(19), (size_t)1024 * 512, 512, PIN(17), DM, [](int n, float& sc) -> int { sc = 1.f; return n; }, g, base, ngt);
            build_bt<false>(wall + W_CAKV, 1024, 1024, PIN(20), (size_t)1024 * 1024, 1024, PIN(18), DM, [](int n, float& sc) -> int { sc = 1.f; return n; }, g, base, ngt);
            build_bt<false>(wall + W_CAO, 1024, 512, PIN(23), (size_t)512 * 1024, 1024, nullptr, 0, [](int n, float& sc) -> int { sc = 1.f; return n; }, g, base, ngt);
            build_bt<true>(wall + W_FFI, 5632, 1024, PIN(25), (size_t)1024 * 5632, 5632, PIN(24), DM, [](int n, float& sc) -> int { sc = 1.f; const int j = n >> 8, c = n & 255; return c < 128 ? 128 * j + c : 2816 + 128 * j + (c - 128); }, g, base, ngt);
            build_bt<true>(wall + W_FFO, 1024, 2816, PIN(28), (size_t)2816 * 1024, 1024, nullptr, 0, [](int n, float& sc) -> int { sc = 1.f; return n; }, g, base, ngt);
            for (size_t it = gt; it < (size_t)DEPTH * 128 * 128; it += ngt) {
                const int l = (int)(it >> 14), j = (int)(it & 127), k0 = (int)((it >> 7) & 127) * 8;
                const float* w_in = PIN(4) + (size_t)l * DM * P_IN; const float* wg = PIN(11) + (size_t)l * 16 * 128; const float* gain = PIN(3) + l * DM;
                float v[8];
#pragma unroll
                for (int e = 0; e < 8; ++e) { float s = 0.f;
#pragma unroll
                    for (int r = 0; r < 16; ++r) s = fmaf(w_in[(size_t)(k0 + e) * P_IN + 1088 + r], wg[r * 128 + j], s);
                    v[e] = s * gain[k0 + e]; }
                u32x4 w; w.x = cvt_pk_f16(v[0], v[1]); w.y = cvt_pk_f16(v[2], v[3]); w.z = cvt_pk_f16(v[4], v[5]); w.w = cvt_pk_f16(v[6], v[7]);
                *(u32x4*)(wall + (size_t)l * W_LAYER + W_IN + (size_t)(768 + j) * 1024 + k0) = w;
            }
        }
        for (size_t it = gt; it < (size_t)T * 32; it += ngt) {
            const int j = (int)(it & 31); const size_t t = it >> 5;
            const int pos = ((const int*)PIN(2))[t];
            float c, s; sincos_d((double)pos * INVF[j], c, s);
            rot[it] = (f32x2){c, s};
        }
        if (gt < 256) {
            const float* lg = PIN(14);
            const float a0 = lg[gt], a1 = lg[256 + gt], a2 = lg[512 + gt], a3 = lg[768 + gt];
            const float mx = fmaxf(fmaxf(a0, a1), fmaxf(a2, a3));
            const float e0 = expf(a0 - mx), e1 = expf(a1 - mx), e2 = expf(a2 - mx), e3 = expf(a3 - mx), inv = 1.0f / (e0 + e1 + e2 + e3);
            lbt[gt] = 0.f; lbt[256 + gt] = e1 * inv; lbt[512 + gt] = (e1 + e2) * inv; lbt[768 + gt] = (e1 + e2 + e3) * inv;
        }
        for (int r = gw; r < NB * NMEM; r += ngw) {
            const f32x4* xr = (const f32x4*)(PIN(1) + (size_t)r * DM) + lane;
            f32x4 v[4]; float s = 0.f;
#pragma unroll
            for (int j = 0; j < 4; ++j) { v[j] = xr[64 * j]; s += (v[j][0] * v[j][0] + v[j][1] * v[j][1]) + (v[j][2] * v[j][2] + v[j][3] * v[j][3]); }
            s = wave_sum(s);
            if (lane == 0) memrstd[r] = 1.0f / sqrtf(s * (1.0f / DM) + EPS);
            u32x2* o8 = (u32x2*)(memb + (size_t)r * DM) + lane;
#pragma unroll
            for (int j = 0; j < 4; ++j) o8[64 * j] = (u32x2){cvt_pk_bf16(v[j][0], v[j][1]), cvt_pk_bf16(v[j][2], v[j][3])};
        }
        NORM_PHASE(x_in);
    } }
    SEAM(0);
    if (IN(1)) { PHASE_BEGIN
#pragma unroll 1
        for (int l = 0; l < DEPTH; ++l) {
            pg8::Gemm g{memb, wall + (size_t)l * W_LAYER + W_CAKV, NB * NMEM, 1024, 1024}; pg8::StaticOrder S; S.init(NB * NMEM, 1024, G, (bx + G - 32 * l) % G);
            EpiScaleF32 E{memrstd, kvraw_ca + (size_t)l * 2048 * 1024, 1024};
            pg8::gemm_phase<EpiScaleF32, pg8::StaticOrder>(glds, g, S, E);
            __syncthreads();
        }
    }
    SEAM(1);
    if (IN(2)) { PHASE_BEGIN
#pragma unroll 1
        for (int l = 0; l < DEPTH; ++l) {
            const float* kvraw_l = kvraw_ca + (size_t)l * 2048 * 1024; bf16_t* kca_l = kca + (size_t)l * 2048 * 512; bf16_t* vca_l = vca + (size_t)l * 2048 * 512;

            const float* qg = PIN(21) + l * 128; const float* kg = PIN(22) + l * 128;
            const int h = lane >> 4, i = lane & 15;
            for (int r = gw; r < NB * NMEM; r += ngw) {
                const int b = r >> 8, m = r & 255;
                const float* src = kvraw_l + (size_t)r * 1024 + h * 256;
                const f32x4 k0 = *(const f32x4*)(src + 8 * i), k1 = *(const f32x4*)(src + 8 * i + 4), v0 = *(const f32x4*)(src + 128 + 8 * i), v1 = *(const f32x4*)(src + 128 + 8 * i + 4);
                float ss = (k0[0] * k0[0] + k0[1] * k0[1]) + (k0[2] * k0[2] + k0[3] * k0[3]) + (k1[0] * k1[0] + k1[1] * k1[1]) + (k1[2] * k1[2] + k1[3] * k1[3]);
                ss = sum16(ss);
                const float rs = 1.0f / sqrtf(ss * (1.0f / 128.0f) + EPS);
                const f32x4 g0 = *(const f32x4*)(kg + 8 * i) * *(const f32x4*)(qg + 8 * i), g1 = *(const f32x4*)(kg + 8 * i + 4) * *(const f32x4*)(qg + 8 * i + 4);
                const size_t o = ((size_t)(b * 4 + h) * NMEM + m) * 128 + 8 * i;
                *(u32x4*)(kca_l + o) = pack8(k0 * rs * g0, k1 * rs * g1);
                *(u32x4*)(vca_l + o) = pack8(v0, v1);
            }
        }
    }
    SEAM(2);

    for (int l = 0; l < DEPTH; ++l) {
        const int pb = NPRE + l * NPH;
#define wl (wall + (size_t)l * W_LAYER)
#define hsrc0 ((l == 0) ? x_in : (const float*)hout)


        if (INP(1)) { _Pragma("unroll 1") for (int rep_ = 0; rep_ < (((PROBE_MASK >> 1) & 1) ? 2 : 1); ++rep_) { PHASE_BEGIN
            int bxo = bx; asm volatile("" : "+s"(bxo));
            pg8::Gemm g{hb, wl + W_IN, T, 2560, 1024}; pg8::StaticOrderG1 S; S.init(T, 2560, G, bxo);
            EpiInProj E{ws, PIN(12) + l * 128, lbt + l * 256, (PG8_LAS float*)(glds + LDS_STAGE)};
            pg8::gemm_phase<EpiInProj, pg8::StaticOrderG1, true>(glds, g, S, E);
        } }
        SEAMP(1);

        if (INP(2)) { _Pragma("unroll 1") for (int rep_ = 0; rep_ < (((PROBE_MASK >> 2) & 1) ? 2 : 1); ++rep_) { PHASE_BEGIN
            for (int uu = bx; uu < 256; uu += G) {
                const int j = uu * 4 + (wave & 3), head = j & 3, seg = (j >> 2) & 31, b = j >> 7;
                const size_t t0 = (size_t)b * SEQ + (size_t)seg * SEGL; const int un = (b * 4 + head) * NSEG + seg;
                char* wlp = (char*)lds + wave * scan::WREG;
                if (wave < 4) scan::seg<32, false>(ga + t0 * 128 + head * 32, 128, nullptr, gqk + t0 * 256 + 128 + head * 32, gv + t0 * 256 + head * 64, nullptr, sg + (size_t)un * 2048, pg + (size_t)un * 32, nullptr, nullptr, wlp, lane);
                else          scan::seg<64, false>(ha + t0 * 256 + head * 64, 256, nullptr, hk + t0 * 256 + head * 64, hi_ + t0 * 256 + head * 64, nullptr, sh + (size_t)un * 4096, ph + (size_t)un * 64, nullptr, nullptr, wlp, lane);
            }
        } }
        SEAMP(2);

        if (INP(3)) { _Pragma("unroll 1") for (int rep_ = 0; rep_ < (((PROBE_MASK >> 3) & 1) ? 2 : 1); ++rep_) { PHASE_BEGIN
            for (size_t c = gt; c < (size_t)32 * 32 * 64; c += ngt) {
                const int bh = (int)(c >> 11), d = (int)(c >> 6) & 31, e = (int)c & 63;
                float* a0 = sg + (size_t)bh * NSEG * 2048 + d * 64 + e; const float* p0 = pg + (size_t)bh * NSEG * 32 + d;
                float sv[NSEG], pv[NSEG];
#pragma unroll
                for (int q = 0; q < NSEG; ++q) { sv[q] = a0[(size_t)q * 2048]; pv[q] = p0[q * 32]; }
                float carry = 0.f;
#pragma unroll
                for (int q = 0; q < NSEG; ++q) { const float tmp = sv[q]; a0[(size_t)q * 2048] = carry; carry = fmaf(pv[q], carry, tmp); }
            }
            for (size_t c = gt; c < (size_t)32 * 64 * 64; c += ngt) {
                const int bh = (int)(c >> 12), d = (int)(c >> 6) & 63, e = (int)c & 63;
                float* a0 = sh + (size_t)bh * NSEG * 4096 + d * 64 + e; const float* p0 = ph + (size_t)bh * NSEG * 64 + d;
                float sv[NSEG], pv[NSEG];
#pragma unroll
                for (int q = 0; q < NSEG; ++q) { sv[q] = a0[(size_t)q * 4096]; pv[q] = p0[q * 64]; }
                float carry = 0.f;
#pragma unroll
                for (int q = 0; q < NSEG; ++q) { const float tmp = sv[q]; a0[(size_t)q * 4096] = carry; carry = fmaf(pv[q], carry, tmp); }
            }
        } }
        SEAMP(3);

        if (INP(4)) { _Pragma("unroll 1") for (int rep_ = 0; rep_ < (((PROBE_MASK >> 4) & 1) ? 2 : 1); ++rep_) { PHASE_BEGIN
            for (int uu = bx; uu < 256; uu += G) {
                const int j = uu * 4 + (wave & 3), head = j & 3, seg = (j >> 2) & 31, b = j >> 7;
                const size_t t0 = (size_t)b * SEQ + (size_t)seg * SEGL; const int un = (b * 4 + head) * NSEG + seg;
                char* wlp = (char*)lds + wave * scan::WREG;
                if (wave < 4) scan::seg<32, true>(ga + t0 * 128 + head * 32, 128, gqk + t0 * 256 + head * 32, gqk + t0 * 256 + 128 + head * 32, gv + t0 * 256 + head * 64, gr + t0 * 256 + head * 64,
                                                  sg + (size_t)un * 2048, nullptr, PIN(13) + l * 64, ybuf + t0 * 1024 + 512 + head * 64, wlp, lane);
                else          scan::seg<64, true>(ha + t0 * 256 + head * 64, 256, hq + t0 * 256 + head * 64, hk + t0 * 256 + head * 64, hi_ + t0 * 256 + head * 64, hg + t0 * 256 + head * 64,
                                                  sh + (size_t)un * 4096, nullptr, PIN(15) + l * 64, ybuf + t0 * 1024 + 768 + head * 64, wlp, lane);
            }
        } }
        SEAMP(4);

        if (INP(5)) { _Pragma("unroll 1") for (int rep_ = 0; rep_ < (((PROBE_MASK >> 5) & 1) ? 2 : 1); ++rep_) { PHASE_BEGIN
            { int k256 = 256; asm volatile("" : "+s"(k256)); pg8::Gemm g{qlat, wl + W_Q, T, 1024, k256}; pg8::StaticOrder S; S.init(T, 1024, G, bx);
              EpiQUp E{ws, PIN(9) + l * 192, (PG8_LAS float*)(glds + LDS_STAGE), (PG8_LAS float*)(glds + LDS_STAGE + 4096)};
              pg8::gemm_phase<EpiQUp, pg8::StaticOrder>(glds, g, S, E); }
            __syncthreads();
            { int k256 = 256; asm volatile("" : "+s"(k256)); pg8::Gemm g{kvlat, wl + W_KV, T, 1024, k256}; pg8::StaticOrder S; S.init(T, 1024, G, bx);
              EpiKVUp E{ws, PIN(10) + l * 192, (PG8_LAS float*)(glds + LDS_STAGE), (PG8_LAS float*)(glds + LDS_STAGE + 4096)};
              pg8::gemm_phase<EpiKVUp, pg8::StaticOrder>(glds, g, S, E); }
        } }
        SEAMP(5);

        if (INP(7)) { _Pragma("unroll 1") for (int rep_ = 0; rep_ < (((PROBE_MASK >> 7) & 1) ? 2 : 1); ++rep_) { PHASE_BEGIN
#pragma unroll 1
            for (int uid = bx * 4; uid < 1024; uid += G * 4) {
            const int vbx = uid >> 2;
            const int bh = (vbx & 7) * 4 + ((vbx >> 3) & 3), gg = (vbx >> 5) & 7, b = bh >> 2, h = bh & 3;
#pragma unroll 1
            for (int ui = 0; ui < 3; ++ui) {
                const int qblk = (ui == 0) ? 31 - gg : (ui == 1) ? 16 + gg : 15 - gg;
                att::attn_body_dma(qb + ((size_t)bh * SEQ + (size_t)qblk * 256) * 192, 192, kn + (size_t)bh * SEQ * 128, krh + (size_t)bh * SEQ * 64, vb + (size_t)bh * SEQ * 128,
                                  ybuf + ((size_t)b * SEQ + (size_t)qblk * 256) * 1024 + h * 128, 1024, 4 * qblk + 4, 4 * qblk + (wave >> 1), (char*)lds, (LAS unsigned char*)lds);
            }
            }
            {
                volatile LAS int* slot = (volatile LAS int*)((LAS unsigned char*)lds + LDS_MISC + 128);
                int* ctr = (int*)(ws + WS_CTL + 16384 + l * 64);
#pragma unroll 1
                for (;;) {
                    __syncthreads();
                    if (tid == 0) *slot = atomicAdd(ctr, 1);
                    __syncthreads();
                    const int u = __builtin_amdgcn_readfirstlane(*slot);
                    if (u >= 256) break;
                    const int qblk = 7 - (u >> 5), bh = u & 31, b = bh >> 2, h = bh & 3;
                    att::attn_body_dma(qb + ((size_t)bh * SEQ + (size_t)qblk * 256) * 192, 192, kn + (size_t)bh * SEQ * 128, krh + (size_t)bh * SEQ * 64, vb + (size_t)bh * SEQ * 128,
                                      ybuf + ((size_t)b * SEQ + (size_t)qblk * 256) * 1024 + h * 128, 1024, 4 * qblk + 4, 4 * qblk + (wave >> 1), (char*)lds, (LAS unsigned char*)lds);
                }
            }
        } }
        SEAMP(7);

        if (INP(8)) { _Pragma("unroll 1") for (int rep_ = 0; rep_ < (((PROBE_MASK >> 8) & 1) ? 2 : 1); ++rep_) { PHASE_BEGIN
#pragma unroll 1
            for (int pm = bx; pm < T / 256; pm += G) {
                { pg8::Gemm g{ybuf, wl + W_MIX, T, 1024, 1024}; pg8::PanelOrder S{pm, 4}; EpiResid E{hb, hb, hout, part, 0};
                  pg8::gemm_phase<EpiResid, pg8::PanelOrder>(glds, g, S, E); }
                __syncthreads();
                { pg8::Gemm g{hb, wl + W_CAQ, T, 512, 1024}; pg8::PanelOrder S{pm, 2}; EpiScaleBf16<true> E{part, qca, 512, (PG8_LAS float*)(glds + LDS_STAGE)};
                  pg8::gemm_phase<EpiScaleBf16<true>, pg8::PanelOrder, true>(glds, g, S, E); }
                __syncthreads();
                { const int b = pm >> 5, qblk = pm & 31;
#pragma unroll 1
                  for (int h = 0; h < 4; ++h) { const int bh = b * 4 + h;
                      att::attn_body<1, 2>(qca + ((size_t)b * SEQ + (size_t)qblk * 256) * 512 + h * 128, 512, kca + (size_t)l * 2048 * 512 + (size_t)bh * NMEM * 128, nullptr, vca + (size_t)l * 2048 * 512 + (size_t)bh * NMEM * 128,
                                        oca + ((size_t)b * SEQ + (size_t)qblk * 256) * 512 + h * 128, 512, 4, 1 << 30, (char*)lds); } }
                __syncthreads();
                { pg8::Gemm g{oca, wl + W_CAO, T, 1024, 512}; pg8::PanelOrder S{pm, 4}; EpiResid E{hb, hb, hout, part, 0};
                  pg8::gemm_phase<EpiResid, pg8::PanelOrder>(glds, g, S, E); }
                __syncthreads();
            }
        } }
        SEAMP(8);

        if (false) { }

        if (INP(15)) { _Pragma("unroll 1") for (int rep_ = 0; rep_ < (((PROBE_MASK >> 15) & 1) ? 2 : 1); ++rep_) { PHASE_BEGIN
            pg8::Gemm g{hb, wl + W_FFI, T, 5632, 1024}; pg8::StaticOrder S; S.init(T, 5632, G, bx);
            EpiGateUpConv E{part, uraw, ghb, uhb, PIN(26) + (size_t)l * 3 * D_FF, PIN(27) + (size_t)l * D_FF, (PG8_LAS float*)(glds + LDS_STAGE), (PG8_LAS float*)(glds + LDS_STAGE + 4096)};
            pg8::gemm_phase<EpiGateUpConv, pg8::StaticOrder, true>(glds, g, S, E);
        } }
        SEAMP(15);

        if (INP(16)) { _Pragma("unroll 1") for (int rep_ = 0; rep_ < (((PROBE_MASK >> 16) & 1) ? 2 : 1); ++rep_) { PHASE_BEGIN
            const float* cw = PIN(26) + (size_t)l * 3 * D_FF; const float* cbias = PIN(27) + (size_t)l * D_FF;
            for (size_t it = gt; it < (size_t)256 * (D_FF / 8); it += ngt) {
                const int c = (int)(it % (D_FF / 8)) * 8, pm = (int)(it / (D_FF / 8));
                if ((pm & 31) == 0) continue;
                f32x4 gm2[2], gm1[2], g0[2], g1[2], w0[2], w1[2], w2[2], bb[2], u0[2], u1[2];
#pragma unroll
                for (int hh = 0; hh < 2; ++hh) { const int cc = c + 4 * hh;
                    gm2[hh] = *(const f32x4*)(ghb + ((size_t)(pm - 1) * 4 + 0) * D_FF + cc); gm1[hh] = *(const f32x4*)(ghb + ((size_t)(pm - 1) * 4 + 1) * D_FF + cc);
                    g0[hh] = *(const f32x4*)(ghb + ((size_t)pm * 4 + 2) * D_FF + cc); g1[hh] = *(const f32x4*)(ghb + ((size_t)pm * 4 + 3) * D_FF + cc);
                    u0[hh] = *(const f32x4*)(uhb + ((size_t)pm * 2) * D_FF + cc); u1[hh] = *(const f32x4*)(uhb + ((size_t)pm * 2 + 1) * D_FF + cc);
                    w0[hh] = *(const f32x4*)(cw + cc); w1[hh] = *(const f32x4*)(cw + D_FF + cc); w2[hh] = *(const f32x4*)(cw + 2 * D_FF + cc); bb[hh] = *(const f32x4*)(cbias + cc); }
                float o0[8], o1[8];
#pragma unroll
                for (int hh = 0; hh < 2; ++hh)
#pragma unroll
                    for (int e = 0; e < 4; ++e) {
                        const float c0v = bb[hh][e] + gm2[hh][e] * w0[hh][e] + gm1[hh][e] * w1[hh][e] + g0[hh][e] * w2[hh][e], c1v = bb[hh][e] + gm1[hh][e] * w0[hh][e] + g0[hh][e] * w1[hh][e] + g1[hh][e] * w2[hh][e];
                        o0[4 * hh + e] = fast_silu(c0v) * u0[hh][e]; o1[4 * hh + e] = fast_silu(c1v) * u1[hh][e]; }
                *(u32x4*)(uraw + ((size_t)pm * 256) * D_FF + c) = (u32x4){cvt_pk_f16(o0[0], o0[1]), cvt_pk_f16(o0[2], o0[3]), cvt_pk_f16(o0[4], o0[5]), cvt_pk_f16(o0[6], o0[7])};
                *(u32x4*)(uraw + ((size_t)pm * 256 + 1) * D_FF + c) = (u32x4){cvt_pk_f16(o1[0], o1[1]), cvt_pk_f16(o1[2], o1[3]), cvt_pk_f16(o1[4], o1[5]), cvt_pk_f16(o1[6], o1[7])};
            }
        } }
        SEAMP(16);

        if (INP(17)) { _Pragma("unroll 1") for (int rep_ = 0; rep_ < (((PROBE_MASK >> 17) & 1) ? 2 : 1); ++rep_) { PHASE_BEGIN
            pg8::Gemm g{uraw, wl + W_FFO, T, 1024, 2816}; pg8::StaticOrder S; S.init(T, 1024, G, bx); EpiResid E{hb, (((PROBE_MASK >> 17) & 1) && rep_ == 0) ? (bf16_t*)(ws + WS_R + 32 * MiB) : hb, hout, part, ((l == DEPTH - 1) && !(((PROBE_MASK >> 17) & 1) && rep_ == 0)) ? 1 : 0};
            pg8::gemm_phase<EpiResid, pg8::StaticOrder, true>(glds, g, S, E);
        } }
        SEAMP(17);
    }
#undef IN
#undef SEAM
#undef INP
#undef SEAMP
#undef INR
#undef PHSEL
#undef PHASE_BEGIN
#undef PIN
#undef x_in
#undef hout
#undef lbt
#undef rstd
#undef part
#undef latpb
#undef cq
#undef ckv
#undef memrstd
#undef memb
#undef kvraw_ca
#undef kca
#undef vca
#undef rot
#undef wall
#undef hb
#undef gqk
#undef gv
#undef gr
#undef hq
#undef hi_
#undef hg
#undef hk
#undef ga
#undef ha
#undef qlat
#undef kvlat
#undef krope
#undef ybuf
#undef sg
#undef sh
#undef pg
#undef ph
#undef qb
#undef krh
#undef qraw
#undef kvraw
#undef kn
#undef vb
#undef qca
#undef oca
#undef ghb
#undef uhb
#undef uraw
#undef wl
#undef hsrc0
}

typedef void (*kern_t)(Params);
extern "C" void kernel_launch(void* const* d_in, const int* in_sizes, int n_in, void* d_out, int out_size, void* d_ws, size_t ws_size, hipStream_t stream) {
#if MK_FUSED
    static const kern_t kt[1] = {mk_fwd<-1>};
    constexpr int NK = 1;
#else
    static const kern_t kt[19] = {mk_fwd<0>, mk_fwd<1>, mk_fwd<2>, mk_fwd<3>, mk_fwd<4>, mk_fwd<5>, mk_fwd<6>, mk_fwd<7>, mk_fwd<8>, mk_fwd<9>, mk_fwd<10>, mk_fwd<11>, mk_fwd<12>, mk_fwd<13>, mk_fwd<14>,
                                  mk_fwd<15>, mk_fwd<16>, mk_fwd<17>, mk_fwd<18>};
    constexpr int NK = 19;
#endif
    static int grid = 0;
    if (grid == 0) {
        if (n_in != 29 || out_size != T * DM || ws_size < WS_END) { fprintf(stderr, "kernel_launch: unexpected shapes (n_in %d out %d ws %zu need %zu)\n", n_in, out_size, ws_size, (size_t)WS_END); grid = -1; return; }
        int dev = 0, cus = 0, per_cu = 0;
        if (hipGetDevice(&dev) != hipSuccess || hipDeviceGetAttribute(&cus, hipDeviceAttributeMultiprocessorCount, dev) != hipSuccess) { grid = -1; return; }
        for (int i = 0; i < NK; ++i)
            if (hipFuncSetAttribute((const void*)kt[i], hipFuncAttributeMaxDynamicSharedMemorySize, (int)LDS_BYTES) != hipSuccess) { fprintf(stderr, "kernel_launch: hipFuncSetAttribute failed\n"); grid = -1; return; }
        if (hipOccupancyMaxActiveBlocksPerMultiprocessor(&per_cu, (const void*)kt[0], NTHREADS, LDS_BYTES) != hipSuccess || per_cu < 1) fprintf(stderr, "kernel_launch: occupancy query says %d\n", per_cu);
        (void)hipGetLastError();
        grid = cus;
    }
    if (grid < 0) return;
    (void)hipMemsetAsync((char*)d_ws + WS_CTL, 0, CTL_BYTES, stream);
    Params p{};
    for (int i = 0; i < 29; ++i) p.in[i] = (const float*)d_in[i];
    p.out = (float*)d_out; p.ws = (unsigned char*)d_ws;
#if MK_FUSED
    p.ph_lo = 0; p.ph_hi = NPHASES;
    hipLaunchKernelGGL(kt[0], dim3(grid), dim3(NTHREADS), LDS_BYTES, stream, p);
#else
    for (int k = 0; k < NPHASES; ++k) { p.ph_lo = k; p.ph_hi = k + 1; const int sel = (k < NPRE) ? 0 : ((k - NPRE) % NPH) + 1;
        hipLaunchKernelGGL(kt[sel], dim3(grid), dim3(NTHREADS), LDS_BYTES, stream, p); }
#endif
    const hipError_t le = hipPeekAtLastError();
    if (le != hipSuccess) fprintf(stderr, "kernel_launch: launch failed: %s\n", hipGetErrorName(le));
}
```

```cpp
#include <hip/hip_runtime.h>
#include <cstdio>
#include <cstdint>

#ifndef PROBE_MASK
#define PROBE_MASK 0
#endif
#ifndef MK_FUSED
#define MK_FUSED 1
#endif

#define LAS __attribute__((address_space(3)))
typedef unsigned short bf16_t;
typedef short bf16x8 __attribute__((ext_vector_type(8)));
typedef short s16x4 __attribute__((ext_vector_type(4)));
typedef float f32x2 __attribute__((ext_vector_type(2)));
typedef float f32x4 __attribute__((ext_vector_type(4)));
typedef float f32x16 __attribute__((ext_vector_type(16)));
typedef unsigned u32x2 __attribute__((ext_vector_type(2)));
typedef unsigned u32x4 __attribute__((ext_vector_type(4)));

constexpr int NB = 8, SEQ = 8192, DM = 1024, DEPTH = 4, T = NB * SEQ;
constexpr int NMEM = 256, P_IN = 2384, D_FF = 2816;
constexpr float EPS = 1e-6f, LOG2E = 1.4426950408889634f;
constexpr int NWAVES = 8, NTHREADS = 512;

typedef __bf16 bf16x2_t __attribute__((ext_vector_type(2)));
__device__ __forceinline__ unsigned cvt_pk_bf16(float lo, float hi) { const f32x2 v = {lo, hi}; return __builtin_bit_cast(unsigned, __builtin_convertvector(v, bf16x2_t)); }
__device__ __forceinline__ float bf2f(unsigned short b) { return __uint_as_float(((unsigned)b) << 16); }
__device__ __forceinline__ float bflo(unsigned w) { return __uint_as_float(w << 16); }
__device__ __forceinline__ float bfhi(unsigned w) { return __uint_as_float(w & 0xffff0000u); }
__device__ __forceinline__ bf16_t f2bf(float f) { return (bf16_t)(cvt_pk_bf16(f, 0.f) & 0xffffu); }
__device__ __forceinline__ float wave_sum(float v) {
#pragma unroll
    for (int o = 1; o < 64; o <<= 1) v += __shfl_xor(v, o);
    return v;
}

__device__ __forceinline__ float wave_sum_dpp(float v) {
#define DPPF(x, ctrl, rm, bc) __builtin_bit_cast(float, __builtin_amdgcn_update_dpp(0, __builtin_bit_cast(int, (x)), (ctrl), (rm), 0xf, (bc)))
    v += DPPF(v, 0x111, 0xf, true); v += DPPF(v, 0x112, 0xf, true); v += DPPF(v, 0x114, 0xf, true); v += DPPF(v, 0x118, 0xf, true);
    v += DPPF(v, 0x142, 0xa, false); v += DPPF(v, 0x143, 0xc, false);
#undef DPPF
    return __uint_as_float((unsigned)__builtin_amdgcn_readlane((int)__float_as_uint(v), 63));
}
__device__ __forceinline__ float sum16(float v) {
    v += __shfl_xor(v, 1); v += __shfl_xor(v, 2); v += __shfl_xor(v, 4); v += __shfl_xor(v, 8); return v;
}
__device__ __forceinline__ float fast_sigmoid(float x) { return __builtin_amdgcn_rcpf(1.0f + __expf(-x)); }
__device__ __forceinline__ float fast_silu(float x) { return x * fast_sigmoid(x); }
__device__ __forceinline__ void exp2_8(f32x4& a, f32x4& b) {
#pragma unroll
    for (int j = 0; j < 4; ++j) { a[j] = __builtin_amdgcn_exp2f(a[j]); b[j] = __builtin_amdgcn_exp2f(b[j]); } }
__device__ __forceinline__ void rcp_8(f32x4& a, f32x4& b) {
#pragma unroll
    for (int j = 0; j < 4; ++j) { a[j] = __builtin_amdgcn_rcpf(a[j]); b[j] = __builtin_amdgcn_rcpf(b[j]); } }
__device__ __forceinline__ void log2_8(f32x4& a, f32x4& b) {
#pragma unroll
    for (int j = 0; j < 4; ++j) { a[j] = __builtin_amdgcn_logf(a[j]); b[j] = __builtin_amdgcn_logf(b[j]); } }
__device__ __forceinline__ void sigmoid_8(const f32x4& x0, const f32x4& x1, f32x4& s0, f32x4& s1) {
    s0 = x0 * -1.4426950408889634f; s1 = x1 * -1.4426950408889634f; exp2_8(s0, s1); s0 = s0 + 1.0f; s1 = s1 + 1.0f; rcp_8(s0, s1); }
__device__ __forceinline__ u32x4 pack8(f32x4 a, f32x4 b) { u32x4 w; w.x = cvt_pk_bf16(a[0], a[1]); w.y = cvt_pk_bf16(a[2], a[3]); w.z = cvt_pk_bf16(b[0], b[1]); w.w = cvt_pk_bf16(b[2], b[3]); return w; }


typedef _Float16 f16x2_t __attribute__((ext_vector_type(2)));
typedef _Float16 f16x8_t __attribute__((ext_vector_type(8)));
__device__ __forceinline__ unsigned cvt_pk_f16(float lo, float hi) { const f32x2 v = {lo, hi}; return __builtin_bit_cast(unsigned, __builtin_convertvector(v, f16x2_t)); }
__device__ __forceinline__ u32x4 pack8h(f32x4 a, f32x4 b) { u32x4 w; w.x = cvt_pk_f16(a[0], a[1]); w.y = cvt_pk_f16(a[2], a[3]); w.z = cvt_pk_f16(b[0], b[1]); w.w = cvt_pk_f16(b[2], b[3]); return w; }
__device__ __forceinline__ f32x2 unpk_f16(unsigned w) { return __builtin_convertvector(__builtin_bit_cast(f16x2_t, w), f32x2); }

#define XB_TMO      128
#define XB_XCNT(j)  (256  + 64 * (j))
#define XB_XSUB(j)  (1280 + 64 * (j))
#define XB_XGEN(j)  (2304 + 64 * (j))
#define XB_TOP      3328
#define XB_TOPGEN   3392
#define XCD_BAR_WORDS 3456
#define XB_SPIN_CAP (1u << 20)

__device__ __forceinline__ unsigned xb_ld(unsigned* p)              { return __hip_atomic_load(p, __ATOMIC_RELAXED, __HIP_MEMORY_SCOPE_AGENT); }
__device__ __forceinline__ unsigned xb_add(unsigned* p, unsigned v) { return __hip_atomic_fetch_add(p, v, __ATOMIC_RELAXED, __HIP_MEMORY_SCOPE_AGENT); }
__device__ __forceinline__ unsigned xb_xcc_id() { return (unsigned)__builtin_amdgcn_s_getreg((3 << 11) | 20) & 0xFu; }
#define XB_SPIN(cond, bar) do { unsigned _sp = 0; while (cond) { __builtin_amdgcn_s_sleep(1); \
    if ((++_sp & 255u) == 0u) { if (xb_ld(&(bar)[XB_TMO])) break; if (_sp > XB_SPIN_CAP) { atomicAdd(&(bar)[XB_TMO], 1u); break; } } } } while (0)

struct XcdBarrier { unsigned* bar; unsigned x; volatile LAS unsigned* st; };

__device__ __forceinline__ XcdBarrier xcd_barrier_post(unsigned* bar, volatile LAS unsigned* st) {
    XcdBarrier b; b.bar = bar; b.x = xb_xcc_id(); b.st = st;
    if (threadIdx.x == 0) (void)xb_add(&bar[XB_XCNT(b.x)], 1u);
    return b;
}
__device__ __forceinline__ void xcd_barrier_complete(unsigned* bar, unsigned x, unsigned& nloc, unsigned& nx) {
    const unsigned G = gridDim.x * gridDim.y * gridDim.z;
    unsigned sum, cnt, mine, sp = 0u;
    for (;;) {
        sum = 0u; cnt = 0u; mine = 0u;
#pragma unroll
        for (unsigned j = 0; j < 16; ++j) { const unsigned c = xb_ld(&bar[XB_XCNT(j)]); sum += c; cnt += (c > 0u) ? 1u : 0u; mine = (j == x) ? c : mine; }
        if (sum == G) break;
        __builtin_amdgcn_s_sleep(1);
        if ((++sp & 255u) == 0u) { if (xb_ld(&bar[XB_TMO])) break; if (sp > XB_SPIN_CAP) { atomicAdd(&bar[XB_TMO], 1u); break; } }
    }
    nloc = mine > 0u ? mine : 1u; nx = cnt > 0u ? cnt : 1u;
}
__device__ __forceinline__ void xcd_barrier(const XcdBarrier& b) {
    asm volatile("s_waitcnt vmcnt(0)" ::: "memory");
    __syncthreads();
    if (threadIdx.x == 0) {
        unsigned* bar = b.bar;
        __builtin_amdgcn_s_waitcnt(0);
        unsigned nloc = b.st[0], nx = b.st[1];
        if (nloc == 0u) { xcd_barrier_complete(bar, b.x, nloc, nx); b.st[0] = nloc; b.st[1] = nx; }
        const unsigned old = xb_add(&bar[XB_XSUB(b.x)], 1u);
        const unsigned gen = old / nloc;
        if (old + 1u == (gen + 1u) * nloc) {
            __builtin_amdgcn_fence(__ATOMIC_RELEASE, "agent");
            asm volatile("s_waitcnt vmcnt(0)" ::: "memory");
            const unsigned og = xb_add(&bar[XB_TOP], 1u);
            const unsigned tg = og / nx;
            if (og + 1u == (tg + 1u) * nx) xb_add(&bar[XB_TOPGEN], 1u);
            else XB_SPIN(xb_ld(&bar[XB_TOPGEN]) == tg, bar);
            __builtin_amdgcn_fence(__ATOMIC_ACQUIRE, "agent");
            xb_add(&bar[XB_XGEN(b.x)], 1u);
            asm volatile("s_waitcnt vmcnt(0)" ::: "memory");
        } else {
            XB_SPIN(xb_ld(&bar[XB_XGEN(b.x)]) == gen, bar);
            __builtin_amdgcn_fence(__ATOMIC_ACQUIRE, "agent");
            asm volatile("s_waitcnt vmcnt(0)" ::: "memory");
        }
    }
    __syncthreads();
}

namespace pg8 {
#define PG8_LAS __attribute__((address_space(3)))
constexpr int BM = 256, BK = 64, HALF = 128, HTB = HALF * BK * 2, STAGE_BYTES = 8 * HTB, NXCD = 8, WGM = 8;
__host__ __device__ __forceinline__ int lds_byte(int r, int c) { const int st = (r >> 4) * 2 + (c >> 5), rr = r & 15, cc = c & 31, ob = rr * 64 + cc * 2; return st * 1024 + (ob ^ (((ob >> 9) & 1) << 5)); }
__host__ __device__ __forceinline__ void stage_rc(int b, int& R, int& C) { const int st = b / 1024, sb = b % 1024, swz = sb ^ (((sb >> 9) & 1) << 5); R = (st >> 1) * 16 + swz / 64; C = (st & 1) * 32 + (swz % 64) / 2; }
__host__ __device__ __forceinline__ int perm32(int rho) { const int n = rho >> 4, i = rho & 15; return 8 * (i >> 2) + 4 * n + (i & 3); }
struct Unit { int pm, pn; };
struct Gemm { const bf16_t* A; const bf16_t* Bt; int M, N, K; };
struct StaticOrder {
    int nM, nN, nwg, G, c;
    __host__ __device__ void init(int M, int N, int G_, int c_) { nM = M / BM; nN = N / BM; nwg = nM * nN; G = G_; c = c_; }
    __host__ __device__ bool next(int i, Unit& u) const {
        const long L = (long)i * G + c; if (L >= nwg) return false;
        int wgid = (int)L; { const int q = nwg / NXCD, r = nwg % NXCD, xcd = wgid % NXCD, off = wgid / NXCD; wgid = (xcd < r ? xcd * (q + 1) : r * (q + 1) + (xcd - r) * q) + off; }
        const int nig = WGM * nN, gid = wgid / nig, fm = gid * WGM, gsz = (nM - fm) < WGM ? (nM - fm) : WGM;
        u.pm = fm + ((wgid % nig) % gsz); u.pn = (wgid % nig) / gsz; return true;
    }
    __device__ __forceinline__ void a_ready(const Unit&) const {}
    __device__ __forceinline__ void done(const Unit&) const {}
};
struct StaticOrderG1 : StaticOrder {
    __device__ __forceinline__ bool next(int i, Unit& u) const {
        const bool r = StaticOrder::next(i, u);
        if (r) { const int q = u.pn; u.pn = (q == 3) ? 4 : (q == 4) ? 3 : (q == 8) ? 9 : (q == 9) ? 8 : q; }
        return r; }
};
struct PanelOrder {
    int pm, n;
    __device__ __forceinline__ bool next(int i, Unit& u) const { if (i >= n) return false; u.pm = pm; u.pn = i; return true; }
    __device__ __forceinline__ void a_ready(const Unit&) const {}
    __device__ __forceinline__ void done(const Unit&) const {}
};

template <class Epi, class Sched, bool F16 = false, bool ALIGN_EPI = true, bool SP2 = true>
__device__ __forceinline__ void gemm_phase(PG8_LAS unsigned char* lds, const Gemm g, const Sched& S, const Epi& E) {
    int tid = threadIdx.x; asm volatile("" : "+v"(tid));
    const int wid = __builtin_amdgcn_readfirstlane(tid >> 6), lane = tid & 63, wr = wid >> 2, wc = wid & 3, fr = lane & 15, fq = lane >> 4;
    const int K = g.K, nt = K / BK;
    unsigned voffA[2], voffB[2];
#pragma unroll
    for (int i = 0; i < 2; ++i) { int R, C; stage_rc(tid * 16 + i * 8192, R, C); const int Rb = Epi::PERM ? ((R & ~31) + perm32(R & 31)) : R;
        voffA[i] = (unsigned)(R * K + C) * 2u; voffB[i] = (unsigned)(Rb * K + C) * 2u; }
    const size_t kstep = (size_t)(BK * 2);
    const size_t hstep = (size_t)HALF * K * 2;
    const size_t tstep = 2 * hstep;
    const unsigned ldsw = (unsigned)wid * 1024u;
    const int aoff = lds_byte(wr * 64 + fr, fq * 8), boff = lds_byte(wc * 32 + fr, fq * 8);
#define PG8_SA(b, h) (((b) * 2 + (h)) * HTB)
#define PG8_SB(b, h) ((4 + (b) * 2 + (h)) * HTB)
#define PG8_STAGE(bufoff, gbase, voff) do { _Pragma("unroll") for (int _i = 0; _i < 2; ++_i) \
        __builtin_amdgcn_global_load_lds((const unsigned*)((const char*)(gbase) + (voff)[_i]), (PG8_LAS unsigned*)(lds + (bufoff) + ldsw + _i * 8192), 16, 0, 0); } while (0)
#define PG8_LDA(dst, b, h) do { _Pragma("unroll") for (int m = 0; m < 4; ++m) _Pragma("unroll") for (int k = 0; k < 2; ++k) dst[m][k] = *(const PG8_LAS bf16x8*)(lds + PG8_SA(b, h) + aoff + m * 2048 + k * 1024); } while (0)
#define PG8_LDB(dst, b, h) do { _Pragma("unroll") for (int n = 0; n < 2; ++n) _Pragma("unroll") for (int k = 0; k < 2; ++k) dst[n][k] = *(const PG8_LAS bf16x8*)(lds + PG8_SB(b, h) + boff + n * 2048 + k * 1024); } while (0)
#define PG8_MMA(ai, bj, At, Bt) do { __builtin_amdgcn_s_setprio(1); _Pragma("unroll") for (int m = 0; m < 4; ++m) _Pragma("unroll") for (int n = 0; n < 2; ++n) _Pragma("unroll") for (int k = 0; k < 2; ++k) \
        acc[ai][bj][m][n] = F16 ? __builtin_amdgcn_mfma_f32_16x16x32_f16(__builtin_bit_cast(f16x8_t, Bt[n][k]), __builtin_bit_cast(f16x8_t, At[m][k]), acc[ai][bj][m][n], 0, 0, 0) \
                                : __builtin_amdgcn_mfma_f32_16x16x32_bf16(Bt[n][k], At[m][k], acc[ai][bj][m][n], 0, 0, 0); __builtin_amdgcn_s_setprio(0); } while (0)
#define PG8_WAIT_V(n) asm volatile("s_waitcnt vmcnt(" #n ")" ::: "memory")
#define PG8_WAIT_L(n) asm volatile("s_waitcnt lgkmcnt(" #n ")" ::: "memory")
#define PG8_BAR __builtin_amdgcn_s_barrier()
#define PG8_SCHED __builtin_amdgcn_sched_barrier(0)
    Unit cur, nxt; int ui = 0;
    if (!S.next(0, cur)) return;
    f32x4 acc[2][2][4][2];
#pragma unroll
    for (int a = 0; a < 2; ++a)
#pragma unroll
        for (int b = 0; b < 2; ++b)
#pragma unroll
            for (int m = 0; m < 4; ++m)
#pragma unroll
                for (int n = 0; n < 2; ++n) acc[a][b][m][n] = (f32x4){0.f, 0.f, 0.f, 0.f};
    bf16x8 At[4][2], B0[2][2], B1[2][2];
    const char* cA = (const char*)g.A + (size_t)cur.pm * tstep; const char* cB = (const char*)g.Bt + (size_t)cur.pn * tstep;
    S.a_ready(cur);
    E.prefetch(cur, wid, lane);
    if constexpr (SP2) {
        PG8_STAGE(PG8_SB(0, 0), cB, voffB); PG8_STAGE(PG8_SB(0, 1), cB + hstep, voffB); PG8_STAGE(PG8_SA(0, 0), cA, voffA); PG8_STAGE(PG8_SA(0, 1), cA + hstep, voffA);
        if (wr == 1) PG8_BAR;
        PG8_WAIT_V(2); PG8_BAR;
        PG8_STAGE(PG8_SB(1, 0), cB + kstep, voffB); PG8_STAGE(PG8_SA(1, 0), cA + kstep, voffA); PG8_STAGE(PG8_SB(1, 1), cB + hstep + kstep, voffB);
        PG8_WAIT_V(6); PG8_BAR;
    } else {
        PG8_STAGE(PG8_SB(0, 0), cB, voffB); PG8_STAGE(PG8_SA(0, 0), cA, voffA); PG8_STAGE(PG8_SB(0, 1), cB + hstep, voffB); PG8_STAGE(PG8_SA(0, 1), cA + hstep, voffA);
        if (wr == 1) PG8_BAR;
        PG8_WAIT_V(4); PG8_BAR;
        PG8_STAGE(PG8_SB(1, 0), cB + kstep, voffB); PG8_STAGE(PG8_SA(1, 0), cA + kstep, voffA); PG8_STAGE(PG8_SB(1, 1), cB + hstep + kstep, voffB);
        PG8_WAIT_V(6); PG8_BAR;
    }
    for (;;) {
        const bool has_next = S.next(ui + 1, nxt);
        const char* nA = has_next ? (const char*)g.A + (size_t)nxt.pm * tstep : cA; const char* nB = has_next ? (const char*)g.Bt + (size_t)nxt.pn * tstep : cB;
        for (int t = 0; t < nt; t += 2) {
            const bool last = (t == nt - 2);
            const char* a1 = cA + (size_t)(t + 1) * kstep;
            const char* a2 = last ? nA : cA + (size_t)(t + 2) * kstep; const char* b2 = last ? nB : cB + (size_t)(t + 2) * kstep;
            const char* a3 = a2 + kstep; const char* b3 = b2 + kstep;
            if (last && has_next) S.a_ready(nxt);
            if constexpr (SP2) {
            PG8_LDB(B0, 0, 0); PG8_LDB(B1, 0, 1); PG8_SCHED; PG8_LDA(At, 0, 0); PG8_STAGE(PG8_SA(1, 1), a1 + hstep, voffA);
            PG8_WAIT_V(8); PG8_WAIT_L(0); PG8_BAR; PG8_MMA(0, 0, At, B0); PG8_MMA(0, 1, At, B1); PG8_BAR; PG8_SCHED;
            PG8_LDA(At, 0, 1); PG8_STAGE(PG8_SB(0, 0), b2, voffB); PG8_STAGE(PG8_SB(0, 1), b2 + hstep, voffB); PG8_STAGE(PG8_SA(0, 0), a2, voffA);
            PG8_WAIT_V(8); PG8_WAIT_L(0); PG8_BAR; PG8_MMA(1, 0, At, B0); PG8_MMA(1, 1, At, B1); PG8_BAR; PG8_SCHED;
            PG8_LDB(B0, 1, 0); PG8_LDB(B1, 1, 1); PG8_SCHED; PG8_LDA(At, 1, 0); PG8_STAGE(PG8_SA(0, 1), a2 + hstep, voffA);
            PG8_WAIT_V(8); PG8_WAIT_L(0); PG8_BAR; PG8_MMA(0, 0, At, B0); PG8_MMA(0, 1, At, B1); PG8_BAR; PG8_SCHED;
            PG8_LDA(At, 1, 1); PG8_STAGE(PG8_SB(1, 0), b3, voffB); PG8_STAGE(PG8_SB(1, 1), b3 + hstep, voffB); PG8_STAGE(PG8_SA(1, 0), a3, voffA);
            PG8_WAIT_V(8); PG8_WAIT_L(0); PG8_BAR; PG8_MMA(1, 0, At, B0); PG8_MMA(1, 1, At, B1); PG8_BAR; PG8_SCHED;
            } else {
            PG8_LDB(B0, 0, 0); PG8_SCHED; PG8_LDA(At, 0, 0); PG8_STAGE(PG8_SA(1, 1), a1 + hstep, voffA);
            PG8_WAIT_L(8); PG8_BAR; PG8_WAIT_L(0); PG8_MMA(0, 0, At, B0); PG8_BAR; PG8_SCHED;
            PG8_LDB(B1, 0, 1); PG8_STAGE(PG8_SB(0, 0), b2, voffB);
            PG8_BAR; PG8_WAIT_L(0); PG8_MMA(0, 1, At, B1); PG8_BAR;
            PG8_LDA(At, 0, 1); PG8_STAGE(PG8_SA(0, 0), a2, voffA);
            PG8_BAR; PG8_WAIT_L(0); PG8_MMA(1, 0, At, B0); PG8_BAR; PG8_SCHED;
            PG8_STAGE(PG8_SB(0, 1), b2 + hstep, voffB);
            PG8_WAIT_V(6); PG8_BAR; PG8_MMA(1, 1, At, B1); PG8_BAR;
            PG8_LDB(B0, 1, 0); PG8_SCHED; PG8_LDA(At, 1, 0); PG8_STAGE(PG8_SA(0, 1), a2 + hstep, voffA);
            PG8_WAIT_L(8); PG8_BAR; PG8_WAIT_L(0); PG8_MMA(0, 0, At, B0); PG8_BAR; PG8_SCHED;
            PG8_LDB(B1, 1, 1); PG8_STAGE(PG8_SB(1, 0), b3, voffB);
            PG8_BAR; PG8_WAIT_L(0); PG8_MMA(0, 1, At, B1); PG8_BAR;
            PG8_LDA(At, 1, 1); PG8_STAGE(PG8_SA(1, 0), a3, voffA);
            PG8_BAR; PG8_WAIT_L(0); PG8_MMA(1, 0, At, B0); PG8_BAR; PG8_SCHED;
            PG8_STAGE(PG8_SB(1, 1), b3 + hstep, voffB);
            PG8_WAIT_V(6); PG8_BAR; PG8_MMA(1, 1, At, B1); PG8_BAR;
            }
        }
        if constexpr (ALIGN_EPI) { if (wr == 0) PG8_BAR; }
        E(acc, cur, wr, wc, fr, fq);
        if (!has_next) break;
        E.prefetch(nxt, wid, lane);
#pragma unroll
        for (int a = 0; a < 2; ++a)
#pragma unroll
            for (int b = 0; b < 2; ++b)
#pragma unroll
                for (int m = 0; m < 4; ++m)
#pragma unroll
                    for (int n = 0; n < 2; ++n) acc[a][b][m][n] = (f32x4){0.f, 0.f, 0.f, 0.f};
        cur = nxt; cA = nA; cB = nB; ++ui;
        if constexpr (ALIGN_EPI) { if (wr == 1) PG8_BAR; }
    }
    PG8_WAIT_V(0);
    if constexpr (!ALIGN_EPI) { if (wr == 0) PG8_BAR; }
    PG8_BAR;
#undef PG8_SA
#undef PG8_SB
#undef PG8_STAGE
#undef PG8_LDA
#undef PG8_LDB
#undef PG8_MMA
#undef PG8_WAIT_V
#undef PG8_WAIT_L
#undef PG8_BAR
#undef PG8_SCHED
}
}


constexpr size_t MiB = 1024 * 1024;
constexpr size_t al256(size_t x) { return (x + 255) / 256 * 256; }
constexpr size_t W_IN = 0, W_Q = W_IN + (size_t)2560 * 1024, W_KV = W_Q + (size_t)1024 * 256, W_MIX = W_KV + (size_t)1024 * 256, W_CAQ = W_MIX + (size_t)1024 * 1024,
                 W_CAKV = W_CAQ + (size_t)512 * 1024, W_CAO = W_CAKV + (size_t)1024 * 1024, W_FFI = W_CAO + (size_t)1024 * 512, W_FFO = W_FFI + (size_t)5632 * 1024,
                 W_LAYER = W_FFO + (size_t)1024 * 2816;
constexpr size_t WS_CTL = 0, CTL_BYTES = 65536;
constexpr size_t WS_LB = WS_CTL + CTL_BYTES;
constexpr size_t WS_RSTD = WS_LB + 4096;
constexpr size_t WS_CQ = WS_RSTD + (size_t)T * 4, WS_CKV = WS_CQ + (size_t)T * 4;
constexpr size_t WS_MEMRSTD = WS_CKV + (size_t)T * 4;
constexpr size_t WS_MEMB = WS_MEMRSTD + 8192;
constexpr size_t WS_KVRAW = WS_MEMB + (size_t)2048 * 1024 * 2;
constexpr size_t WS_KCA = WS_KVRAW + (size_t)2048 * 1024 * 4;
constexpr size_t WS_VCA = WS_KCA + (size_t)4 * 2048 * 512 * 2;
constexpr size_t WS_ROT = WS_VCA + (size_t)4 * 2048 * 512 * 2;
constexpr size_t WS_PART = WS_ROT + (size_t)T * 32 * 8;
constexpr size_t WS_LATP = WS_PART + (size_t)T * 16 * 4;
constexpr size_t WS_W = WS_LATP + (size_t)T * 16 * 4;
constexpr size_t WS_HB = al256(WS_W + 4 * W_LAYER * 2);
constexpr size_t WS_R = WS_HB + (size_t)T * 1024 * 2;
constexpr size_t R_GQK = WS_R, R_GA = R_GQK + 32 * MiB, R_GV = R_GA + 32 * MiB, R_GR = R_GV + 32 * MiB, R_HQ = R_GR + 32 * MiB, R_HA = R_HQ + 32 * MiB, R_HI = R_HA + 64 * MiB,
                 R_HG = R_HI + 32 * MiB, R_QLAT = R_HG + 32 * MiB  , R_KVLAT = R_QLAT + 32 * MiB, R_KROPE = R_KVLAT + 32 * MiB, R_Y = R_KROPE + 8 * MiB  ,
                 R_SG = R_Y + 128 * MiB, R_SH = R_SG + 8 * MiB, R_PG = R_SH + 16 * MiB, R_PH = R_PG + 1 * MiB, R_Q = R_PH + 1 * MiB  , R_KRH = R_Q + 96 * MiB, R_HK = R_KRH + 32 * MiB, R_END1 = R_HK + 32 * MiB;
constexpr size_t R_QRAW = WS_R, R_KVRAW = WS_R + 128 * MiB;
constexpr size_t R_KN = WS_R, R_V = WS_R + 64 * MiB;
constexpr size_t R_QCA = WS_R, R_OCA = WS_R + 64 * MiB;
constexpr size_t R_GH = WS_R, R_UH = WS_R + 16 * MiB, R_URAW = WS_R + 352 * MiB, R_END3 = R_URAW + 352 * MiB;
constexpr size_t WS_END = R_END3;
static_assert(R_END1 <= R_END3, "mixer window must fit the region");
static_assert(WS_END <= (size_t)1024 * MiB, "workspace map exceeds 1 GiB");

constexpr size_t LDS_STAGE = 131072, LDS_MISC = 163840 - 256, LDS_BYTES = 163840;


__device__ __forceinline__ void stat_dma(const float* tab, PG8_LAS float* st, const int pm, const int wid, const int lane) {
#pragma unroll
    for (int i = 0; i < 2; ++i)
        __builtin_amdgcn_global_load_lds((const unsigned*)(tab + ((size_t)pm * 256 + 32 * wid) * 16 + (i * 64 + lane) * 4), (PG8_LAS unsigned*)((PG8_LAS unsigned char*)st + wid * 2048 + i * 1024), 16, 0, 0);
}
__device__ __forceinline__ float rstd_from_lds(const PG8_LAS float* strow) {
    const f32x4 v = *(const PG8_LAS f32x4*)strow;
    float sq = (v[0] + v[1]) + (v[2] + v[3]); sq += __shfl_xor(sq, 16); sq += __shfl_xor(sq, 32);
    return __builtin_amdgcn_rsqf(sq * (1.0f / DM) + EPS);
}
__device__ __forceinline__ float rstd_from_part(const float* part, const size_t row, const int fq) {
    const f32x4 v = *(const f32x4*)(part + row * 16 + 4 * fq);
    float s = (v[0] + v[1]) + (v[2] + v[3]);
    s += __shfl_xor(s, 16); s += __shfl_xor(s, 32);
    return __builtin_amdgcn_rsqf(s * (1.0f / DM) + EPS);
}
struct EpiInProj {
    static constexpr bool PERM = true, AFTER_DRAIN = false;
    unsigned char* wsb;
    const float* bgate; const float* lb;
    PG8_LAS float* st;
    template <int MODE>
    __device__ __forceinline__ void run(const f32x4 (&acc)[2][2][4][2], const int row0, const int cw, const int wc, bf16_t* dst, const float sc, const int lslot, const PG8_LAS float* strow) const {
        const int fq = (cw >> 3) & 3;
#pragma unroll
        for (int ai = 0; ai < 2; ++ai)
#pragma unroll
            for (int m = 0; m < 4; ++m) {
                const size_t row = (size_t)(row0 + ai * 128 + m * 16);
                const float rs = rstd_from_lds(strow + (ai * 128 + m * 16) * 16);
                float lss = 0.f;
#pragma unroll
                for (int bj = 0; bj < 2; ++bj) {
                    f32x4 v0 = acc[ai][bj][m][0] * rs, v1 = acc[ai][bj][m][1] * rs;
                    const int c = bj * 128 + cw;
                    if constexpr (MODE == 0 || MODE == 4) { *(u32x4*)(dst + row * 256 + c) = pack8(v0, v1);
                        if constexpr (MODE == 4) lss += (v0[0] * v0[0] + v0[1] * v0[1]) + (v0[2] * v0[2] + v0[3] * v0[3]) + (v1[0] * v1[0] + v1[1] * v1[1]) + (v1[2] * v1[2] + v1[3] * v1[3]); }
                    else if constexpr (MODE == 1) {
                        f32x4 s0, s1; sigmoid_8(v0, v1, s0, s1);
                        v0 = v0 * s0 * sc; v1 = v1 * s1 * sc;
                        *(u32x4*)(dst + row * 256 + c) = pack8(v0, v1);
                    } else if constexpr (MODE == 2) {
                        const f32x4 l0 = *(const f32x4*)(lb + c), l1 = *(const f32x4*)(lb + c + 4);
                        f32x4 s0, s1; sigmoid_8(v0, v1, s0, s1);
                        f32x4 a0 = l0 + (1.0f - l0) * s0, a1 = l1 + (1.0f - l1) * s1;
                        const f32x4 k0 = 1.0f - a0, k1 = 1.0f - a1;
                        log2_8(a0, a1);
#pragma unroll
                        for (int j = 0; j < 4; ++j) { v0[j] = fminf(a0[j], 0.f); v1[j] = fminf(a1[j], 0.f); }
                        *(u32x4*)((bf16_t*)(wsb + R_HA) + row * 256 + c) = pack8h(v0, v1);
                        *(u32x4*)((bf16_t*)(wsb + R_HK) + row * 256 + c) = pack8(k0, k1);
                    } else {
                        if (bj == 0) {
                            const f32x4 b0 = *(const f32x4*)(bgate + cw), b1 = *(const f32x4*)(bgate + cw + 4);
                            const f32x4 z0 = v0 + b0, z1 = v1 + b1;
                            f32x4 t0, t1;
#pragma unroll
                            for (int j = 0; j < 4; ++j) { t0[j] = fabsf(z0[j]) * -1.4426950408889634f; t1[j] = fabsf(z1[j]) * -1.4426950408889634f; }
                            exp2_8(t0, t1); t0 = t0 + 1.0f; t1 = t1 + 1.0f; log2_8(t0, t1);
#pragma unroll
                            for (int j = 0; j < 4; ++j) { v0[j] = (fminf(z0[j], 0.f) * 1.4426950408889634f - t0[j]) * 0.0625f; v1[j] = (fminf(z1[j], 0.f) * 1.4426950408889634f - t1[j]) * 0.0625f; }
                            *(u32x4*)((bf16_t*)(wsb + R_GA) + row * 128 + cw) = pack8h(v0, v1);
                        } else if (wc < 2) {
                            *(u32x4*)((bf16_t*)(wsb + R_KROPE) + row * 64 + cw) = pack8(v0, v1);
                            float ks = (v0[0] * v0[0] + v0[1] * v0[1]) + (v0[2] * v0[2] + v0[3] * v0[3]) + (v1[0] * v1[0] + v1[1] * v1[1]) + (v1[2] * v1[2] + v1[3] * v1[3]);
                            ks += __shfl_xor(ks, 16); ks += __shfl_xor(ks, 32);
                            if (fq == 0) ((float*)(wsb + WS_LATP))[row * 16 + 8 + wc] = ks;
                        }
                    }
                }
                if constexpr (MODE == 4) { lss += __shfl_xor(lss, 16); lss += __shfl_xor(lss, 32); if (fq == 0) ((float*)(wsb + WS_LATP))[row * 16 + lslot + wc] = lss; }
            }
    }
    __device__ __forceinline__ void prefetch(const pg8::Unit& u, int wid, int lane) const { __builtin_amdgcn_s_barrier(); stat_dma((const float*)(wsb + WS_PART), st, u.pm, wid, lane); }
    __device__ __forceinline__ void operator()(const f32x4 (&acc)[2][2][4][2], const pg8::Unit& u, int wr, int wc, int fr, int fq) const {
        asm volatile("" : "+v"(fr), "+v"(fq));
        const int row0 = u.pm * 256 + wr * 64 + fr, cw = wc * 32 + 8 * fq, pn = u.pn;
        const PG8_LAS float* strow = st + (wr * 64 + fr) * 16 + 4 * fq;
        if (pn == 3) run<3>(acc, row0, cw, wc, nullptr, 1.f, 0, strow);
        else if (pn == 7) run<2>(acc, row0, cw, wc, nullptr, 1.f, 0, strow);
        else if (pn == 5 || pn == 6 || pn == 9) run<1>(acc, row0, cw, wc, (bf16_t*)(wsb + ((pn == 5) ? R_GR : ((pn == 9) ? R_HG : R_HQ))), (pn == 6) ? 0.125f : 1.0f, 0, strow);
        else if (pn < 2) run<4>(acc, row0, cw, wc, (bf16_t*)(wsb + ((pn == 0) ? R_QLAT : R_KVLAT)), 1.f, pn * 4, strow);
        else run<0>(acc, row0, cw, wc, (bf16_t*)(wsb + ((pn == 2) ? R_GQK : (pn == 4) ? R_GV : R_HI)), 1.f, 0, strow);
    }
};
template <bool PARTS>
struct EpiScaleBf16 {
    static constexpr bool PERM = true, AFTER_DRAIN = false;
    const float* rs; bf16_t* O; int ldc;
    PG8_LAS float* st;
    __device__ __forceinline__ void prefetch(const pg8::Unit& u, int wid, int lane) const { if constexpr (PARTS) { __builtin_amdgcn_s_barrier(); stat_dma(rs, st, u.pm, wid, lane); } }
    __device__ __forceinline__ void operator()(const f32x4 (&acc)[2][2][4][2], const pg8::Unit& u, int wr, int wc, int fr, int fq) const {
        asm volatile("" : "+v"(fr), "+v"(fq));
        const int row0 = u.pm * 256 + wr * 64 + fr, c0 = u.pn * 256 + wc * 32 + 8 * fq;
        const PG8_LAS float* strow = st + (wr * 64 + fr) * 16 + 4 * fq;
#pragma unroll
        for (int ai = 0; ai < 2; ++ai)
#pragma unroll
            for (int m = 0; m < 4; ++m) {
                const size_t row = (size_t)(row0 + ai * 128 + m * 16); const float s = PARTS ? rstd_from_lds(strow + (ai * 128 + m * 16) * 16) : rs[row];
#pragma unroll
                for (int bj = 0; bj < 2; ++bj) *(u32x4*)(O + row * ldc + c0 + bj * 128) = pack8(acc[ai][bj][m][0] * s, acc[ai][bj][m][1] * s);
            }
    }
};
struct EpiScaleF32 {
    static constexpr bool PERM = true, AFTER_DRAIN = false;
    const float* rs; float* O; int ldc;
    __device__ __forceinline__ void prefetch(const pg8::Unit&, int, int) const {}
    __device__ __forceinline__ void operator()(const f32x4 (&acc)[2][2][4][2], const pg8::Unit& u, int wr, int wc, int fr, int fq) const {
        asm volatile("" : "+v"(fr), "+v"(fq));
        const int row0 = u.pm * 256 + wr * 64 + fr, c0 = u.pn * 256 + wc * 32 + 8 * fq;
#pragma unroll
        for (int ai = 0; ai < 2; ++ai)
#pragma unroll
            for (int m = 0; m < 4; ++m) {
                const size_t row = (size_t)(row0 + ai * 128 + m * 16); const float s = rs[row];
#pragma unroll
                for (int bj = 0; bj < 2; ++bj) { float* p = O + row * ldc + c0 + bj * 128; *(f32x4*)p = acc[ai][bj][m][0] * s; *(f32x4*)(p + 4) = acc[ai][bj][m][1] * s; }
            }
    }
};
struct EpiResid {
    static constexpr bool PERM = true, AFTER_DRAIN = false;
    bf16_t* h16; bf16_t* h16o; float* out; float* parts; int last;
    __device__ __forceinline__ void prefetch(const pg8::Unit&, int, int) const {}
    __device__ __forceinline__ void operator()(const f32x4 (&acc)[2][2][4][2], const pg8::Unit& u, int wr, int wc, int fr, int fq) const {
        asm volatile("" : "+v"(fr), "+v"(fq));
        const int row0 = u.pm * 256 + wr * 64 + fr, c0 = u.pn * 256 + wc * 32 + 8 * fq;
#pragma unroll
        for (int ai = 0; ai < 2; ++ai) {
            u32x4 hw[4][2];
#pragma unroll
            for (int m = 0; m < 4; ++m)
#pragma unroll
                for (int bj = 0; bj < 2; ++bj) hw[m][bj] = *(const u32x4*)(h16 + (size_t)(row0 + ai * 128 + m * 16) * DM + c0 + bj * 128);
#pragma unroll
            for (int m = 0; m < 4; ++m) {
                const size_t row = (size_t)(row0 + ai * 128 + m * 16);
                float ss = 0.f;
#pragma unroll
                for (int bj = 0; bj < 2; ++bj) { const size_t o = row * DM + c0 + bj * 128;
                    const f32x2 a0 = unpk_f16(hw[m][bj].x), a1 = unpk_f16(hw[m][bj].y), a2 = unpk_f16(hw[m][bj].z), a3 = unpk_f16(hw[m][bj].w);
                    const f32x4 h0 = (f32x4){a0[0], a0[1], a1[0], a1[1]} + acc[ai][bj][m][0], h1 = (f32x4){a2[0], a2[1], a3[0], a3[1]} + acc[ai][bj][m][1];
                    if (last) { *(f32x4*)(out + o) = h0; *(f32x4*)(out + o + 4) = h1; }
                    else { *(u32x4*)(h16o + o) = pack8h(h0, h1);
                        ss += (h0[0] * h0[0] + h0[1] * h0[1]) + (h0[2] * h0[2] + h0[3] * h0[3]) + (h1[0] * h1[0] + h1[1] * h1[1]) + (h1[2] * h1[2] + h1[3] * h1[3]); } }
                if (!last) { ss += __shfl_xor(ss, 16); ss += __shfl_xor(ss, 32); if (fq == 0) parts[row * 16 + u.pn * 4 + wc] = ss; }
            }
        }
    }
};
struct EpiQUp {
    static constexpr bool PERM = true, AFTER_DRAIN = false;
    unsigned char* wsb; const float* qg; PG8_LAS float* sx; PG8_LAS float* st;
    __device__ __forceinline__ void prefetch(const pg8::Unit& u, int wid, int lane) const { __builtin_amdgcn_s_barrier(); stat_dma((const float*)(wsb + WS_LATP), st, u.pm, wid, lane); }
    __device__ __forceinline__ void operator()(const f32x4 (&acc)[2][2][4][2], const pg8::Unit& u, int wr, int wc, int fr, int fq) const {
        asm volatile("" : "+v"(fr), "+v"(fq));
        const int lrow0 = wr * 64 + fr, cw = wc * 32 + 8 * fq, h = u.pn, jb = 4 * (4 * wc + fq);
#pragma unroll
        for (int ai = 0; ai < 2; ++ai)
#pragma unroll
            for (int m = 0; m < 4; ++m) { const int lrow = lrow0 + ai * 128 + m * 16; const size_t row = (size_t)u.pm * 256 + lrow;
                const f32x4 lp = *(const PG8_LAS f32x4*)(st + lrow * 16);
                const float cl1 = __builtin_amdgcn_rsqf(((lp[0] + lp[1]) + (lp[2] + lp[3])) * (1.0f / 256.0f) + EPS);
                float ss = 0.f;
#pragma unroll
                for (int bj = 0; bj < 2; ++bj)
#pragma unroll
                    for (int n = 0; n < 2; ++n) { const f32x4 x = acc[ai][bj][m][n] * cl1; ss += (x[0] * x[0] + x[1] * x[1]) + (x[2] * x[2] + x[3] * x[3]); }
                ss += __shfl_xor(ss, 16); ss += __shfl_xor(ss, 32);
                if (fq == 0) sx[lrow * 4 + wc] = ss; }
        asm volatile("s_waitcnt lgkmcnt(0)" ::: "memory"); __builtin_amdgcn_s_barrier(); asm volatile("" ::: "memory");
        const f32x4 g0 = *(const f32x4*)(qg + cw), g1 = *(const f32x4*)(qg + cw + 4);
        f32x4 gr1 = {0.f, 0.f, 0.f, 0.f}, gr2 = {0.f, 0.f, 0.f, 0.f};
        if (wc < 2) { gr1 = *(const f32x4*)(qg + 128 + jb); gr2 = *(const f32x4*)(qg + 160 + jb); }
#pragma unroll
        for (int ai = 0; ai < 2; ++ai)
#pragma unroll
            for (int m = 0; m < 4; ++m) { const int lrow = lrow0 + ai * 128 + m * 16; const size_t row = (size_t)u.pm * 256 + lrow;
                const f32x4 t4 = *(const PG8_LAS f32x4*)(sx + lrow * 4);
                const f32x4 lp2 = *(const PG8_LAS f32x4*)(st + lrow * 16);
                const float cl2 = __builtin_amdgcn_rsqf(((lp2[0] + lp2[1]) + (lp2[2] + lp2[3])) * (1.0f / 256.0f) + EPS);
                const float sc = cl2 * __builtin_amdgcn_rsqf(((t4[0] + t4[1]) + (t4[2] + t4[3])) * (1.0f / 192.0f) + EPS);
                bf16_t* qrow = (bf16_t*)(wsb + R_Q) + (((size_t)(row >> 13) * 4 + h) * SEQ + (row & (SEQ - 1))) * 192;
                *(u32x4*)(qrow + cw) = pack8(acc[ai][0][m][0] * sc * g0, acc[ai][0][m][1] * sc * g1);
                if (wc < 2) {
                    const f32x4 x1 = acc[ai][1][m][0] * sc * gr1, x2 = acc[ai][1][m][1] * sc * gr2;
                    const f32x4 csa = *(const f32x4*)((const f32x2*)(wsb + WS_ROT) + row * 32 + jb), csb = *(const f32x4*)((const f32x2*)(wsb + WS_ROT) + row * 32 + jb + 2);
                    const float o10 = x1[0] * csa[0] - x2[0] * csa[1], o11 = x1[1] * csa[2] - x2[1] * csa[3], o12 = x1[2] * csb[0] - x2[2] * csb[1], o13 = x1[3] * csb[2] - x2[3] * csb[3];
                    const float o20 = x2[0] * csa[0] + x1[0] * csa[1], o21 = x2[1] * csa[2] + x1[1] * csa[3], o22 = x2[2] * csb[0] + x1[2] * csb[1], o23 = x2[3] * csb[2] + x1[3] * csb[3];
                    *(u32x2*)(qrow + 128 + jb) = (u32x2){cvt_pk_bf16(o10, o11), cvt_pk_bf16(o12, o13)};
                    *(u32x2*)(qrow + 160 + jb) = (u32x2){cvt_pk_bf16(o20, o21), cvt_pk_bf16(o22, o23)};
                } }
    }
};
struct EpiKVUp {
    static constexpr bool PERM = true, AFTER_DRAIN = false;
    unsigned char* wsb; const float* kg; PG8_LAS float* sx; PG8_LAS float* st;
    __device__ __forceinline__ void prefetch(const pg8::Unit& u, int wid, int lane) const { __builtin_amdgcn_s_barrier(); stat_dma((const float*)(wsb + WS_LATP), st, u.pm, wid, lane); }
    __device__ __forceinline__ void operator()(const f32x4 (&acc)[2][2][4][2], const pg8::Unit& u, int wr, int wc, int fr, int fq) const {
        asm volatile("" : "+v"(fr), "+v"(fq));
        const int lrow0 = wr * 64 + fr, cw = wc * 32 + 8 * fq, h = u.pn, j2 = 2 * (4 * wc + fq);
#pragma unroll
        for (int ai = 0; ai < 2; ++ai)
#pragma unroll
            for (int m = 0; m < 4; ++m) { const int lrow = lrow0 + ai * 128 + m * 16; const size_t row = (size_t)u.pm * 256 + lrow;
                const f32x4 lp = *(const PG8_LAS f32x4*)(st + lrow * 16 + 4);
                const float cl1 = __builtin_amdgcn_rsqf(((lp[0] + lp[1]) + (lp[2] + lp[3])) * (1.0f / 256.0f) + EPS);
                float ss = 0.f;
#pragma unroll
                for (int n = 0; n < 2; ++n) { const f32x4 x = acc[ai][0][m][n] * cl1; ss += (x[0] * x[0] + x[1] * x[1]) + (x[2] * x[2] + x[3] * x[3]); }
                ss += __shfl_xor(ss, 16); ss += __shfl_xor(ss, 32);
                if (fq == 0) sx[lrow * 4 + wc] = ss; }
        asm volatile("s_waitcnt lgkmcnt(0)" ::: "memory"); __builtin_amdgcn_s_barrier(); asm volatile("" ::: "memory");
        const f32x4 g0 = *(const f32x4*)(kg + cw), g1 = *(const f32x4*)(kg + cw + 4);
        const f32x2 gk1 = *(const f32x2*)(kg + 128 + j2), gk2 = *(const f32x2*)(kg + 160 + j2);
#pragma unroll
        for (int ai = 0; ai < 2; ++ai)
#pragma unroll
            for (int m = 0; m < 4; ++m) { const int lrow = lrow0 + ai * 128 + m * 16; const size_t row = (size_t)u.pm * 256 + lrow;
                const f32x4 t4 = *(const PG8_LAS f32x4*)(sx + lrow * 4);
                const f32x2 kr = *(const PG8_LAS f32x2*)(st + lrow * 16 + 8);
                const float rk = __builtin_amdgcn_rsqf((((t4[0] + t4[1]) + (t4[2] + t4[3])) + (kr[0] + kr[1])) * (1.0f / 192.0f) + EPS);
                const size_t bhs = ((size_t)(row >> 13) * 4 + h) * SEQ + (row & (SEQ - 1));
                const f32x4 lp2 = *(const PG8_LAS f32x4*)(st + lrow * 16 + 4);
                const float cl2 = __builtin_amdgcn_rsqf(((lp2[0] + lp2[1]) + (lp2[2] + lp2[3])) * (1.0f / 256.0f) + EPS);
                const float sc = cl2 * rk;
                *(u32x4*)((bf16_t*)(wsb + R_KN) + bhs * 128 + cw) = pack8(acc[ai][0][m][0] * sc * g0, acc[ai][0][m][1] * sc * g1);
                *(u32x4*)((bf16_t*)(wsb + R_V) + bhs * 128 + cw) = pack8(acc[ai][1][m][0] * cl2, acc[ai][1][m][1] * cl2);
                const unsigned x1w = *(const unsigned*)((const bf16_t*)(wsb + R_KROPE) + row * 64 + j2), x2w = *(const unsigned*)((const bf16_t*)(wsb + R_KROPE) + row * 64 + 32 + j2);
                const f32x4 cs = *(const f32x4*)((const f32x2*)(wsb + WS_ROT) + row * 32 + j2);
                const float a0 = bflo(x1w) * rk * gk1[0], a1 = bfhi(x1w) * rk * gk1[1], b0 = bflo(x2w) * rk * gk2[0], b1 = bfhi(x2w) * rk * gk2[1];
                *(unsigned*)((bf16_t*)(wsb + R_KRH) + bhs * 64 + j2) = cvt_pk_bf16(a0 * cs[0] - b0 * cs[1], a1 * cs[2] - b1 * cs[3]);
                *(unsigned*)((bf16_t*)(wsb + R_KRH) + bhs * 64 + 32 + j2) = cvt_pk_bf16(b0 * cs[0] + a0 * cs[1], b1 * cs[2] + a1 * cs[3]); }
    }
};

#define DPPU_(old, x, ctrl) ((unsigned)__builtin_amdgcn_update_dpp((int)(old), (int)(x), (ctrl), 0xf, 0xf, false))
__device__ __forceinline__ f16x2_t f2h2(float a, float b) { const f32x2 v = {a, b}; return __builtin_convertvector(v, f16x2_t); }
__device__ __forceinline__ f16x2_t silu_mul_h2(f16x2_t cv, f16x2_t up) {
    const f16x2_t nl = {(_Float16)-1.4426950408889634f, (_Float16)-1.4426950408889634f}, one = {(_Float16)1.0f, (_Float16)1.0f};
    const f16x2_t d = one + __builtin_elementwise_exp2(cv * nl);
    f16x2_t r; r.x = __builtin_amdgcn_rcph(d.x); r.y = __builtin_amdgcn_rcph(d.y);
    return cv * r * up;
}
#define TRANS_PK4(OP, r, x) asm(OP "_e32 %0, %4\n\t" OP "_e32 %1, %5\n\t" OP "_e32 %2, %6\n\t" OP "_e32 %3, %7\n\t" \
        OP "_sdwa %0, %4 dst_sel:WORD_1 dst_unused:UNUSED_PRESERVE src0_sel:WORD_1\n\t" OP "_sdwa %1, %5 dst_sel:WORD_1 dst_unused:UNUSED_PRESERVE src0_sel:WORD_1\n\t" \
        OP "_sdwa %2, %6 dst_sel:WORD_1 dst_unused:UNUSED_PRESERVE src0_sel:WORD_1\n\t" OP "_sdwa %3, %7 dst_sel:WORD_1 dst_unused:UNUSED_PRESERVE src0_sel:WORD_1\n\ts_nop 0" \
        : "=&v"(r[0]), "=&v"(r[1]), "=&v"(r[2]), "=&v"(r[3]) : "v"(x[0]), "v"(x[1]), "v"(x[2]), "v"(x[3]))
struct EpiGateUpConv {
    static constexpr bool PERM = true, AFTER_DRAIN = false;
    const float* parts; bf16_t* act; float* gh; float* uh;
    const float* cw_; const float* cb_;
    PG8_LAS float* hx;
    PG8_LAS float* st;
    __device__ __forceinline__ void prefetch(const pg8::Unit& u, int wid, int lane) const {
        stat_dma(parts, st, u.pm, wid, lane);
    }
    __device__ __forceinline__ void operator()(const f32x4 (&acc)[2][2][4][2], const pg8::Unit& u, int wr, int wc, int fr, int fq) const {
        asm volatile("" : "+v"(fr), "+v"(fq));
        const int row0 = u.pm * 256 + wr * 64 + fr, cw = wc * 32 + 8 * fq, c0 = u.pn * 128 + cw;
        f16x2_t w0p[4], w1p[4], w2p[4], bbp[4];
#pragma unroll
        for (int n = 0; n < 2; ++n) { const f32x4 a = *(const f32x4*)(cw_ + c0 + 4 * n), b = *(const f32x4*)(cw_ + D_FF + c0 + 4 * n), c = *(const f32x4*)(cw_ + 2 * D_FF + c0 + 4 * n), d = *(const f32x4*)(cb_ + c0 + 4 * n);
            w0p[2 * n] = f2h2(a[0], a[1]); w0p[2 * n + 1] = f2h2(a[2], a[3]); w1p[2 * n] = f2h2(b[0], b[1]); w1p[2 * n + 1] = f2h2(b[2], b[3]);
            w2p[2 * n] = f2h2(c[0], c[1]); w2p[2 * n + 1] = f2h2(c[2], c[3]); bbp[2 * n] = f2h2(d[0], d[1]); bbp[2 * n + 1] = f2h2(d[2], d[3]); }
        float rs[2][4];
#pragma unroll
        for (int ai = 0; ai < 2; ++ai)
#pragma unroll
            for (int m = 0; m < 4; ++m) { const f32x4 v = *(const PG8_LAS f32x4*)(st + (wr * 64 + fr + ai * 128 + m * 16) * 16 + 4 * fq);
                float sq = (v[0] + v[1]) + (v[2] + v[3]); sq += __shfl_xor(sq, 16); sq += __shfl_xor(sq, 32);
                rs[ai][m] = __builtin_amdgcn_rsqf(sq * (1.0f / DM) + EPS); }
        if (fr >= 14) {
#pragma unroll
            for (int ai = 0; ai < 2; ++ai)
#pragma unroll
                for (int n = 0; n < 2; ++n) { const f32x4 g = acc[ai][0][3][n] * rs[ai][3];
                    *(PG8_LAS f32x4*)(hx + ((ai * 2 + wr) * 2 + (fr - 14)) * 128 + cw + 4 * n) = g;
                    if (ai == 1 && wr == 1) *(f32x4*)(gh + ((size_t)u.pm * 4 + (fr - 14)) * D_FF + c0 + 4 * n) = g; }
        }
        if (wr == 0 && fr < 2) {
#pragma unroll
            for (int n = 0; n < 2; ++n) { *(f32x4*)(gh + ((size_t)u.pm * 4 + 2 + fr) * D_FF + c0 + 4 * n) = acc[0][0][0][n] * rs[0][0];
                                          *(f32x4*)(uh + ((size_t)u.pm * 2 + fr) * D_FF + c0 + 4 * n) = acc[0][1][0][n] * rs[0][0]; }
        }
        asm volatile("s_waitcnt lgkmcnt(0)" ::: "memory"); __builtin_amdgcn_s_barrier(); asm volatile("" ::: "memory");
#pragma unroll
        for (int ai = 0; ai < 2; ++ai) {
            const int pblk = ai * 2 + wr - 1;
            unsigned prv[4];
#pragma unroll
            for (int n = 0; n < 2; ++n) { const f32x4 pv4 = (pblk >= 0) ? *(const PG8_LAS f32x4*)(hx + (pblk * 2 + (fr & 1)) * 128 + cw + 4 * n) : (f32x4){0.f, 0.f, 0.f, 0.f};
                prv[2 * n] = __builtin_bit_cast(unsigned, f2h2(pv4[0], pv4[1])); prv[2 * n + 1] = __builtin_bit_cast(unsigned, f2h2(pv4[2], pv4[3])); }
#pragma unroll
            for (int m = 0; m < 4; ++m) {
                const size_t row = (size_t)(row0 + ai * 128 + m * 16);
                unsigned gg[4], upk[4], t1[4], t2[4], g1[4], g2[4], xe[4], ee[4], dd[4], rr[4], ow[4]; f16x2_t cv[4];
#pragma unroll
                for (int n = 0; n < 2; ++n) { const f32x4 g0 = acc[ai][0][m][n] * rs[ai][m], up = acc[ai][1][m][n] * rs[ai][m];
                    gg[2 * n] = __builtin_bit_cast(unsigned, f2h2(g0[0], g0[1])); gg[2 * n + 1] = __builtin_bit_cast(unsigned, f2h2(g0[2], g0[3]));
                    upk[2 * n] = __builtin_bit_cast(unsigned, f2h2(up[0], up[1])); upk[2 * n + 1] = __builtin_bit_cast(unsigned, f2h2(up[2], up[3])); }
                asm volatile("" : "+v"(gg[0]), "+v"(gg[1]), "+v"(gg[2]), "+v"(gg[3]), "+v"(prv[0]), "+v"(prv[1]), "+v"(prv[2]), "+v"(prv[3]));
                asm volatile("" : "=v"(t1[0]), "=v"(t1[1]), "=v"(t1[2]), "=v"(t1[3]), "=v"(t2[0]), "=v"(t2[1]), "=v"(t2[2]), "=v"(t2[3]));
#pragma unroll
                for (int q = 0; q < 4; ++q) t1[q] = DPPU_(t1[q], prv[q], 0x15F);
#pragma unroll
                for (int q = 0; q < 4; ++q) g1[q] = DPPU_(t1[q], gg[q], 0x111);
#pragma unroll
                for (int q = 0; q < 4; ++q) t2[q] = DPPU_(t2[q], prv[q], 0x15E);
#pragma unroll
                for (int q = 0; q < 4; ++q) g2[q] = DPPU_(t2[q], g1[q], 0x111);
                const f16x2_t nl = {(_Float16)-1.4426950408889634f, (_Float16)-1.4426950408889634f}, one = {(_Float16)1.0f, (_Float16)1.0f};
#pragma unroll
                for (int q = 0; q < 4; ++q) { cv[q] = bbp[q] + __builtin_bit_cast(f16x2_t, g2[q]) * w0p[q] + __builtin_bit_cast(f16x2_t, g1[q]) * w1p[q] + __builtin_bit_cast(f16x2_t, gg[q]) * w2p[q];
                    xe[q] = __builtin_bit_cast(unsigned, cv[q] * nl); }
                TRANS_PK4("v_exp_f16", ee, xe);
#pragma unroll
                for (int q = 0; q < 4; ++q) dd[q] = __builtin_bit_cast(unsigned, one + __builtin_bit_cast(f16x2_t, ee[q]));
                TRANS_PK4("v_rcp_f16", rr, dd);
#pragma unroll
                for (int q = 0; q < 4; ++q) { ow[q] = __builtin_bit_cast(unsigned, cv[q] * __builtin_bit_cast(f16x2_t, rr[q]) * __builtin_bit_cast(f16x2_t, upk[q])); prv[q] = gg[q]; }
                *(u32x4*)(act + row * D_FF + c0) = (u32x4){ow[0], ow[1], ow[2], ow[3]};
            }
        }
    }
};

namespace att {
constexpr int KVBLK = 64;
constexpr float THR = 8.f;
constexpr size_t SHM_V = 64 * 128 * 2, SHM_K = 64 * 128 * 2, SHM_KR = 64 * 64 * 2;
constexpr size_t OFF_V = 0, OFF_K = 2 * SHM_V, OFF_KR = OFF_K + 2 * SHM_K, OFF_WS = OFF_KR + 2 * SHM_KR, OFF_QR = OFF_WS + 8 * 64 * 4, SHM_ATTN = OFF_QR + 8 * 9216;
#define KSWZ(row, colB) ((row) * 256 + ((colB) ^ (((row) & 7) << 4)))
#define KRSWZ(row, colB) ((row) * 128 + ((colB) ^ ((((row) >> 1) & 7) << 4)))
#define SBAR() __builtin_amdgcn_sched_barrier(0)
__device__ __forceinline__ int crow(int r, int hi) { return (r & 3) + 8 * (r >> 2) + 4 * hi; }

__device__ __forceinline__ void partialSM(f32x16& p0, f32x16& p1, float& m_reg, float& mn, float& alpha, const float Cl, const bool masked) {
    float pmax = p0[0];
#pragma unroll
    for (int r = 1; r < 16; ++r) pmax = fmaxf(pmax, p0[r]);
#pragma unroll
    for (int r = 0; r < 16; ++r) pmax = fmaxf(pmax, p1[r]);
    { auto rr = __builtin_amdgcn_permlane32_swap(__float_as_uint(pmax), __float_as_uint(pmax), false, false);
      pmax = fmaxf(__uint_as_float(rr[0]), __uint_as_float(rr[1])); }
    pmax = masked ? -1e30f : pmax;
    if (__builtin_expect(__all((pmax - m_reg) * Cl <= THR * LOG2E), 1)) { mn = m_reg; alpha = 1.f; }
    else { mn = fmaxf(m_reg, pmax); alpha = __builtin_amdgcn_exp2f((m_reg - mn) * Cl); m_reg = mn; }
    const float mnC = -mn * Cl - (masked ? 1e30f : 0.f);
#pragma unroll
    for (int r = 0; r < 16; ++r) p0[r] = fmaf(p0[r], Cl, mnC);
#pragma unroll
    for (int r = 0; r < 16; ++r) p1[r] = fmaf(p1[r], Cl, mnC);
#pragma unroll
    for (int r = 0; r < 16; ++r) p0[r] = __builtin_amdgcn_exp2f(p0[r]);
}
__device__ __forceinline__ void finishSM(f32x16& p0, f32x16& p1, float alpha, float& l_reg, bf16x8& pa0, bf16x8& pa1, bf16x8& pa2, bf16x8& pa3) {
#pragma unroll
    for (int r = 0; r < 16; ++r) p1[r] = __builtin_amdgcn_exp2f(p1[r]);
    float ps = 0;
#pragma unroll
    for (int r = 0; r < 16; ++r) ps += p0[r];
#pragma unroll
    for (int r = 0; r < 16; ++r) ps += p1[r];
    { auto rr = __builtin_amdgcn_permlane32_swap(__float_as_uint(ps), __float_as_uint(ps), false, false);
      ps = __uint_as_float(rr[0]) + __uint_as_float(rr[1]); }
    l_reg = l_reg * alpha + ps;
#define PK4(P, BASE, OUT) do { unsigned a0 = cvt_pk_bf16(P[BASE + 0], P[BASE + 1]), a1 = cvt_pk_bf16(P[BASE + 2], P[BASE + 3]);   \
    unsigned b0 = cvt_pk_bf16(P[BASE + 4], P[BASE + 5]), b1 = cvt_pk_bf16(P[BASE + 6], P[BASE + 7]);                              \
    auto r0 = __builtin_amdgcn_permlane32_swap(a0, b0, false, false); auto r1 = __builtin_amdgcn_permlane32_swap(a1, b1, false, false); \
    u32x4 w = {r0[0], r1[0], r0[1], r1[1]}; OUT = *reinterpret_cast<bf16x8*>(&w); } while (0)
    PK4(p0, 0, pa0); PK4(p0, 8, pa1); PK4(p1, 0, pa2); PK4(p1, 8, pa3);
#undef PK4
}
template <int NQ, int NQREG>
__device__ __forceinline__ void qkt(f32x16& p0, f32x16& p1, const char* Ks, const char* Krs, const bf16x8* qr, const char* qrl, int r32, int hi) {
    p0 = f32x16{}; p1 = f32x16{};
#pragma unroll
    for (int d0 = 0; d0 < 8; ++d0) { const int cb = (d0 * 16 + hi * 8) * 2;
        bf16x8 b0 = *reinterpret_cast<const bf16x8*>(Ks + KSWZ(r32, cb));
        bf16x8 b1 = *reinterpret_cast<const bf16x8*>(Ks + KSWZ(32 + r32, cb));
        bf16x8 qf; if (d0 < NQREG) qf = qr[d0 < NQREG ? d0 : 0]; else qf = *reinterpret_cast<const bf16x8*>(qrl + (d0 - NQREG) * 1024);
        p0 = __builtin_amdgcn_mfma_f32_32x32x16_bf16(b0, qf, p0, 0, 0, 0);
        p1 = __builtin_amdgcn_mfma_f32_32x32x16_bf16(b1, qf, p1, 0, 0, 0); }
    if constexpr (NQ == 12) {
        SBAR();
#pragma unroll
        for (int d1 = 0; d1 < 4; ++d1) { const int cb = (d1 * 16 + hi * 8) * 2;
            bf16x8 b0 = *reinterpret_cast<const bf16x8*>(Krs + KRSWZ(r32, cb));
            bf16x8 b1 = *reinterpret_cast<const bf16x8*>(Krs + KRSWZ(32 + r32, cb));
            bf16x8 qf; if (8 + d1 < NQREG) qf = qr[8 + d1 < NQREG ? 8 + d1 : 0]; else qf = *reinterpret_cast<const bf16x8*>(qrl + (8 + d1 - NQREG) * 1024);
            p0 = __builtin_amdgcn_mfma_f32_32x32x16_bf16(b0, qf, p0, 0, 0, 0);
            p1 = __builtin_amdgcn_mfma_f32_32x32x16_bf16(b1, qf, p1, 0, 0, 0); }
    }
}
__device__ __forceinline__ int v_st(int k, int c) { const int kk = (k & ~0xC) | ((k & 4) << 1) | ((k & 8) >> 1); return ((kk >> 3) * 4 + (c >> 5)) * 512 + ((kk & 7) * 32 + (c & 31)) * 2; }
__device__ __forceinline__ int v_rd_base(int lane) { return ((lane & 3) << 3) | (((lane >> 2) & 3) << 6) | (((lane >> 4) & 1) << 5) | (((lane >> 5) & 1) << 8); }
constexpr int v_rd_off(int d0, int ks, int half) { return d0 * 512 + ks * 4096 + half * 2048; }
template <int OFF> __device__ __forceinline__ s16x4 tr_read(int vb) {
    s16x4 r; asm volatile("ds_read_b64_tr_b16 %0, %1 offset:%2" : "=&v"(r) : "v"(vb), "i"(OFF) : "memory"); return r;
}
template <int D0> __device__ __forceinline__ void pv_one(f32x16& od, int vb, bf16x8 pa0, bf16x8 pa1, bf16x8 pa2, bf16x8 pa3) {
    const s16x4 l0 = tr_read<v_rd_off(D0, 0, 0)>(vb), h0 = tr_read<v_rd_off(D0, 0, 1)>(vb), l1 = tr_read<v_rd_off(D0, 1, 0)>(vb), h1 = tr_read<v_rd_off(D0, 1, 1)>(vb);
    const s16x4 l2 = tr_read<v_rd_off(D0, 2, 0)>(vb), h2 = tr_read<v_rd_off(D0, 2, 1)>(vb), l3 = tr_read<v_rd_off(D0, 3, 0)>(vb), h3 = tr_read<v_rd_off(D0, 3, 1)>(vb);
    asm volatile("s_waitcnt lgkmcnt(0)" ::: "memory"); SBAR();
#define PK(L, H) (bf16x8){L[0], L[1], L[2], L[3], H[0], H[1], H[2], H[3]}
    od = __builtin_amdgcn_mfma_f32_32x32x16_bf16(pa0, PK(l0, h0), od, 0, 0, 0);
    od = __builtin_amdgcn_mfma_f32_32x32x16_bf16(pa1, PK(l1, h1), od, 0, 0, 0);
    od = __builtin_amdgcn_mfma_f32_32x32x16_bf16(pa2, PK(l2, h2), od, 0, 0, 0);
    od = __builtin_amdgcn_mfma_f32_32x32x16_bf16(pa3, PK(l3, h3), od, 0, 0, 0);
#undef PK
}
__device__ __forceinline__ void pv_d0(f32x16* o, int vb, bf16x8 pa0, bf16x8 pa1, bf16x8 pa2, bf16x8 pa3) {
    pv_one<0>(o[0], vb, pa0, pa1, pa2, pa3); pv_one<1>(o[1], vb, pa0, pa1, pa2, pa3); pv_one<2>(o[2], vb, pa0, pa1, pa2, pa3); pv_one<3>(o[3], vb, pa0, pa1, pa2, pa3);
}

template <int MODE, int SDEPTH>
__device__ __forceinline__ void attn_body(const bf16_t* Qb, const int ldq, const bf16_t* Kn, const bf16_t* Krp, const bf16_t* Vh,
                                          bf16_t* Ob, const int ldo, const int NT, const int last_tile, char* lds) {
    constexpr int NQ = (MODE == 0) ? 12 : 8;
    constexpr int NLD = (MODE == 0) ? 5 : 4;
    int tid = threadIdx.x; asm volatile("" : "+v"(tid));
    const int wid = tid >> 6, lane = tid & 63, r32 = lane & 31, hi = lane >> 5;
    char* V_lds = lds + OFF_V; char* K_lds = lds + OFF_K; char* Kr_lds = lds + OFF_KR;
    float* ws = (float*)(lds + OFF_WS) + wid * 64; float* li_l = ws; float* al_l = ws + 32;
    constexpr int NQREG = (MODE == 0) ? 8 : 8;
    float m_reg = -1e30f, l_reg = 0; f32x16 o[4] = {}; bf16x8 qr[NQREG];
    const bf16_t* Qw = Qb + (size_t)(wid * 32 + r32) * ldq + hi * 8;
#pragma unroll
    for (int d0 = 0; d0 < NQREG; ++d0) qr[d0] = *reinterpret_cast<const bf16x8*>(Qw + d0 * 16);
    char* qrl = lds + OFF_QR + wid * 9216 + lane * 16;
#pragma unroll
    for (int d1 = NQREG; d1 < NQ; ++d1) *reinterpret_cast<bf16x8*>(qrl + (d1 - NQREG) * 1024) = *reinterpret_cast<const bf16x8*>(Qw + d1 * 16);
    float Cl;
    if constexpr (MODE == 0) Cl = 0.07216878364870322f * LOG2E;
    else {
        float ss = 0.f;
#pragma unroll
        for (int d0 = 0; d0 < 8; ++d0)
#pragma unroll
            for (int j = 0; j < 8; ++j) { const float x = bf2f((unsigned short)qr[d0][j]); ss = fmaf(x, x, ss); }
        { auto rr = __builtin_amdgcn_permlane32_swap(__float_as_uint(ss), __float_as_uint(ss), false, false);
          ss = __uint_as_float(rr[0]) + __uint_as_float(rr[1]); }
        Cl = 0.08838834764831845f * LOG2E * __builtin_amdgcn_rsqf(ss * (1.0f / 128.0f) + EPS);
    }
    const int sr = tid >> 4, sc = (tid & 15) * 8, vst0 = v_st(sr, sc), vst1 = v_st(32 + sr, sc);
    const int krr = tid >> 3, krc = (tid & 7) * 8;
    const int vb0 = (int)(uintptr_t)V_lds + v_rd_base(lane);
    struct { bf16x8 vs0, vs1, ks0, ks1, kr; } sr_[SDEPTH];
#define SLOAD(i, k0) do { sr_[i].vs0 = *(const bf16x8*)(Vh + (size_t)((k0) + sr) * 128 + sc); sr_[i].vs1 = *(const bf16x8*)(Vh + (size_t)((k0) + 32 + sr) * 128 + sc); \
    sr_[i].ks0 = *(const bf16x8*)(Kn + (size_t)((k0) + sr) * 128 + sc); sr_[i].ks1 = *(const bf16x8*)(Kn + (size_t)((k0) + 32 + sr) * 128 + sc); \
    if constexpr (MODE == 0) sr_[i].kr = *(const bf16x8*)(Krp + (size_t)((k0) + krr) * 64 + krc); } while (0)
#define SWRITE(b, i) do { *(bf16x8*)(V_lds + (b) * SHM_V + vst0) = sr_[i].vs0;          \
    *(bf16x8*)(V_lds + (b) * SHM_V + vst1) = sr_[i].vs1; const int kc = sc * 2;               \
    *(bf16x8*)(K_lds + (b) * SHM_K + KSWZ(sr, kc)) = sr_[i].ks0;                       \
    *(bf16x8*)(K_lds + (b) * SHM_K + KSWZ(32 + sr, kc)) = sr_[i].ks1;                  \
    if constexpr (MODE == 0) *(bf16x8*)(Kr_lds + (b) * SHM_KR + KRSWZ(krr, krc * 2)) = sr_[i].kr; } while (0)
#define SWAIT() do { if constexpr (SDEPTH == 1) asm volatile("s_waitcnt vmcnt(0)" ::: "memory"); else if constexpr (NLD == 5) asm volatile("s_waitcnt vmcnt(5)" ::: "memory"); else asm volatile("s_waitcnt vmcnt(4)" ::: "memory"); } while (0)
#define RESC(a) do { if (__any((a) < 1.f)) { if (hi == 0) al_l[r32] = (a); asm volatile("s_waitcnt lgkmcnt(0)" ::: "memory"); \
    _Pragma("unroll") for (int d = 0; d < 4; ++d) _Pragma("unroll") for (int r = 0; r < 16; ++r) o[d][r] *= al_l[crow(r, hi)]; } } while (0)
    f32x16 pA0, pA1, pB0, pB1; float mnA, mnB, alA, alB; bf16x8 pa0, pa1, pa2, pa3;
    constexpr int SE = 0, SO = SDEPTH - 1;
    SLOAD(SE, 0); asm volatile("s_waitcnt vmcnt(0)" ::: "memory"); SWRITE(0, SE); __syncthreads();
    qkt<NQ, NQREG>(pA0, pA1, K_lds, Kr_lds, qr, qrl, r32, hi); partialSM(pA0, pA1, m_reg, mnA, alA, Cl, false);
    SLOAD(SO, KVBLK); if constexpr (SDEPTH == 2) { if (2 < NT) SLOAD(SE, 2 * KVBLK); }
    SWAIT(); SWRITE(1, SO); __syncthreads();
    for (int j = 1; j + 1 < NT; j += 2) {
        SBAR(); qkt<NQ, NQREG>(pB0, pB1, K_lds + SHM_K, Kr_lds + SHM_KR, qr, qrl, r32, hi);
        finishSM(pA0, pA1, alA, l_reg, pa0, pa1, pa2, pa3); SBAR();
        SLOAD(SO, (j + SDEPTH) * KVBLK); SBAR();
        pv_d0(o, vb0, pa0, pa1, pa2, pa3); partialSM(pB0, pB1, m_reg, mnB, alB, Cl, j > last_tile);
        __syncthreads(); SWAIT(); SWRITE(0, SE);
        RESC(alB); __syncthreads();
        SBAR(); qkt<NQ, NQREG>(pA0, pA1, K_lds, Kr_lds, qr, qrl, r32, hi);
        finishSM(pB0, pB1, alB, l_reg, pa0, pa1, pa2, pa3); SBAR();
        if (SDEPTH == 1 || j + 3 < NT) SLOAD(SE, (j + 1 + SDEPTH) * KVBLK); SBAR();
        pv_d0(o, vb0 + (int)SHM_V, pa0, pa1, pa2, pa3); partialSM(pA0, pA1, m_reg, mnA, alA, Cl, (j + 1) > last_tile);
        __syncthreads(); SWAIT(); SWRITE(1, SO);
        RESC(alA); __syncthreads();
    }
    SBAR(); qkt<NQ, NQREG>(pB0, pB1, K_lds + SHM_K, Kr_lds + SHM_KR, qr, qrl, r32, hi);
    finishSM(pA0, pA1, alA, l_reg, pa0, pa1, pa2, pa3); SBAR();
    pv_d0(o, vb0, pa0, pa1, pa2, pa3); partialSM(pB0, pB1, m_reg, mnB, alB, Cl, (NT - 1) > last_tile);
    __syncthreads(); RESC(alB);
    finishSM(pB0, pB1, alB, l_reg, pa0, pa1, pa2, pa3); SBAR();
    pv_d0(o, vb0 + (int)SHM_V, pa0, pa1, pa2, pa3);
    if (hi == 0) li_l[r32] = l_reg; asm volatile("s_waitcnt lgkmcnt(0)" ::: "memory");
    float rli[16];
#pragma unroll
    for (int r = 0; r < 16; ++r) rli[r] = __builtin_amdgcn_rcpf(li_l[crow(r, hi)]);
    bf16_t* Ow = Ob + (size_t)(wid * 32) * ldo;
#pragma unroll
    for (int r = 0; r < 16; ++r) { const int orow = crow(r, hi);
#pragma unroll
        for (int d0 = 0; d0 < 4; ++d0) Ow[(size_t)orow * ldo + d0 * 32 + r32] = f2bf(o[d0][r] * rli[r]); }
#undef SLOAD
#undef SWRITE
#undef SWAIT
#undef RESC
}

__device__ __forceinline__ void qkt12(f32x16& p0, f32x16& p1, const char* Ks, const char* Krs, const bf16x8* qr, int r32, int hi) {
    p0 = f32x16{}; p1 = f32x16{};
    const int x7 = (r32 & 7) << 4, xr = ((r32 >> 1) & 7) << 4;
    const int kb = (int)(uintptr_t)Ks + r32 * 256, krb = (int)(uintptr_t)Krs + r32 * 128;
    bf16x8 f0[2], f1[2];
#define QK_RD(slot, d) do { if ((d) < 8) { const int ad_ = kb + ((((d) * 32) + hi * 16) ^ x7); \
            asm volatile("ds_read_b128 %0, %1" : "=&v"(f0[slot]) : "v"(ad_) : "memory"); asm volatile("ds_read_b128 %0, %1 offset:8192" : "=&v"(f1[slot]) : "v"(ad_) : "memory"); } \
        else { const int ad_ = krb + (((((d) - 8) * 32) + hi * 16) ^ xr); \
            asm volatile("ds_read_b128 %0, %1" : "=&v"(f0[slot]) : "v"(ad_) : "memory"); asm volatile("ds_read_b128 %0, %1 offset:4096" : "=&v"(f1[slot]) : "v"(ad_) : "memory"); } } while (0)
    QK_RD(0, 0);
#pragma unroll
    for (int d = 0; d < 12; ++d) { const int sl = d & 1;
        if (d + 1 < 12) { QK_RD(sl ^ 1, d + 1); asm volatile("s_waitcnt lgkmcnt(2)" : "+v"(f0[sl]), "+v"(f1[sl]) :: "memory"); }
        else asm volatile("s_waitcnt lgkmcnt(0)" : "+v"(f0[sl]), "+v"(f1[sl]) :: "memory");
        p0 = __builtin_amdgcn_mfma_f32_32x32x16_bf16(f0[sl], qr[d], p0, 0, 0, 0);
        p1 = __builtin_amdgcn_mfma_f32_32x32x16_bf16(f1[sl], qr[d], p1, 0, 0, 0);
    }
#undef QK_RD
}

constexpr size_t D_OFF_V = 0, D_OFF_K = 3 * SHM_V, D_OFF_KR = D_OFF_K + 3 * SHM_K, D_OFF_WS = D_OFF_KR + 3 * SHM_KR, SHM_ATTN_DMA = D_OFF_WS + 8 * 64 * 4;
__device__ __forceinline__ void attn_body_dma(const bf16_t* Qb, const int ldq, const bf16_t* Kn, const bf16_t* Krp, const bf16_t* Vh,
                                              bf16_t* Ob, const int ldo, const int NT, const int last_tile, char* lds, LAS unsigned char* ldsl) {
    int tid = threadIdx.x; asm volatile("" : "+v"(tid));
    const int wid = __builtin_amdgcn_readfirstlane(tid >> 6), lane = tid & 63, r32 = lane & 31, hi = lane >> 5;
    char* K_lds = lds + D_OFF_K; char* Kr_lds = lds + D_OFF_KR;
    float* ws = (float*)(lds + D_OFF_WS) + wid * 64; float* li_l = ws; float* al_l = ws + 32;
    float m_reg = -1e30f, l_reg = 0; f32x16 o[4] = {}; bf16x8 qr[12];
    const bf16_t* Qw = Qb + (size_t)(wid * 32 + r32) * ldq + hi * 8;
#pragma unroll
    for (int d0 = 0; d0 < 12; ++d0) qr[d0] = *reinterpret_cast<const bf16x8*>(Qw + d0 * 16);
    const float Cl = 0.07216878364870322f * LOG2E;
    unsigned ko[2], vo[2], kro;
#pragma unroll
    for (int i = 0; i < 2; ++i) { const int sb = (i * 8 + wid) * 1024 + lane * 16;
        { const int row = sb >> 8, cb = (sb & 255) ^ ((row & 7) << 4); ko[i] = (unsigned)(row * 128 + (cb >> 1)); }
        { const int sub = sb >> 9, wi = sb & 511, kk = (sub >> 2) * 8 + (wi >> 6), c = (sub & 3) * 32 + ((wi & 63) >> 1), k = (kk & ~0xC) | ((kk & 4) << 1) | ((kk & 8) >> 1);
          vo[i] = (unsigned)(k * 128 + c); } }
    { const int sb = wid * 1024 + lane * 16; const int row = sb >> 7, cb = (sb & 127) ^ (((row >> 1) & 7) << 4); kro = (unsigned)(row * 64 + (cb >> 1)); }
    const int vbb = (int)(uintptr_t)(lds + D_OFF_V) + v_rd_base(lane);
#define ADMA(st, k0) do { _Pragma("unroll") for (int i_ = 0; i_ < 2; ++i_) { \
        __builtin_amdgcn_global_load_lds((const unsigned*)(Kn + (size_t)(k0) * 128 + ko[i_]), (LAS unsigned*)(ldsl + D_OFF_K + (st) * SHM_K + (i_ * 8 + wid) * 1024), 16, 0, 0); \
        __builtin_amdgcn_global_load_lds((const unsigned*)(Vh + (size_t)(k0) * 128 + vo[i_]), (LAS unsigned*)(ldsl + D_OFF_V + (st) * SHM_V + (i_ * 8 + wid) * 1024), 16, 0, 0); } \
        __builtin_amdgcn_global_load_lds((const unsigned*)(Krp + (size_t)(k0) * 64 + kro), (LAS unsigned*)(ldsl + D_OFF_KR + (st) * SHM_KR + wid * 1024), 16, 0, 0); } while (0)
#define AWAIT() asm volatile("s_waitcnt vmcnt(0)" ::: "memory")
#define RESC(a) do { if (__any((a) < 1.f)) { if (hi == 0) al_l[r32] = (a); asm volatile("s_waitcnt lgkmcnt(0)" ::: "memory"); \
    _Pragma("unroll") for (int d = 0; d < 4; ++d) _Pragma("unroll") for (int r = 0; r < 16; ++r) o[d][r] *= al_l[crow(r, hi)]; } } while (0)
    f32x16 pA0, pA1, pB0, pB1; float mnA, mnB, alA, alB; bf16x8 pa0, pa1, pa2, pa3;
    __syncthreads();
    ADMA(0, 0); ADMA(1, KVBLK);
    AWAIT(); __syncthreads();
    qkt12(pA0, pA1, K_lds, Kr_lds, qr, r32, hi); partialSM(pA0, pA1, m_reg, mnA, alA, Cl, false);
    int sa = 0, sb_ = 1, sc = 2;
#pragma unroll 1
    for (int j = 1; j + 1 < NT; j += 2) {
        ADMA(sc, (j + 1) * KVBLK);
        SBAR(); qkt12(pB0, pB1, K_lds + sb_ * SHM_K, Kr_lds + sb_ * SHM_KR, qr, r32, hi);
        finishSM(pA0, pA1, alA, l_reg, pa0, pa1, pa2, pa3); SBAR();
        pv_d0(o, vbb + sa * (int)SHM_V, pa0, pa1, pa2, pa3); partialSM(pB0, pB1, m_reg, mnB, alB, Cl, j > last_tile);
        RESC(alB); AWAIT(); __syncthreads();
        if (j + 2 < NT) ADMA(sa, (j + 2) * KVBLK);
        SBAR(); qkt12(pA0, pA1, K_lds + sc * SHM_K, Kr_lds + sc * SHM_KR, qr, r32, hi);
        finishSM(pB0, pB1, alB, l_reg, pa0, pa1, pa2, pa3); SBAR();
        pv_d0(o, vbb + sb_ * (int)SHM_V, pa0, pa1, pa2, pa3); partialSM(pA0, pA1, m_reg, mnA, alA, Cl, (j + 1) > last_tile);
        RESC(alA); AWAIT(); __syncthreads();
        const int t_ = sa; sa = sc; sc = sb_; sb_ = t_;
    }
    SBAR(); qkt12(pB0, pB1, K_lds + sb_ * SHM_K, Kr_lds + sb_ * SHM_KR, qr, r32, hi);
    finishSM(pA0, pA1, alA, l_reg, pa0, pa1, pa2, pa3); SBAR();
    pv_d0(o, vbb + sa * (int)SHM_V, pa0, pa1, pa2, pa3); partialSM(pB0, pB1, m_reg, mnB, alB, Cl, (NT - 1) > last_tile);
    RESC(alB);
    finishSM(pB0, pB1, alB, l_reg, pa0, pa1, pa2, pa3); SBAR();
    pv_d0(o, vbb + sb_ * (int)SHM_V, pa0, pa1, pa2, pa3);
    if (hi == 0) li_l[r32] = l_reg; asm volatile("s_waitcnt lgkmcnt(0)" ::: "memory");
    float rli[16];
#pragma unroll
    for (int r = 0; r < 16; ++r) rli[r] = __builtin_amdgcn_rcpf(li_l[crow(r, hi)]);
    bf16_t* Ow = Ob + (size_t)(wid * 32) * ldo;
#pragma unroll
    for (int r = 0; r < 16; ++r) { const int orow = crow(r, hi);
#pragma unroll
        for (int d0 = 0; d0 < 4; ++d0) Ow[(size_t)orow * ldo + d0 * 32 + r32] = f2bf(o[d0][r] * rli[r]); }
#undef ADMA
#undef AWAIT
#undef RESC
}
}

static_assert(att::SHM_ATTN <= LDS_MISC && att::SHM_ATTN_DMA <= LDS_MISC, "attention LDS");

struct Params {
    const float* in[29];
    float* out; unsigned char* ws;
    int ph_lo, ph_hi;
};

__device__ const double INVF[32] = {1.0, 0.7498942093324559, 0.5623413251903491, 0.4216965034285822, 0.31622776601683794, 0.23713737056616552, 0.1778279410038923, 0.1333521432163324, 0.1, 0.07498942093324558, 0.05623413251903491, 0.042169650342858224, 0.03162277660168379, 0.023713737056616554, 0.01778279410038923, 0.01333521432163324, 0.01, 0.007498942093324558, 0.005623413251903491, 0.004216965034285823, 0.0031622776601683794, 0.0023713737056616554, 0.0017782794100389228, 0.001333521432163324, 0.001, 0.0007498942093324559, 0.0005623413251903491, 0.00042169650342858224, 0.00031622776601683794, 0.00023713737056616554, 0.00017782794100389227, 0.0001333521432163324};

template <bool F16, class F>
__device__ __forceinline__ void build_bt(bf16_t* Bt0, const int N, const int K, const float* W0, const size_t wstride, const int ldw, const float* gain0, const int gstride, F srcmap,
                                         size_t& g, size_t& base, const size_t ngt) {
    const size_t per = (size_t)(N / 4) * (K / 8), total = per * DEPTH;
    for (; g < base + total; g += ngt) {
        const size_t b = g - base; const int l = (int)(b / per), r = (int)(b % per);
        const int n0 = (r % (N / 4)) * 4, k0 = (r / (N / 4)) * 8;
        float sc; const int src = srcmap(n0, sc);
        if (src == -2) continue;
        const float* W = W0 + (size_t)l * wstride;
        f32x4 v[8];
#pragma unroll
        for (int j = 0; j < 8; ++j) v[j] = (src >= 0) ? *(const f32x4*)(W + (size_t)(k0 + j) * ldw + src) : (f32x4){0.f, 0.f, 0.f, 0.f};
        if (gain0) {
#pragma unroll
            for (int j = 0; j < 8; ++j) v[j] *= gain0[(size_t)l * gstride + k0 + j] * sc;
        } else {
#pragma unroll
            for (int j = 0; j < 8; ++j) v[j] *= sc;
        }
        bf16_t* Bt = Bt0 + (size_t)l * W_LAYER + (size_t)n0 * K + k0;
#pragma unroll
        for (int e = 0; e < 4; ++e) {
            u32x4 w;
            if constexpr (F16) { w.x = cvt_pk_f16(v[0][e], v[1][e]); w.y = cvt_pk_f16(v[2][e], v[3][e]); w.z = cvt_pk_f16(v[4][e], v[5][e]); w.w = cvt_pk_f16(v[6][e], v[7][e]); }
            else { w.x = cvt_pk_bf16(v[0][e], v[1][e]); w.y = cvt_pk_bf16(v[2][e], v[3][e]); w.z = cvt_pk_bf16(v[4][e], v[5][e]); w.w = cvt_pk_bf16(v[6][e], v[7][e]); }
            *(u32x4*)(Bt + (size_t)e * K) = w;
        }
    }
    base += total;
}

__device__ __forceinline__ void sincos_d(double a, float& c, float& s) {
    const double k = __builtin_rint(a * 0.6366197723675814);
    double r = __builtin_fma(-k, 1.5707963267948966, a); r = __builtin_fma(-k, 6.123233995736766e-17, r);
    const double r2 = r * r;
    double sp = -7.647163731819816e-13; sp = sp * r2 + 1.6059043836821613e-10; sp = sp * r2 - 2.505210838544172e-08; sp = sp * r2 + 2.7557319223985893e-06;
    sp = sp * r2 - 1.984126984126984e-04; sp = sp * r2 + 8.333333333333333e-03; sp = sp * r2 - 1.6666666666666666e-01; sp = r + r * r2 * sp;
    double cp = 4.779477332387385e-14; cp = cp * r2 - 1.1470745597729725e-11; cp = cp * r2 + 2.08767569878681e-09; cp = cp * r2 - 2.755731922398589e-07;
    cp = cp * r2 + 2.48015873015873e-05; cp = cp * r2 - 1.388888888888889e-03; cp = cp * r2 + 4.1666666666666664e-02; cp = cp * r2 - 0.5; cp = 1.0 + r2 * cp;
    const int q = ((int)k) & 3;
    const double sv = (q == 0) ? sp : (q == 1) ? cp : (q == 2) ? -sp : -cp;
    const double cv = (q == 0) ? cp : (q == 1) ? -sp : (q == 2) ? -cp : sp;
    s = (float)sv; c = (float)cv;
}

constexpr int SEGL = 256, NSEG = SEQ / SEGL;

namespace scan {
typedef short bf16x4 __attribute__((ext_vector_type(4)));
constexpr int QT = 0, KT = 2048, KH = 4096, VT = 6144, DC = 8192, WREG = 8448;
template <int OFF> __device__ __forceinline__ bf16x4 trd(int addr) { bf16x4 r; asm volatile("ds_read_b64_tr_b16 %0, %1 offset:%2" : "=&v"(r) : "v"(addr), "i"(OFF) : "memory"); return r; }
__device__ __forceinline__ u32x4 pk8(const float* x) { u32x4 w; w.x = cvt_pk_bf16(x[0], x[1]); w.y = cvt_pk_bf16(x[2], x[3]); w.z = cvt_pk_bf16(x[4], x[5]); w.w = cvt_pk_bf16(x[6], x[7]); return w; }

template <int DK, bool OUT>
__device__ __forceinline__ void seg(const _Float16* la_base, const int la_stride, const bf16_t* q_base, const bf16_t* k_base, const bf16_t* v_base, const bf16_t* g_base,
                                    float* Sio, float* Pout, const float* gain, bf16_t* y_base, char* wl, const int lane_in) {
    constexpr int NM = DK / 16, NS = DK / 32;
    int lane = lane_in; asm volatile("" : "+v"(lane));
    const int l16 = lane & 15, g4 = lane >> 4, ch = lane & (DK - 1);
    const int wla = (int)(uintptr_t)wl;
    float* sbase = Sio + (4 * g4) * 64 + l16;
    f32x4 S[NM][4];
#pragma unroll
    for (int m = 0; m < NM; ++m)
#pragma unroll
        for (int n = 0; n < 4; ++n) {
            if constexpr (OUT) {
#pragma unroll
                for (int r = 0; r < 4; ++r) S[m][n][r] = sbase[(16 * m + r) * 64 + 16 * n];
            } else S[m][n] = (f32x4){0.f, 0.f, 0.f, 0.f};
        }
    float gn[4] = {1.f, 1.f, 1.f, 1.f};
    if constexpr (OUT) {
#pragma unroll
        for (int n = 0; n < 4; ++n) gn[n] = gain[16 * n + l16];
        asm volatile("s_waitcnt vmcnt(0)" ::: "memory");
    }
    float btot = 0.f;
    constexpr bool HALF = (DK == 32); constexpr int TT = HALF ? 8 : 16;
    const int hf = HALF ? (lane >> 5) : 0, tb = hf * 8;
    float la_n[TT]; unsigned short q_n[TT], k_n[TT], v_n[16];
#pragma unroll
    for (int t = 0; t < 16; ++t) v_n[t] = v_base[(size_t)t * 256 + lane];
#pragma unroll
    for (int t = 0; t < TT; ++t) { la_n[t] = (float)la_base[(size_t)(tb + t) * la_stride + ch]; k_n[t] = k_base[(size_t)(tb + t) * 256 + ch];
        if constexpr (OUT) q_n[t] = q_base[(size_t)(tb + t) * 256 + ch]; }
#pragma unroll 1
    for (int c = 0; c < SEGL / 16; ++c) {
        unsigned short gt16[4][4];
        if constexpr (OUT) {
#pragma unroll
            for (int r = 0; r < 4; ++r)
#pragma unroll
                for (int n = 0; n < 4; ++n) gt16[r][n] = g_base[((size_t)c * 16 + 4 * g4 + r) * 256 + 16 * n + l16];
        }
        unsigned qw[TT / 2], ktw[TT / 2], khw[TT / 2]; float bL;
        float pre = 0.f, post = 0.f, tot2 = 0.f;
        if constexpr (HALF) { float tot = 0.f;
#pragma unroll
            for (int t = 0; t < TT; ++t) tot += la_n[t];
            auto rr = __builtin_amdgcn_permlane32_swap(__float_as_uint(tot), __float_as_uint(tot), false, false);
            tot2 = __uint_as_float(rr[0]) + __uint_as_float(rr[1]);
            const float oth = tot2 - tot; pre = hf ? oth : 0.f; post = hf ? 0.f : oth; }
        if constexpr (OUT) { float b = pre;
#pragma unroll
            for (int tp = 0; tp < TT / 2; ++tp) {
                b += la_n[2 * tp]; const float e0 = b; b += la_n[2 * tp + 1]; const float e1 = b;
                qw[tp] = cvt_pk_bf16(bf2f(q_n[2 * tp]) * __builtin_amdgcn_exp2f(e0), bf2f(q_n[2 * tp + 1]) * __builtin_amdgcn_exp2f(e1));
                ktw[tp] = cvt_pk_bf16(bf2f(k_n[2 * tp]) * __builtin_amdgcn_exp2f(fminf(-e0, 115.f)), bf2f(k_n[2 * tp + 1]) * __builtin_amdgcn_exp2f(fminf(-e1, 115.f)));
            } }
        { float cs = post;
#pragma unroll
            for (int tp = TT / 2 - 1; tp >= 0; --tp) {
                const float h1 = bf2f(k_n[2 * tp + 1]) * __builtin_amdgcn_exp2f(cs); cs += la_n[2 * tp + 1];
                const float h0 = bf2f(k_n[2 * tp]) * __builtin_amdgcn_exp2f(cs); cs += la_n[2 * tp];
                khw[tp] = cvt_pk_bf16(h0, h1);
            }
            bL = HALF ? tot2 : cs; }
        btot += bL;
        u32x4 vv0, vv1;
        vv0.x = (unsigned)v_n[0] | ((unsigned)v_n[1] << 16); vv0.y = (unsigned)v_n[2] | ((unsigned)v_n[3] << 16); vv0.z = (unsigned)v_n[4] | ((unsigned)v_n[5] << 16); vv0.w = (unsigned)v_n[6] | ((unsigned)v_n[7] << 16);
        vv1.x = (unsigned)v_n[8] | ((unsigned)v_n[9] << 16); vv1.y = (unsigned)v_n[10] | ((unsigned)v_n[11] << 16); vv1.z = (unsigned)v_n[12] | ((unsigned)v_n[13] << 16); vv1.w = (unsigned)v_n[14] | ((unsigned)v_n[15] << 16);
        if (c + 1 < SEGL / 16) {
#pragma unroll
            for (int t = 0; t < 16; ++t) v_n[t] = v_base[((size_t)(c + 1) * 16 + t) * 256 + lane];
#pragma unroll
            for (int t = 0; t < TT; ++t) { const size_t tt = (size_t)(c + 1) * 16 + tb + t;
                la_n[t] = (float)la_base[tt * la_stride + ch]; k_n[t] = k_base[tt * 256 + ch];
                if constexpr (OUT) q_n[t] = q_base[tt * 256 + ch]; }
        }
        if constexpr (HALF) {
            *(u32x4*)(wl + KH + ch * 32 + hf * 16) = (u32x4){khw[0], khw[1], khw[2], khw[3]};
            if constexpr (OUT) { *(u32x4*)(wl + KT + ch * 32 + hf * 16) = (u32x4){ktw[0], ktw[1], ktw[2], ktw[3]}; *(u32x4*)(wl + QT + ch * 32 + hf * 16) = (u32x4){qw[0], qw[1], qw[2], qw[3]}; }
            if (lane < DK) *(float*)(wl + DC + ch * 4) = __builtin_amdgcn_exp2f(bL);
        } else if (lane < DK) {
            *(u32x4*)(wl + KH + ch * 32) = (u32x4){khw[0], khw[1], khw[2], khw[3]}; *(u32x4*)(wl + KH + ch * 32 + 16) = (u32x4){khw[4 % (TT / 2)], khw[5 % (TT / 2)], khw[6 % (TT / 2)], khw[7 % (TT / 2)]};
            if constexpr (OUT) { *(u32x4*)(wl + KT + ch * 32) = (u32x4){ktw[0], ktw[1], ktw[2], ktw[3]}; *(u32x4*)(wl + KT + ch * 32 + 16) = (u32x4){ktw[4 % (TT / 2)], ktw[5 % (TT / 2)], ktw[6 % (TT / 2)], ktw[7 % (TT / 2)]};
                                 *(u32x4*)(wl + QT + ch * 32) = (u32x4){qw[0], qw[1], qw[2], qw[3]}; *(u32x4*)(wl + QT + ch * 32 + 16) = (u32x4){qw[4 % (TT / 2)], qw[5 % (TT / 2)], qw[6 % (TT / 2)], qw[7 % (TT / 2)]}; }
            *(float*)(wl + DC + ch * 4) = __builtin_amdgcn_exp2f(bL);
        }
        *(u32x4*)(wl + VT + lane * 32) = vv0; *(u32x4*)(wl + VT + lane * 32 + 16) = vv1;
        asm volatile("s_waitcnt lgkmcnt(0)" ::: "memory");
        bf16x4 vf[4];
#pragma unroll
        for (int n = 0; n < 4; ++n) vf[n] = *(const bf16x4*)(wl + VT + (16 * n + l16) * 32 + g4 * 8);
        f32x4 O[4];
        if constexpr (OUT) {
            bf16x8 qf[NS], kf8[NS];
#pragma unroll
            for (int s2 = 0; s2 < NS; ++s2) {
                const int a0 = wla + (32 * s2 + 4 * g4) * 32 + l16 * 8;
                bf16x4 q0 = trd<QT>(a0), q1 = trd<QT + 512>(a0), k0 = trd<KT>(a0), k1 = trd<KT + 512>(a0);
                asm volatile("s_waitcnt lgkmcnt(0)" : "+v"(q0), "+v"(q1), "+v"(k0), "+v"(k1) :: "memory");
                qf[s2] = (bf16x8){q0[0], q0[1], q0[2], q0[3], q1[0], q1[1], q1[2], q1[3]};
                kf8[s2] = (bf16x8){k0[0], k0[1], k0[2], k0[3], k1[0], k1[1], k1[2], k1[3]};
            }
            __builtin_amdgcn_sched_barrier(0);
#pragma unroll
            for (int n = 0; n < 4; ++n) { O[n] = (f32x4){0.f, 0.f, 0.f, 0.f};
#pragma unroll
                for (int s2 = 0; s2 < NS; ++s2) {
                    u32x4 w; w.x = cvt_pk_bf16(S[2 * s2][n][0], S[2 * s2][n][1]); w.y = cvt_pk_bf16(S[2 * s2][n][2], S[2 * s2][n][3]);
                    w.z = cvt_pk_bf16(S[2 * s2 + 1][n][0], S[2 * s2 + 1][n][1]); w.w = cvt_pk_bf16(S[2 * s2 + 1][n][2], S[2 * s2 + 1][n][3]);
                    O[n] = __builtin_amdgcn_mfma_f32_16x16x32_bf16(qf[s2], *reinterpret_cast<bf16x8*>(&w), O[n], 0, 0, 0); } }
            f32x4 P = (f32x4){0.f, 0.f, 0.f, 0.f};
#pragma unroll
            for (int s2 = 0; s2 < NS; ++s2) P = __builtin_amdgcn_mfma_f32_16x16x32_bf16(kf8[s2], qf[s2], P, 0, 0, 0);
#pragma unroll
            for (int r = 0; r < 4; ++r) P[r] = (4 * g4 + r <= l16) ? P[r] : 0.f;
            u32x2 pw; pw.x = cvt_pk_bf16(P[0], P[1]); pw.y = cvt_pk_bf16(P[2], P[3]);
            const bf16x4 pf = *reinterpret_cast<bf16x4*>(&pw);
#pragma unroll
            for (int n = 0; n < 4; ++n) O[n] = __builtin_amdgcn_mfma_f32_16x16x16bf16_1k(pf, vf[n], O[n], 0, 0, 0);
        }
#pragma unroll
        for (int m = 0; m < NM; ++m) {
            const f32x4 dc = *(const f32x4*)(wl + DC + (16 * m + 4 * g4) * 4);
            const bf16x4 khf = *(const bf16x4*)(wl + KH + (16 * m + l16) * 32 + g4 * 8);
#pragma unroll
            for (int n = 0; n < 4; ++n) S[m][n] = __builtin_amdgcn_mfma_f32_16x16x16bf16_1k(khf, vf[n], S[m][n] * dc, 0, 0, 0);
        }
        if constexpr (OUT) {
            float ss[4];
#pragma unroll
            for (int r = 0; r < 4; ++r) { ss[r] = (O[0][r] * O[0][r] + O[1][r] * O[1][r]) + (O[2][r] * O[2][r] + O[3][r] * O[3][r]); ss[r] = sum16(ss[r]); }
#pragma unroll
            for (int r = 0; r < 4; ++r) { const float rs = __builtin_amdgcn_rsqf(ss[r] * (1.0f / 64.0f) + EPS); const size_t tt = (size_t)c * 16 + 4 * g4 + r;
#pragma unroll
                for (int n = 0; n < 4; ++n) { const float gt_ = bf2f(gt16[r][n]);
                    y_base[tt * 1024 + 16 * n + l16] = f2bf(O[n][r] * rs * gn[n] * gt_); } }
        }
    }
    if constexpr (!OUT) {
#pragma unroll
        for (int m = 0; m < NM; ++m)
#pragma unroll
            for (int n = 0; n < 4; ++n)
#pragma unroll
                for (int r = 0; r < 4; ++r) sbase[(16 * m + r) * 64 + 16 * n] = S[m][n][r];
        if (lane < DK) Pout[ch] = __builtin_amdgcn_exp2f(btot);
    }
}
}

__device__ __forceinline__ int opq(int i) { asm volatile("" : "+s"(i)); return i; }

constexpr int NPH = 18, NPRE = 3, NPHASES = NPRE + DEPTH * NPH;

template <int SEL>
__global__ void __launch_bounds__(NTHREADS, 2) mk_fwd(Params p) {
    extern __shared__ __attribute__((aligned(16))) unsigned char lds[];
    const int bx = blockIdx.x, G = gridDim.x;
    const size_t ngt = (size_t)G * NTHREADS;
    const int ngw = G * NWAVES;
    PG8_LAS unsigned char* glds = (PG8_LAS unsigned char*)lds;
#define PHASE_BEGIN \
    int tid = threadIdx.x; asm volatile("" : "+v"(tid)); \
    const int lane = tid & 63, wave = __builtin_amdgcn_readfirstlane(tid >> 6); \
    const size_t gt = (size_t)bx * NTHREADS + tid; const int gw = bx * NWAVES + wave; \
    size_t wsz_ = 0; asm volatile("" : "+s"(wsz_)); unsigned char* ws = p.ws + wsz_;     \
    (void)lane; (void)wave; (void)gt; (void)gw;
#define PIN(i) (p.in[opq(i)])
#if MK_FUSED
    volatile LAS unsigned* misc = (volatile LAS unsigned*)((LAS unsigned char*)lds + LDS_MISC);
    if (threadIdx.x < 4) misc[threadIdx.x] = 0u;
    __syncthreads();
    XcdBarrier bar = xcd_barrier_post((unsigned*)(p.ws + WS_CTL), misc);
#define GRID_BAR() xcd_barrier(bar)
#else
#define GRID_BAR() do { } while (0)
#endif
    const int lo = p.ph_lo, hi = p.ph_hi;
#define PHSEL(i) (SEL < 0 || (i) + 1 == SEL)
#define INR(k) (lo <= (k) && (k) < hi)
#define IN(k) (PHSEL(-1) && INR(k))
#define SEAM(k) do { if (INR(k) && INR((k) + 1)) { GRID_BAR(); if ((PROBE_MASK >> 29) & 1) GRID_BAR(); } } while (0)
#define INP(i) (PHSEL(i) && INR(pb + (i)))
#define SEAMP(i) SEAM(pb + (i))

#define x_in (PIN(0))
#define hout (p.out)
#define lbt ((float*)(ws + WS_LB))
#define rstd ((float*)(ws + WS_RSTD))
#define part ((float*)(ws + WS_PART))
#define latpb ((float*)(ws + WS_LATP))
#define cq ((float*)(ws + WS_CQ))
#define ckv ((float*)(ws + WS_CKV))
#define memrstd ((float*)(ws + WS_MEMRSTD))
#define memb ((bf16_t*)(ws + WS_MEMB))
#define kvraw_ca ((float*)(ws + WS_R))
#define kca ((bf16_t*)(ws + WS_KCA))
#define vca ((bf16_t*)(ws + WS_VCA))
#define rot ((f32x2*)(ws + WS_ROT))
#define wall ((bf16_t*)(ws + WS_W))
#define hb ((bf16_t*)(ws + WS_HB))
#define gqk ((bf16_t*)(ws + R_GQK))
#define gv ((bf16_t*)(ws + R_GV))
#define gr ((bf16_t*)(ws + R_GR))
#define hq ((bf16_t*)(ws + R_HQ))
#define hi_ ((bf16_t*)(ws + R_HI))
#define hg ((bf16_t*)(ws + R_HG))
#define hk ((bf16_t*)(ws + R_HK))
#define ga ((const _Float16*)(ws + R_GA))
#define ha ((const _Float16*)(ws + R_HA))
#define qlat ((bf16_t*)(ws + R_QLAT))
#define kvlat ((bf16_t*)(ws + R_KVLAT))
#define krope ((bf16_t*)(ws + R_KROPE))
#define ybuf ((bf16_t*)(ws + R_Y))
#define sg ((float*)(ws + R_SG))
#define sh ((float*)(ws + R_SH))
#define pg ((float*)(ws + R_PG))
#define ph ((float*)(ws + R_PH))
#define qb ((bf16_t*)(ws + R_Q))
#define krh ((bf16_t*)(ws + R_KRH))
#define qraw ((bf16_t*)(ws + R_QRAW))
#define kvraw ((bf16_t*)(ws + R_KVRAW))
#define kn ((bf16_t*)(ws + R_KN))
#define vb ((bf16_t*)(ws + R_V))
#define qca ((bf16_t*)(ws + R_QCA))
#define oca ((bf16_t*)(ws + R_OCA))
#define ghb ((float*)(ws + R_GH))
#define uhb ((float*)(ws + R_UH))
#define uraw ((bf16_t*)(ws + R_URAW))

#define NORM_PHASE(SRC) do {   \
        for (int r0 = gw * 4; r0 < T; r0 += ngw * 4) { \
            f32x4 v[4][4]; float s[4]; \
            _Pragma("unroll") for (int q = 0; q < 4; ++q) { const f32x4* xr = (const f32x4*)((SRC) + (size_t)(r0 + q) * DM) + lane; \
                _Pragma("unroll") for (int j = 0; j < 4; ++j) v[q][j] = xr[64 * j]; } \
            _Pragma("unroll") for (int q = 0; q < 4; ++q) { float a = 0.f; \
                _Pragma("unroll") for (int j = 0; j < 4; ++j) a += (v[q][j][0] * v[q][j][0] + v[q][j][1] * v[q][j][1]) + (v[q][j][2] * v[q][j][2] + v[q][j][3] * v[q][j][3]); \
                s[q] = wave_sum_dpp(a); } \
            _Pragma("unroll") for (int q = 0; q < 4; ++q) { \
                if (lane < 16) part[(size_t)(r0 + q) * 16 + lane] = (lane == 0) ? s[q] : 0.f; \
                u32x2* o8 = (u32x2*)(hb + (size_t)(r0 + q) * DM) + lane; \
                _Pragma("unroll") for (int j = 0; j < 4; ++j) o8[64 * j] = (u32x2){cvt_pk_f16(v[q][j][0], v[q][j][1]), cvt_pk_f16(v[q][j][2], v[q][j][3])}; } \
        } } while (0)
    if (IN(0)) { for (int rep0_ = 0; rep0_ < (((PROBE_MASK >> 30) & 1) ? 2 : 1); ++rep0_) {
        PHASE_BEGIN
        {
            size_t g = gt, base = 0;
            build_bt<true>(wall + W_IN, 2560, 1024, PIN(4), (size_t)DM * P_IN, P_IN, PIN(3), DM, [](int n, float& sc) -> int { sc = 1.f;
                if (n < 512) return n;
                if (n < 640) { sc = 0.17677669529663687f; return 576 + (n - 512); }
                if (n < 768) return 704 + (n - 640);
                if (n < 896) return -2;
                if (n < 960) return 512 + (n - 896);
                if (n < 1024) return -1;
                if (n < 1280) return 832 + (n - 1024);
                if (n < 1536) return 1104 + (n - 1280);
                return 1360 + (n - 1536); }, g, base, ngt);
            build_bt<false>(wall + W_Q, 1024, 256, PIN(6), (size_t)256 * 768, 768, PIN(5), 256, [](int n, float& sc) -> int { sc = 1.f; const int h = n >> 8, c = n & 255;
                if (c < 128) return h * 192 + c;
                if (c >= 192) return -1;
                const int cc = c - 128, jb = 4 * (4 * (cc >> 5) + ((cc >> 3) & 3)), i8 = cc & 7;
                return h * 192 + (i8 < 4 ? 128 + jb + i8 : 160 + jb + (i8 - 4)); }, g, base, ngt);
            build_bt<false>(wall + W_KV, 1024, 256, PIN(8), (size_t)256 * 1024, 1024, PIN(7), 256, [](int n, float& sc) -> int { sc = 1.f; return n; }, g, base, ngt);
            build_bt<false>(wall + W_MIX, 1024, 1024, PIN(16), (size_t)1024 * 1024, 1024, nullptr, 0, [](int n, float& sc) -> int { sc = 1.f; return n; }, g, base, ngt);
            build_bt<true>(wall + W_CAQ, 512, 1024, PIN(19), (size_t)1024 * 512, 512, PIN(17), DM, [](int n, float& sc) -> int { sc = 1.f; return n; }, g, base, ngt);
            build_bt<false>(wall + W_CAKV, 1024, 1024, PIN(20), (size_t)1024 * 1024, 1024, PIN(18), DM, [](int n, float& sc) -> int { sc = 1.f; return n; }, g, base, ngt);
            build_bt<false>(wall + W_CAO, 1024, 512, PIN(23), (size_t)512 * 1024, 1024, nullptr, 0, [](int n, float& sc) -> int { sc = 1.f; return n; }, g, base, ngt);
            build_bt<true>(wall + W_FFI, 5632, 1024, PIN(25), (size_t)1024 * 5632, 5632, PIN(24), DM, [](int n, float& sc) -> int { sc = 1.f; const int j = n >> 8, c = n & 255; return c < 128 ? 128 * j + c : 2816 + 128 * j + (c - 128); }, g, base, ngt);
            build_bt<true>(wall + W_FFO, 1024, 2816, PIN(28), (size_t)2816 * 1024, 1024, nullptr, 0, [](int n, float& sc) -> int { sc = 1.f; return n; }, g, base, ngt);
            for (size_t it = gt; it < (size_t)DEPTH * 128 * 128; it += ngt) {
                const int l = (int)(it >> 14), j = (int)(it & 127), k0 = (int)((it >> 7) & 127) * 8;
                const float* w_in = PIN(4) + (size_t)l * DM * P_IN; const float* wg = PIN(11) + (size_t)l * 16 * 128; const float* gain = PIN(3) + l * DM;
                float v[8];
#pragma unroll
                for (int e = 0; e < 8; ++e) { float s = 0.f;
#pragma unroll
                    for (int r = 0; r < 16; ++r) s = fmaf(w_in[(size_t)(k0 + e) * P_IN + 1088 + r], wg[r * 128 + j], s);
                    v[e] = s * gain[k0 + e]; }
                u32x4 w; w.x = cvt_pk_f16(v[0], v[1]); w.y = cvt_pk_f16(v[2], v[3]); w.z = cvt_pk_f16(v[4], v[5]); w.w = cvt_pk_f16(v[6], v[7]);
                *(u32x4*)(wall + (size_t)l * W_LAYER + W_IN + (size_t)(768 + j) * 1024 + k0) = w;
            }
        }
        for (size_t it = gt; it < (size_t)T * 32; it += ngt) {
            const int j = (int)(it & 31); const size_t t = it >> 5;
            const int pos = ((const int*)PIN(2))[t];
            float c, s; sincos_d((double)pos * INVF[j], c, s);
            rot[it] = (f32x2){c, s};
        }
        if (gt < 256) {
            const float* lg = PIN(14);
            const float a0 = lg[gt], a1 = lg[256 + gt], a2 = lg[512 + gt], a3 = lg[768 + gt];
            const float mx = fmaxf(fmaxf(a0, a1), fmaxf(a2, a3));
            const float e0 = expf(a0 - mx), e1 = expf(a1 - mx), e2 = expf(a2 - mx), e3 = expf(a3 - mx), inv = 1.0f / (e0 + e1 + e2 + e3);
            lbt[gt] = 0.f; lbt[256 + gt] = e1 * inv; lbt[512 + gt] = (e1 + e2) * inv; lbt[768 + gt] = (e1 + e2 + e3) * inv;
        }
        for (int r = gw; r < NB * NMEM; r += ngw) {
            const f32x4* xr = (const f32x4*)(PIN(1) + (size_t)r * DM) + lane;
            f32x4 v[4]; float s = 0.f;
#pragma unroll
            for (int j = 0; j < 4; ++j) { v[j] = xr[64 * j]; s += (v[j][0] * v[j][0] + v[j][1] * v[j][1]) + (v[j][2] * v[j][2] + v[j][3] * v[j][3]); }
            s = wave_sum(s);
            if (lane == 0) memrstd[r] = 1.0f / sqrtf(s * (1.0f / DM) + EPS);
            u32x2* o8 = (u32x2*)(memb + (size_t)r * DM) + lane;
#pragma unroll
            for (int j = 0; j < 4; ++j) o8[64 * j] = (u32x2){cvt_pk_bf16(v[j][0], v[j][1]), cvt_pk_bf16(v[j][2], v[j][3])};
        }
        NORM_PHASE(x_in);
    } }
    SEAM(0);
    if (IN(1)) { PHASE_BEGIN
#pragma unroll 1
        for (int l = 0; l < DEPTH; ++l) {
            pg8::Gemm g{memb, wall + (size_t)l * W_LAYER + W_CAKV, NB * NMEM, 1024, 1024}; pg8::StaticOrder S; S.init(NB * NMEM, 1024, G, (bx + G - 32 * l) % G);
            EpiScaleF32 E{memrstd, kvraw_ca + (size_t)l * 2048 * 1024, 1024};
            pg8::gemm_phase<EpiScaleF32, pg8::StaticOrder>(glds, g, S, E);
            __syncthreads();
        }
    }
    SEAM(1);
    if (IN(2)) { PHASE_BEGIN
#pragma unroll 1
        for (int l = 0; l < DEPTH; ++l) {
            const float* kvraw_l = kvraw_ca + (size_t)l * 2048 * 1024; bf16_t* kca_l = kca + (size_t)l * 2048 * 512; bf16_t* vca_l = vca + (size_t)l * 2048 * 512;

            const float* qg = PIN(21) + l * 128; const float* kg = PIN(22) + l * 128;
            const int h = lane >> 4, i = lane & 15;
            for (int r = gw; r < NB * NMEM; r += ngw) {
                const int b = r >> 8, m = r & 255;
                const float* src = kvraw_l + (size_t)r * 1024 + h * 256;
                const f32x4 k0 = *(const f32x4*)(src + 8 * i), k1 = *(const f32x4*)(src + 8 * i + 4), v0 = *(const f32x4*)(src + 128 + 8 * i), v1 = *(const f32x4*)(src + 128 + 8 * i + 4);
                float ss = (k0[0] * k0[0] + k0[1] * k0[1]) + (k0[2] * k0[2] + k0[3] * k0[3]) + (k1[0] * k1[0] + k1[1] * k1[1]) + (k1[2] * k1[2] + k1[3] * k1[3]);
                ss = sum16(ss);
                const float rs = 1.0f / sqrtf(ss * (1.0f / 128.0f) + EPS);
                const f32x4 g0 = *(const f32x4*)(kg + 8 * i) * *(const f32x4*)(qg + 8 * i), g1 = *(const f32x4*)(kg + 8 * i + 4) * *(const f32x4*)(qg + 8 * i + 4);
                const size_t o = ((size_t)(b * 4 + h) * NMEM + m) * 128 + 8 * i;
                *(u32x4*)(kca_l + o) = pack8(k0 * rs * g0, k1 * rs * g1);
                *(u32x4*)(vca_l + o) = pack8(v0, v1);
            }
        }
    }
    SEAM(2);

    for (int l = 0; l < DEPTH; ++l) {
        const int pb = NPRE + l * NPH;
#define wl (wall + (size_t)l * W_LAYER)
#define hsrc0 ((l == 0) ? x_in : (const float*)hout)


        if (INP(1)) { _Pragma("unroll 1") for (int rep_ = 0; rep_ < (((PROBE_MASK >> 1) & 1) ? 2 : 1); ++rep_) { PHASE_BEGIN
            int bxo = bx; asm volatile("" : "+s"(bxo));
            pg8::Gemm g{hb, wl + W_IN, T, 2560, 1024}; pg8::StaticOrderG1 S; S.init(T, 2560, G, bxo);
            EpiInProj E{ws, PIN(12) + l * 128, lbt + l * 256, (PG8_LAS float*)(glds + LDS_STAGE)};
            pg8::gemm_phase<EpiInProj, pg8::StaticOrderG1, true>(glds, g, S, E);
        } }
        SEAMP(1);

        if (INP(2)) { _Pragma("unroll 1") for (int rep_ = 0; rep_ < (((PROBE_MASK >> 2) & 1) ? 2 : 1); ++rep_) { PHASE_BEGIN
            for (int uu = bx; uu < 256; uu += G) {
                const int j = uu * 4 + (wave & 3), head = j & 3, seg = (j >> 2) & 31, b = j >> 7;
                const size_t t0 = (size_t)b * SEQ + (size_t)seg * SEGL; const int un = (b * 4 + head) * NSEG + seg;
                char* wlp = (char*)lds + wave * scan::WREG;
                if (wave < 4) scan::seg<32, false>(ga + t0 * 128 + head * 32, 128, nullptr, gqk + t0 * 256 + 128 + head * 32, gv + t0 * 256 + head * 64, nullptr, sg + (size_t)un * 2048, pg + (size_t)un * 32, nullptr, nullptr, wlp, lane);
                else          scan::seg<64, false>(ha + t0 * 256 + head * 64, 256, nullptr, hk + t0 * 256 + head * 64, hi_ + t0 * 256 + head * 64, nullptr, sh + (size_t)un * 4096, ph + (size_t)un * 64, nullptr, nullptr, wlp, lane);
            }
        } }
        SEAMP(2);

        if (INP(3)) { _Pragma("unroll 1") for (int rep_ = 0; rep_ < (((PROBE_MASK >> 3) & 1) ? 2 : 1); ++rep_) { PHASE_BEGIN
            for (size_t c = gt; c < (size_t)32 * 32 * 64; c += ngt) {
                const int bh = (int)(c >> 11), d = (int)(c >> 6) & 31, e = (int)c & 63;
                float* a0 = sg + (size_t)bh * NSEG * 2048 + d * 64 + e; const float* p0 = pg + (size_t)bh * NSEG * 32 + d;
                float sv[NSEG], pv[NSEG];
#pragma unroll
                for (int q = 0; q < NSEG; ++q) { sv[q] = a0[(size_t)q * 2048]; pv[q] = p0[q * 32]; }
                float carry = 0.f;
#pragma unroll
                for (int q = 0; q < NSEG; ++q) { const float tmp = sv[q]; a0[(size_t)q * 2048] = carry; carry = fmaf(pv[q], carry, tmp); }
            }
            for (size_t c = gt; c < (size_t)32 * 64 * 64; c += ngt) {
                const int bh = (int)(c >> 12), d = (int)(c >> 6) & 63, e = (int)c & 63;
                float* a0 = sh + (size_t)bh * NSEG * 4096 + d * 64 + e; const float* p0 = ph + (size_t)bh * NSEG * 64 + d;
                float sv[NSEG], pv[NSEG];
#pragma unroll
                for (int q = 0; q < NSEG; ++q) { sv[q] = a0[(size_t)q * 4096]; pv[q] = p0[q * 64]; }
                float carry = 0.f;
#pragma unroll
                for (int q = 0; q < NSEG; ++q) { const float tmp = sv[q]; a0[(size_t)q * 4096] = carry; carry = fmaf(pv[q], carry, tmp); }
            }
        } }
        SEAMP(3);

        if (INP(4)) { _Pragma("unroll 1") for (int rep_ = 0; rep_ < (((PROBE_MASK >> 4) & 1) ? 2 : 1); ++rep_) { PHASE_BEGIN
            for (int uu = bx; uu < 256; uu += G) {
                const int j = uu * 4 + (wave & 3), head = j & 3, seg = (j >> 2) & 31, b = j >> 7;
                const size_t t0 = (size_t)b * SEQ + (size_t)seg * SEGL; const int un = (b * 4 + head) * NSEG + seg;
                char* wlp = (char*)lds + wave * scan::WREG;
                if (wave < 4) scan::seg<32, true>(ga + t0 * 128 + head * 32, 128, gqk + t0 * 256 + head * 32, gqk + t0 * 256 + 128 + head * 32, gv + t0 * 256 + head * 64, gr + t0 * 256 + head * 64,
                                                  sg + (size_t)un * 2048, nullptr, PIN(13) + l * 64, ybuf + t0 * 1024 + 512 + head * 64, wlp, lane);
                else          scan::seg<64, true>(ha + t0 * 256 + head * 64, 256, hq + t0 * 256 + head * 64, hk + t0 * 256 + head * 64, hi_ + t0 * 256 + head * 64, hg + t0 * 256 + head * 64,
                                                  sh + (size_t)un * 4096, nullptr, PIN(15) + l * 64, ybuf + t0 * 1024 + 768 + head * 64, wlp, lane);
            }
        } }
        SEAMP(4);

        if (INP(5)) { _Pragma("unroll 1") for (int rep_ = 0; rep_ < (((PROBE_MASK >> 5) & 1) ? 2 : 1); ++rep_) { PHASE_BEGIN
            { int k256 = 256; asm volatile("" : "+s"(k256)); pg8::Gemm g{qlat, wl + W_Q, T, 1024, k256}; pg8::StaticOrder S; S.init(T, 1024, G, bx);
              EpiQUp E{ws, PIN(9) + l * 192, (PG8_LAS float*)(glds + LDS_STAGE), (PG8_LAS float*)(glds + LDS_STAGE + 4096)};
              pg8::gemm_phase<EpiQUp, pg8::StaticOrder>(glds, g, S, E); }
            __syncthreads();
            { int k256 = 256; asm volatile("" : "+s"(k256)); pg8::Gemm g{kvlat, wl + W_KV, T, 1024, k256}; pg8::StaticOrder S; S.init(T, 1024, G, bx);
              EpiKVUp E{ws, PIN(10) + l * 192, (PG8_LAS float*)(glds + LDS_STAGE), (PG8_LAS float*)(glds + LDS_STAGE + 4096)};
              pg8::gemm_phase<EpiKVUp, pg8::StaticOrder>(glds, g, S, E); }
        } }
        SEAMP(5);

        if (INP(7)) { _Pragma("unroll 1") for (int rep_ = 0; rep_ < (((PROBE_MASK >> 7) & 1) ? 2 : 1); ++rep_) { PHASE_BEGIN
#pragma unroll 1
            for (int uid = bx * 4; uid < 1024; uid += G * 4) {
            const int vbx = uid >> 2;
            const int bh = (vbx & 7) * 4 + ((vbx >> 3) & 3), gg = (vbx >> 5) & 7, b = bh >> 2, h = bh & 3;
#pragma unroll 1
            for (int ui = 0; ui < 3; ++ui) {
                const int qblk = (ui == 0) ? 31 - gg : (ui == 1) ? 16 + gg : 15 - gg;
                att::attn_body_dma(qb + ((size_t)bh * SEQ + (size_t)qblk * 256) * 192, 192, kn + (size_t)bh * SEQ * 128, krh + (size_t)bh * SEQ * 64, vb + (size_t)bh * SEQ * 128,
                                  ybuf + ((size_t)b * SEQ + (size_t)qblk * 256) * 1024 + h * 128, 1024, 4 * qblk + 4, 4 * qblk + (wave >> 1), (char*)lds, (LAS unsigned char*)lds);
            }
            }
            {
                volatile LAS int* slot = (volatile LAS int*)((LAS unsigned char*)lds + LDS_MISC + 128);
                int* ctr = (int*)(ws + WS_CTL + 16384 + l * 64);
#pragma unroll 1
                for (;;) {
                    __syncthreads();
                    if (tid == 0) *slot = atomicAdd(ctr, 1);
                    __syncthreads();
                    const int u = __builtin_amdgcn_readfirstlane(*slot);
                    if (u >= 256) break;
                    const int qblk = 7 - (u >> 5), bh = u & 31, b = bh >> 2, h = bh & 3;
                    att::attn_body_dma(qb + ((size_t)bh * SEQ + (size_t)qblk * 256) * 192, 192, kn + (size_t)bh * SEQ * 128, krh + (size_t)bh * SEQ * 64, vb + (size_t)bh * SEQ * 128,
                                      ybuf + ((size_t)b * SEQ + (size_t)qblk * 256) * 1024 + h * 128, 1024, 4 * qblk + 4, 4 * qblk + (wave >> 1), (char*)lds, (LAS unsigned char*)lds);
                }
            }
        } }
        SEAMP(7);

        if (INP(8)) { _Pragma("unroll 1") for (int rep_ = 0; rep_ < (((PROBE_MASK >> 8) & 1) ? 2 : 1); ++rep_) { PHASE_BEGIN
#pragma unroll 1
            for (int pm = bx; pm < T / 256; pm += G) {
                { pg8::Gemm g{ybuf, wl + W_MIX, T, 1024, 1024}; pg8::PanelOrder S{pm, 4}; EpiResid E{hb, hb, hout, part, 0};
                  pg8::gemm_phase<EpiResid, pg8::PanelOrder>(glds, g, S, E); }
                __syncthreads();
                { pg8::Gemm g{hb, wl + W_CAQ, T, 512, 1024}; pg8::PanelOrder S{pm, 2}; EpiScaleBf16<true> E{part, qca, 512, (PG8_LAS float*)(glds + LDS_STAGE)};
                  pg8::gemm_phase<EpiScaleBf16<true>, pg8::PanelOrder, true>(glds, g, S, E); }
                __syncthreads();
                { const int b = pm >> 5, qblk = pm & 31;
#pragma unroll 1
                  for (int h = 0; h < 4; ++h) { const int bh = b * 4 + h;
                      att::attn_body<1, 2>(qca + ((size_t)b * SEQ + (size_t)qblk * 256) * 512 + h * 128, 512, kca + (size_t)l * 2048 * 512 + (size_t)bh * NMEM * 128, nullptr, vca + (size_t)l * 2048 * 512 + (size_t)bh * NMEM * 128,
                                        oca + ((size_t)b * SEQ + (size_t)qblk * 256) * 512 + h * 128, 512, 4, 1 << 30, (char*)lds); } }
                __syncthreads();
                { pg8::Gemm g{oca, wl + W_CAO, T, 1024, 512}; pg8::PanelOrder S{pm, 4}; EpiResid E{hb, hb, hout, part, 0};
                  pg8::gemm_phase<EpiResid, pg8::PanelOrder>(glds, g, S, E); }
                __syncthreads();
            }
        } }
        SEAMP(8);

        if (false) { }

        if (INP(15)) { _Pragma("unroll 1") for (int rep_ = 0; rep_ < (((PROBE_MASK >> 15) & 1) ? 2 : 1); ++rep_) { PHASE_BEGIN
            pg8::Gemm g{hb, wl + W_FFI, T, 5632, 1024}; pg8::StaticOrder S; S.init(T, 5632, G, bx);
            EpiGateUpConv E{part, uraw, ghb, uhb, PIN(26) + (size_t)l * 3 * D_FF, PIN(27) + (size_t)l * D_FF, (PG8_LAS float*)(glds + LDS_STAGE), (PG8_LAS float*)(glds + LDS_STAGE + 4096)};
            pg8::gemm_phase<EpiGateUpConv, pg8::StaticOrder, true>(glds, g, S, E);
        } }
        SEAMP(15);

        if (INP(16)) { _Pragma("unroll 1") for (int rep_ = 0; rep_ < (((PROBE_MASK >> 16) & 1) ? 2 : 1); ++rep_) { PHASE_BEGIN
            const float* cw = PIN(26) + (size_t)l * 3 * D_FF; const float* cbias = PIN(27) + (size_t)l * D_FF;
            for (size_t it = gt; it < (size_t)256 * (D_FF / 8); it += ngt) {
                const int c = (int)(it % (D_FF / 8)) * 8, pm = (int)(it / (D_FF / 8));
                if ((pm & 31) == 0) continue;
                f32x4 gm2[2], gm1[2], g0[2], g1[2], w0[2], w1[2], w2[2], bb[2], u0[2], u1[2];
#pragma unroll
                for (int hh = 0; hh < 2; ++hh) { const int cc = c + 4 * hh;
                    gm2[hh] = *(const f32x4*)(ghb + ((size_t)(pm - 1) * 4 + 0) * D_FF + cc); gm1[hh] = *(const f32x4*)(ghb + ((size_t)(pm - 1) * 4 + 1) * D_FF + cc);
                    g0[hh] = *(const f32x4*)(ghb + ((size_t)pm * 4 + 2) * D_FF + cc); g1[hh] = *(const f32x4*)(ghb + ((size_t)pm * 4 + 3) * D_FF + cc);
                    u0[hh] = *(const f32x4*)(uhb + ((size_t)pm * 2) * D_FF + cc); u1[hh] = *(const f32x4*)(uhb + ((size_t)pm * 2 + 1) * D_FF + cc);
                    w0[hh] = *(const f32x4*)(cw + cc); w1[hh] = *(const f32x4*)(cw + D_FF + cc); w2[hh] = *(const f32x4*)(cw + 2 * D_FF + cc); bb[hh] = *(const f32x4*)(cbias + cc); }
                float o0[8], o1[8];
#pragma unroll
                for (int hh = 0; hh < 2; ++hh)
#pragma unroll
                    for (int e = 0; e < 4; ++e) {
                        const float c0v = bb[hh][e] + gm2[hh][e] * w0[hh][e] + gm1[hh][e] * w1[hh][e] + g0[hh][e] * w2[hh][e], c1v = bb[hh][e] + gm1[hh][e] * w0[hh][e] + g0[hh][e] * w1[hh][e] + g1[hh][e] * w2[hh][e];
                        o0[4 * hh + e] = fast_silu(c0v) * u0[hh][e]; o1[4 * hh + e] = fast_silu(c1v) * u1[hh][e]; }
                *(u32x4*)(uraw + ((size_t)pm * 256) * D_FF + c) = (u32x4){cvt_pk_f16(o0[0], o0[1]), cvt_pk_f16(o0[2], o0[3]), cvt_pk_f16(o0[4], o0[5]), cvt_pk_f16(o0[6], o0[7])};
                *(u32x4*)(uraw + ((size_t)pm * 256 + 1) * D_FF + c) = (u32x4){cvt_pk_f16(o1[0], o1[1]), cvt_pk_f16(o1[2], o1[3]), cvt_pk_f16(o1[4], o1[5]), cvt_pk_f16(o1[6], o1[7])};
            }
        } }
        SEAMP(16);

        if (INP(17)) { _Pragma("unroll 1") for (int rep_ = 0; rep_ < (((PROBE_MASK >> 17) & 1) ? 2 : 1); ++rep_) { PHASE_BEGIN
            pg8::Gemm g{uraw, wl + W_FFO, T, 1024, 2816}; pg8::StaticOrder S; S.init(T, 1024, G, bx); EpiResid E{hb, (((PROBE_MASK >> 17) & 1) && rep_ == 0) ? (bf16_t*)(ws + WS_R + 32 * MiB) : hb, hout, part, ((l == DEPTH - 1) && !(((PROBE_MASK >> 17) & 1) && rep_ == 0)) ? 1 : 0};
            pg8::gemm_phase<EpiResid, pg8::StaticOrder, true>(glds, g, S, E);
        } }
        SEAMP(17);
    }
#undef IN
#undef SEAM
#undef INP
#undef SEAMP
#undef INR
#undef PHSEL
#undef PHASE_BEGIN
#undef PIN
#undef x_in
#undef hout
#undef lbt
#undef rstd
#undef part
#undef latpb
#undef cq
#undef ckv
#undef memrstd
#undef memb
#undef kvraw_ca
#undef kca
#undef vca
#undef rot
#undef wall
#undef hb
#undef gqk
#undef gv
#undef gr
#undef hq
#undef hi_
#undef hg
#undef hk
#undef ga
#undef ha
#undef qlat
#undef kvlat
#undef krope
#undef ybuf
#undef sg
#undef sh
#undef pg
#undef ph
#undef qb
#undef krh
#undef qraw
#undef kvraw
#undef kn
#undef vb
#undef qca
#undef oca
#undef ghb
#undef uhb
#undef uraw
#undef wl
#undef hsrc0
}

typedef void (*kern_t)(Params);
extern "C" void kernel_launch(void* const* d_in, const int* in_sizes, int n_in, void* d_out, int out_size, void* d_ws, size_t ws_size, hipStream_t stream) {
#if MK_FUSED
    static const kern_t kt[1] = {mk_fwd<-1>};
    constexpr int NK = 1;
#else
    static const kern_t kt[19] = {mk_fwd<0>, mk_fwd<1>, mk_fwd<2>, mk_fwd<3>, mk_fwd<4>, mk_fwd<5>, mk_fwd<6>, mk_fwd<7>, mk_fwd<8>, mk_fwd<9>, mk_fwd<10>, mk_fwd<11>, mk_fwd<12>, mk_fwd<13>, mk_fwd<14>,
                                  mk_fwd<15>, mk_fwd<16>, mk_fwd<17>, mk_fwd<18>};
    constexpr int NK = 19;
#endif
    static int grid = 0;
    if (grid == 0) {
        if (n_in != 29 || out_size != T * DM || ws_size < WS_END) { fprintf(stderr, "kernel_launch: unexpected shapes (n_in %d out %d ws %zu need %zu)\n", n_in, out_size, ws_size, (size_t)WS_END); grid = -1; return; }
        int dev = 0, cus = 0, per_cu = 0;
        if (hipGetDevice(&dev) != hipSuccess || hipDeviceGetAttribute(&cus, hipDeviceAttributeMultiprocessorCount, dev) != hipSuccess) { grid = -1; return; }
        for (int i = 0; i < NK; ++i)
            if (hipFuncSetAttribute((const void*)kt[i], hipFuncAttributeMaxDynamicSharedMemorySize, (int)LDS_BYTES) != hipSuccess) { fprintf(stderr, "kernel_launch: hipFuncSetAttribute failed\n"); grid = -1; return; }
        if (hipOccupancyMaxActiveBlocksPerMultiprocessor(&per_cu, (const void*)kt[0], NTHREADS, LDS_BYTES) != hipSuccess || per_cu < 1) fprintf(stderr, "kernel_launch: occupancy query says %d\n", per_cu);
        (void)hipGetLastError();
        grid = cus;
    }
    if (grid < 0) return;
    (void)hipMemsetAsync((char*)d_ws + WS_CTL, 0, CTL_BYTES, stream);
    Params p{};
    for (int i = 0; i < 29; ++i) p.in[i] = (const float*)d_in[i];
    p.out = (float*)d_out; p.ws = (unsigned char*)d_ws;
#if MK_FUSED
    p.ph_lo = 0; p.ph_hi = NPHASES;
    hipLaunchKernelGGL(kt[0], dim3(grid), dim3(NTHREADS), LDS_BYTES, stream, p);
#else
    for (int k = 0; k < NPHASES; ++k) { p.ph_lo = k; p.ph_hi = k + 1; const int sel = (k < NPRE) ? 0 : ((k - NPRE) % NPH) + 1;
        hipLaunchKernelGGL(kt[sel], dim3(grid), dim3(NTHREADS), LDS_BYTES, stream, p); }
#endif
    const hipError_t le = hipPeekAtLastError();
    if (le != hipSuccess) fprintf(stderr, "kernel_launch: launch failed: %s\n", hipGetErrorName(le));
}
```

```cpp
#include <hip/hip_runtime.h>
#include <cstdio>
#include <cstdint>

#ifndef PROBE_MASK
#define PROBE_MASK 0
#endif
#ifndef MK_FUSED
#define MK_FUSED 1
#endif

#define LAS __attribute__((address_space(3)))
typedef unsigned short bf16_t;
typedef short bf16x8 __attribute__((ext_vector_type(8)));
typedef short s16x4 __attribute__((ext_vector_type(4)));
typedef float f32x2 __attribute__((ext_vector_type(2)));
typedef float f32x4 __attribute__((ext_vector_type(4)));
typedef float f32x16 __attribute__((ext_vector_type(16)));
typedef unsigned u32x2 __attribute__((ext_vector_type(2)));
typedef unsigned u32x4 __attribute__((ext_vector_type(4)));

constexpr int NB = 8, SEQ = 8192, DM = 1024, DEPTH = 4, T = NB * SEQ;
constexpr int NMEM = 256, P_IN = 2384, D_FF = 2816;
constexpr float EPS = 1e-6f, LOG2E = 1.4426950408889634f;
constexpr int NWAVES = 8, NTHREADS = 512;

typedef __bf16 bf16x2_t __attribute__((ext_vector_type(2)));
__device__ __forceinline__ unsigned cvt_pk_bf16(float lo, float hi) { const f32x2 v = {lo, hi}; return __builtin_bit_cast(unsigned, __builtin_convertvector(v, bf16x2_t)); }
__device__ __forceinline__ float bf2f(unsigned short b) { return __uint_as_float(((unsigned)b) << 16); }
__device__ __forceinline__ float bflo(unsigned w) { return __uint_as_float(w << 16); }
__device__ __forceinline__ float bfhi(unsigned w) { return __uint_as_float(w & 0xffff0000u); }
__device__ __forceinline__ bf16_t f2bf(float f) { return (bf16_t)(cvt_pk_bf16(f, 0.f) & 0xffffu); }
__device__ __forceinline__ float wave_sum(float v) {
#pragma unroll
    for (int o = 1; o < 64; o <<= 1) v += __shfl_xor(v, o);
    return v;
}

__device__ __forceinline__ float wave_sum_dpp(float v) {
#define DPPF(x, ctrl, rm, bc) __builtin_bit_cast(float, __builtin_amdgcn_update_dpp(0, __builtin_bit_cast(int, (x)), (ctrl), (rm), 0xf, (bc)))
    v += DPPF(v, 0x111, 0xf, true); v += DPPF(v, 0x112, 0xf, true); v += DPPF(v, 0x114, 0xf, true); v += DPPF(v, 0x118, 0xf, true);
    v += DPPF(v, 0x142, 0xa, false); v += DPPF(v, 0x143, 0xc, false);
#undef DPPF
    return __uint_as_float((unsigned)__builtin_amdgcn_readlane((int)__float_as_uint(v), 63));
}
__device__ __forceinline__ float sum16(float v) {
    v += __shfl_xor(v, 1); v += __shfl_xor(v, 2); v += __shfl_xor(v, 4); v += __shfl_xor(v, 8); return v;
}
__device__ __forceinline__ float fast_sigmoid(float x) { return __builtin_amdgcn_rcpf(1.0f + __expf(-x)); }
__device__ __forceinline__ float fast_silu(float x) { return x * fast_sigmoid(x); }
__device__ __forceinline__ void exp2_8(f32x4& a, f32x4& b) {
#pragma unroll
    for (int j = 0; j < 4; ++j) { a[j] = __builtin_amdgcn_exp2f(a[j]); b[j] = __builtin_amdgcn_exp2f(b[j]); } }
__device__ __forceinline__ void rcp_8(f32x4& a, f32x4& b) {
#pragma unroll
    for (int j = 0; j < 4; ++j) { a[j] = __builtin_amdgcn_rcpf(a[j]); b[j] = __builtin_amdgcn_rcpf(b[j]); } }
__device__ __forceinline__ void log2_8(f32x4& a, f32x4& b) {
#pragma unroll
    for (int j = 0; j < 4; ++j) { a[j] = __builtin_amdgcn_logf(a[j]); b[j] = __builtin_amdgcn_logf(b[j]); } }
__device__ __forceinline__ void sigmoid_8(const f32x4& x0, const f32x4& x1, f32x4& s0, f32x4& s1) {
    s0 = x0 * -1.4426950408889634f; s1 = x1 * -1.4426950408889634f; exp2_8(s0, s1); s0 = s0 + 1.0f; s1 = s1 + 1.0f; rcp_8(s0, s1); }
__device__ __forceinline__ u32x4 pack8(f32x4 a, f32x4 b) { u32x4 w; w.x = cvt_pk_bf16(a[0], a[1]); w.y = cvt_pk_bf16(a[2], a[3]); w.z = cvt_pk_bf16(b[0], b[1]); w.w = cvt_pk_bf16(b[2], b[3]); return w; }


typedef _Float16 f16x2_t __attribute__((ext_vector_type(2)));
typedef _Float16 f16x8_t __attribute__((ext_vector_type(8)));
__device__ __forceinline__ unsigned cvt_pk_f16(float lo, float hi) { const f32x2 v = {lo, hi}; return __builtin_bit_cast(unsigned, __builtin_convertvector(v, f16x2_t)); }
__device__ __forceinline__ u32x4 pack8h(f32x4 a, f32x4 b) { u32x4 w; w.x = cvt_pk_f16(a[0], a[1]); w.y = cvt_pk_f16(a[2], a[3]); w.z = cvt_pk_f16(b[0], b[1]); w.w = cvt_pk_f16(b[2], b[3]); return w; }
__device__ __forceinline__ f32x2 unpk_f16(unsigned w) { return __builtin_convertvector(__builtin_bit_cast(f16x2_t, w), f32x2); }

#define XB_TMO      128
#define XB_XCNT(j)  (256  + 64 * (j))
#define XB_XSUB(j)  (1280 + 64 * (j))
#define XB_XGEN(j)  (2304 + 64 * (j))
#define XB_TOP      3328
#define XB_TOPGEN   3392
#define XCD_BAR_WORDS 3456
#define XB_SPIN_CAP (1u << 20)

__device__ __forceinline__ unsigned xb_ld(unsigned* p)              { return __hip_atomic_load(p, __ATOMIC_RELAXED, __HIP_MEMORY_SCOPE_AGENT); }
__device__ __forceinline__ unsigned xb_add(unsigned* p, unsigned v) { return __hip_atomic_fetch_add(p, v, __ATOMIC_RELAXED, __HIP_MEMORY_SCOPE_AGENT); }
__device__ __forceinline__ unsigned xb_xcc_id() { return (unsigned)__builtin_amdgcn_s_getreg((3 << 11) | 20) & 0xFu; }
#define XB_SPIN(cond, bar) do { unsigned _sp = 0; while (cond) { __builtin_amdgcn_s_sleep(1); \
    if ((++_sp & 255u) == 0u) { if (xb_ld(&(bar)[XB_TMO])) break; if (_sp > XB_SPIN_CAP) { atomicAdd(&(bar)[XB_TMO], 1u); break; } } } } while (0)

struct XcdBarrier { unsigned* bar; unsigned x; volatile LAS unsigned* st; };

__device__ __forceinline__ XcdBarrier xcd_barrier_post(unsigned* bar, volatile LAS unsigned* st) {
    XcdBarrier b; b.bar = bar; b.x = xb_xcc_id(); b.st = st;
    if (threadIdx.x == 0) (void)xb_add(&bar[XB_XCNT(b.x)], 1u);
    return b;
}
__device__ __forceinline__ void xcd_barrier_complete(unsigned* bar, unsigned x, unsigned& nloc, unsigned& nx) {
    const unsigned G = gridDim.x * gridDim.y * gridDim.z;
    unsigned sum, cnt, mine, sp = 0u;
    for (;;) {
        sum = 0u; cnt = 0u; mine = 0u;
#pragma unroll
        for (unsigned j = 0; j < 16; ++j) { const unsigned c = xb_ld(&bar[XB_XCNT(j)]); sum += c; cnt += (c > 0u) ? 1u : 0u; mine = (j == x) ? c : mine; }
        if (sum == G) break;
        __builtin_amdgcn_s_sleep(1);
        if ((++sp & 255u) == 0u) { if (xb_ld(&bar[XB_TMO])) break; if (sp > XB_SPIN_CAP) { atomicAdd(&bar[XB_TMO], 1u); break; } }
    }
    nloc = mine > 0u ? mine : 1u; nx = cnt > 0u ? cnt : 1u;
}
__device__ __forceinline__ void xcd_barrier(const XcdBarrier& b) {
    asm volatile("s_waitcnt vmcnt(0)" ::: "memory");
    __syncthreads();
    if (threadIdx.x == 0) {
        unsigned* bar = b.bar;
        __builtin_amdgcn_s_waitcnt(0);
        unsigned nloc = b.st[0], nx = b.st[1];
        if (nloc == 0u) { xcd_barrier_complete(bar, b.x, nloc, nx); b.st[0] = nloc; b.st[1] = nx; }
        const unsigned old = xb_add(&bar[XB_XSUB(b.x)], 1u);
        const unsigned gen = old / nloc;
        if (old + 1u == (gen + 1u) * nloc) {
            __builtin_amdgcn_fence(__ATOMIC_RELEASE, "agent");
            asm volatile("s_waitcnt vmcnt(0)" ::: "memory");
            const unsigned og = xb_add(&bar[XB_TOP], 1u);
            const unsigned tg = og / nx;
            if (og + 1u == (tg + 1u) * nx) xb_add(&bar[XB_TOPGEN], 1u);
            else XB_SPIN(xb_ld(&bar[XB_TOPGEN]) == tg, bar);
            __builtin_amdgcn_fence(__ATOMIC_ACQUIRE, "agent");
            xb_add(&bar[XB_XGEN(b.x)], 1u);
            asm volatile("s_waitcnt vmcnt(0)" ::: "memory");
        } else {
            XB_SPIN(xb_ld(&bar[XB_XGEN(b.x)]) == gen, bar);
            __builtin_amdgcn_fence(__ATOMIC_ACQUIRE, "agent");
            asm volatile("s_waitcnt vmcnt(0)" ::: "memory");
        }
    }
    __syncthreads();
}

namespace pg8 {
#define PG8_LAS __attribute__((address_space(3)))
constexpr int BM = 256, BK = 64, HALF = 128, HTB = HALF * BK * 2, STAGE_BYTES = 8 * HTB, NXCD = 8, WGM = 8;
__host__ __device__ __forceinline__ int lds_byte(int r, int c) { const int st = (r >> 4) * 2 + (c >> 5), rr = r & 15, cc = c & 31, ob = rr * 64 + cc * 2; return st * 1024 + (ob ^ (((ob >> 9) & 1) << 5)); }
__host__ __device__ __forceinline__ void stage_rc(int b, int& R, int& C) { const int st = b / 1024, sb = b % 1024, swz = sb ^ (((sb >> 9) & 1) << 5); R = (st >> 1) * 16 + swz / 64; C = (st & 1) * 32 + (swz % 64) / 2; }
__host__ __device__ __forceinline__ int perm32(int rho) { const int n = rho >> 4, i = rho & 15; return 8 * (i >> 2) + 4 * n + (i & 3); }
struct Unit { int pm, pn; };
struct Gemm { const bf16_t* A; const bf16_t* Bt; int M, N, K; };
struct StaticOrder {
    int nM, nN, nwg, G, c;
    __host__ __device__ void init(int M, int N, int G_, int c_) { nM = M / BM; nN = N / BM; nwg = nM * nN; G = G_; c = c_; }
    __host__ __device__ bool next(int i, Unit& u) const {
        const long L = (long)i * G + c; if (L >= nwg) return false;
        int wgid = (int)L; { const int q = nwg / NXCD, r = nwg % NXCD, xcd = wgid % NXCD, off = wgid / NXCD; wgid = (xcd < r ? xcd * (q + 1) : r * (q + 1) + (xcd - r) * q) + off; }
        const int nig = WGM * nN, gid = wgid / nig, fm = gid * WGM, gsz = (nM - fm) < WGM ? (nM - fm) : WGM;
        u.pm = fm + ((wgid % nig) % gsz); u.pn = (wgid % nig) / gsz; return true;
    }
    __device__ __forceinline__ void a_ready(const Unit&) const {}
    __device__ __forceinline__ void done(const Unit&) const {}
};
struct StaticOrderG1 : StaticOrder {
    __device__ __forceinline__ bool next(int i, Unit& u) const {
        const bool r = StaticOrder::next(i, u);
        if (r) { const int q = u.pn; u.pn = (q == 3) ? 4 : (q == 4) ? 3 : (q == 8) ? 9 : (q == 9) ? 8 : q; }
        return r; }
};
struct PanelOrder {
    int pm, n;
    __device__ __forceinline__ bool next(int i, Unit& u) const { if (i >= n) return false; u.pm = pm; u.pn = i; return true; }
    __device__ __forceinline__ void a_ready(const Unit&) const {}
    __device__ __forceinline__ void done(const Unit&) const {}
};

template <class Epi, class Sched, bool F16 = false, bool ALIGN_EPI = true, bool SP2 = true>
__device__ __forceinline__ void gemm_phase(PG8_LAS unsigned char* lds, const Gemm g, const Sched& S, const Epi& E) {
    int tid = threadIdx.x; asm volatile("" : "+v"(tid));
    const int wid = __builtin_amdgcn_readfirstlane(tid >> 6), lane = tid & 63, wr = wid >> 2, wc = wid & 3, fr = lane & 15, fq = lane >> 4;
    const int K = g.K, nt = K / BK;
    unsigned voffA[2], voffB[2];
#pragma unroll
    for (int i = 0; i < 2; ++i) { int R, C; stage_rc(tid * 16 + i * 8192, R, C); const int Rb = Epi::PERM ? ((R & ~31) + perm32(R & 31)) : R;
        voffA[i] = (unsigned)(R * K + C) * 2u; voffB[i] = (unsigned)(Rb * K + C) * 2u; }
    const size_t kstep = (size_t)(BK * 2);
    const size_t hstep = (size_t)HALF * K * 2;
    const size_t tstep = 2 * hstep;
    const unsigned ldsw = (unsigned)wid * 1024u;
    const int aoff = lds_byte(wr * 64 + fr, fq * 8), boff = lds_byte(wc * 32 + fr, fq * 8);
#define PG8_SA(b, h) (((b) * 2 + (h)) * HTB)
#define PG8_SB(b, h) ((4 + (b) * 2 + (h)) * HTB)
#define PG8_STAGE(bufoff, gbase, voff) do { _Pragma("unroll") for (int _i = 0; _i < 2; ++_i) \
        __builtin_amdgcn_global_load_lds((const unsigned*)((const char*)(gbase) + (voff)[_i]), (PG8_LAS unsigned*)(lds + (bufoff) + ldsw + _i * 8192), 16, 0, 0); } while (0)
#define PG8_LDA(dst, b, h) do { _Pragma("unroll") for (int m = 0; m < 4; ++m) _Pragma("unroll") for (int k = 0; k < 2; ++k) dst[m][k] = *(const PG8_LAS bf16x8*)(lds + PG8_SA(b, h) + aoff + m * 2048 + k * 1024); } while (0)
#define PG8_LDB(dst, b, h) do { _Pragma("unroll") for (int n = 0; n < 2; ++n) _Pragma("unroll") for (int k = 0; k < 2; ++k) dst[n][k] = *(const PG8_LAS bf16x8*)(lds + PG8_SB(b, h) + boff + n * 2048 + k * 1024); } while (0)
#define PG8_MMA(ai, bj, At, Bt) do { __builtin_amdgcn_s_setprio(1); _Pragma("unroll") for (int m = 0; m < 4; ++m) _Pragma("unroll") for (int n = 0; n < 2; ++n) _Pragma("unroll") for (int k = 0; k < 2; ++k) \
        acc[ai][bj][m][n] = F16 ? __builtin_amdgcn_mfma_f32_16x16x32_f16(__builtin_bit_cast(f16x8_t, Bt[n][k]), __builtin_bit_cast(f16x8_t, At[m][k]), acc[ai][bj][m][n], 0, 0, 0) \
                                : __builtin_amdgcn_mfma_f32_16x16x32_bf16(Bt[n][k], At[m][k], acc[ai][bj][m][n], 0, 0, 0); __builtin_amdgcn_s_setprio(0); } while (0)
#define PG8_ZERO(ai) do { _Pragma("unroll") for (int b_ = 0; b_ < 2; ++b_) _Pragma("unroll") for (int m = 0; m < 4; ++m) _Pragma("unroll") for (int n = 0; n < 2; ++n) acc[ai][b_][m][n] = (f32x4){0.f, 0.f, 0.f, 0.f}; } while (0)
#define PG8_WAIT_V(n) asm volatile("s_waitcnt vmcnt(" #n ")" ::: "memory")
#define PG8_WAIT_L(n) asm volatile("s_waitcnt lgkmcnt(" #n ")" ::: "memory")
#define PG8_BAR __builtin_amdgcn_s_barrier()
#define PG8_SCHED __builtin_amdgcn_sched_barrier(0)
    Unit cur, nxt; int ui = 0;
    if (!S.next(0, cur)) return;
    f32x4 acc[2][2][4][2];
#pragma unroll
    for (int a = 0; a < 2; ++a)
#pragma unroll
        for (int b = 0; b < 2; ++b)
#pragma unroll
            for (int m = 0; m < 4; ++m)
#pragma unroll
                for (int n = 0; n < 2; ++n) acc[a][b][m][n] = (f32x4){0.f, 0.f, 0.f, 0.f};
    bf16x8 At[4][2], B0[2][2], B1[2][2];
    const char* cA = (const char*)g.A + (size_t)cur.pm * tstep; const char* cB = (const char*)g.Bt + (size_t)cur.pn * tstep;
    S.a_ready(cur);
    E.prefetch(cur, wid, lane);
    if constexpr (SP2) {
        PG8_STAGE(PG8_SB(0, 0), cB, voffB); PG8_STAGE(PG8_SB(0, 1), cB + hstep, voffB); PG8_STAGE(PG8_SA(0, 0), cA, voffA); PG8_STAGE(PG8_SA(0, 1), cA + hstep, voffA);
        if (wr == 1) PG8_BAR;
        PG8_WAIT_V(2); PG8_BAR;
        PG8_STAGE(PG8_SB(1, 0), cB + kstep, voffB); PG8_STAGE(PG8_SA(1, 0), cA + kstep, voffA); PG8_STAGE(PG8_SB(1, 1), cB + hstep + kstep, voffB);
        PG8_WAIT_V(6); PG8_BAR;
    } else {
        PG8_STAGE(PG8_SB(0, 0), cB, voffB); PG8_STAGE(PG8_SA(0, 0), cA, voffA); PG8_STAGE(PG8_SB(0, 1), cB + hstep, voffB); PG8_STAGE(PG8_SA(0, 1), cA + hstep, voffA);
        if (wr == 1) PG8_BAR;
        PG8_WAIT_V(4); PG8_BAR;
        PG8_STAGE(PG8_SB(1, 0), cB + kstep, voffB); PG8_STAGE(PG8_SA(1, 0), cA + kstep, voffA); PG8_STAGE(PG8_SB(1, 1), cB + hstep + kstep, voffB);
        PG8_WAIT_V(6); PG8_BAR;
    }
    for (;;) {
        const bool has_next = S.next(ui + 1, nxt);
        const char* nA = has_next ? (const char*)g.A + (size_t)nxt.pm * tstep : cA; const char* nB = has_next ? (const char*)g.Bt + (size_t)nxt.pn * tstep : cB;
        for (int t = 0; t < nt; t += 2) {
            const bool last = (t == nt - 2);
            const char* a1 = cA + (size_t)(t + 1) * kstep;
            const char* a2 = last ? nA : cA + (size_t)(t + 2) * kstep; const char* b2 = last ? nB : cB + (size_t)(t + 2) * kstep;
            const char* a3 = a2 + kstep; const char* b3 = b2 + kstep;
            if (last && has_next) S.a_ready(nxt);
            if constexpr (SP2) {
            PG8_LDB(B0, 0, 0); PG8_LDB(B1, 0, 1); PG8_SCHED; PG8_LDA(At, 0, 0); PG8_STAGE(PG8_SA(1, 1), a1 + hstep, voffA);
            if (t == 0 && ui > 0) PG8_ZERO(0);
            PG8_WAIT_V(8); PG8_WAIT_L(0); PG8_BAR; PG8_MMA(0, 0, At, B0); PG8_MMA(0, 1, At, B1); PG8_BAR; PG8_SCHED;
            PG8_LDA(At, 0, 1); PG8_STAGE(PG8_SB(0, 0), b2, voffB); PG8_STAGE(PG8_SB(0, 1), b2 + hstep, voffB); PG8_STAGE(PG8_SA(0, 0), a2, voffA);
            if (t == 0 && ui > 0) PG8_ZERO(1);
            PG8_WAIT_V(8); PG8_WAIT_L(0); PG8_BAR; PG8_MMA(1, 0, At, B0); PG8_MMA(1, 1, At, B1); PG8_BAR; PG8_SCHED;
            PG8_LDB(B0, 1, 0); PG8_LDB(B1, 1, 1); PG8_SCHED; PG8_LDA(At, 1, 0); PG8_STAGE(PG8_SA(0, 1), a2 + hstep, voffA);
            PG8_WAIT_V(8); PG8_WAIT_L(0); PG8_BAR; PG8_MMA(0, 0, At, B0); PG8_MMA(0, 1, At, B1); PG8_BAR; PG8_SCHED;
            PG8_LDA(At, 1, 1); PG8_STAGE(PG8_SB(1, 0), b3, voffB); PG8_STAGE(PG8_SB(1, 1), b3 + hstep, voffB); PG8_STAGE(PG8_SA(1, 0), a3, voffA);
            PG8_WAIT_V(8); PG8_WAIT_L(0); PG8_BAR; PG8_MMA(1, 0, At, B0); PG8_MMA(1, 1, At, B1); PG8_BAR; PG8_SCHED;
            } else {
            PG8_LDB(B0, 0, 0); PG8_SCHED; PG8_LDA(At, 0, 0); PG8_STAGE(PG8_SA(1, 1), a1 + hstep, voffA);
            PG8_WAIT_L(8); PG8_BAR; PG8_WAIT_L(0); PG8_MMA(0, 0, At, B0); PG8_BAR; PG8_SCHED;
            PG8_LDB(B1, 0, 1); PG8_STAGE(PG8_SB(0, 0), b2, voffB);
            PG8_BAR; PG8_WAIT_L(0); PG8_MMA(0, 1, At, B1); PG8_BAR;
            PG8_LDA(At, 0, 1); PG8_STAGE(PG8_SA(0, 0), a2, voffA);
            PG8_BAR; PG8_WAIT_L(0); PG8_MMA(1, 0, At, B0); PG8_BAR; PG8_SCHED;
            PG8_STAGE(PG8_SB(0, 1), b2 + hstep, voffB);
            PG8_WAIT_V(6); PG8_BAR; PG8_MMA(1, 1, At, B1); PG8_BAR;
            PG8_LDB(B0, 1, 0); PG8_SCHED; PG8_LDA(At, 1, 0); PG8_STAGE(PG8_SA(0, 1), a2 + hstep, voffA);
            PG8_WAIT_L(8); PG8_BAR; PG8_WAIT_L(0); PG8_MMA(0, 0, At, B0); PG8_BAR; PG8_SCHED;
            PG8_LDB(B1, 1, 1); PG8_STAGE(PG8_SB(1, 0), b3, voffB);
            PG8_BAR; PG8_WAIT_L(0); PG8_MMA(0, 1, At, B1); PG8_BAR;
            PG8_LDA(At, 1, 1); PG8_STAGE(PG8_SA(1, 0), a3, voffA);
            PG8_BAR; PG8_WAIT_L(0); PG8_MMA(1, 0, At, B0); PG8_BAR; PG8_SCHED;
            PG8_STAGE(PG8_SB(1, 1), b3 + hstep, voffB);
            PG8_WAIT_V(6); PG8_BAR; PG8_MMA(1, 1, At, B1); PG8_BAR;
            }
        }
        if constexpr (ALIGN_EPI) { if (wr == 0) PG8_BAR; }
        E(acc, cur, wr, wc, fr, fq);
        if (!has_next) break;
        E.prefetch(nxt, wid, lane);
        if constexpr (!SP2) {
#pragma unroll
        for (int a = 0; a < 2; ++a)
#pragma unroll
            for (int b = 0; b < 2; ++b)
#pragma unroll
                for (int m = 0; m < 4; ++m)
#pragma unroll
                    for (int n = 0; n < 2; ++n) acc[a][b][m][n] = (f32x4){0.f, 0.f, 0.f, 0.f};
        }
        cur = nxt; cA = nA; cB = nB; ++ui;
        if constexpr (ALIGN_EPI) { if (wr == 1) PG8_BAR; }
    }
    PG8_WAIT_V(0);
    if constexpr (!ALIGN_EPI) { if (wr == 0) PG8_BAR; }
    PG8_BAR;
#undef PG8_SA
#undef PG8_SB
#undef PG8_STAGE
#undef PG8_LDA
#undef PG8_LDB
#undef PG8_MMA
#undef PG8_ZERO
#undef PG8_WAIT_V
#undef PG8_WAIT_L
#undef PG8_BAR
#undef PG8_SCHED
}
}


constexpr size_t MiB = 1024 * 1024;
constexpr size_t al256(size_t x) { return (x + 255) / 256 * 256; }
constexpr size_t W_IN = 0, W_Q = W_IN + (size_t)2560 * 1024, W_KV = W_Q + (size_t)1024 * 256, W_MIX = W_KV + (size_t)1024 * 256, W_CAQ = W_MIX + (size_t)1024 * 1024,
                 W_CAKV = W_CAQ + (size_t)512 * 1024, W_CAO = W_CAKV + (size_t)1024 * 1024, W_FFI = W_CAO + (size_t)1024 * 512, W_FFO = W_FFI + (size_t)5632 * 1024,
                 W_LAYER = W_FFO + (size_t)1024 * 2816;
constexpr size_t WS_CTL = 0, CTL_BYTES = 65536;
constexpr size_t WS_LB = WS_CTL + CTL_BYTES;
constexpr size_t WS_RSTD = WS_LB + 4096;
constexpr size_t WS_CQ = WS_RSTD + (size_t)T * 4, WS_CKV = WS_CQ + (size_t)T * 4;
constexpr size_t WS_MEMRSTD = WS_CKV + (size_t)T * 4;
constexpr size_t WS_MEMB = WS_MEMRSTD + 8192;
constexpr size_t WS_KVRAW = WS_MEMB + (size_t)2048 * 1024 * 2;
constexpr size_t WS_KCA = WS_KVRAW + (size_t)2048 * 1024 * 4;
constexpr size_t WS_VCA = WS_KCA + (size_t)4 * 2048 * 512 * 2;
constexpr size_t WS_ROT = WS_VCA + (size_t)4 * 2048 * 512 * 2;
constexpr size_t WS_PART = WS_ROT + (size_t)T * 32 * 8;
constexpr size_t WS_LATP = WS_PART + (size_t)T * 16 * 4;
constexpr size_t WS_W = WS_LATP + (size_t)T * 16 * 4;
constexpr size_t WS_HB = al256(WS_W + 4 * W_LAYER * 2);
constexpr size_t WS_R = WS_HB + (size_t)T * 1024 * 2;
constexpr size_t R_GQK = WS_R, R_GA = R_GQK + 32 * MiB, R_GV = R_GA + 32 * MiB, R_GR = R_GV + 32 * MiB, R_HQ = R_GR + 32 * MiB, R_HA = R_HQ + 32 * MiB, R_HI = R_HA + 64 * MiB,
                 R_HG = R_HI + 32 * MiB, R_QLAT = R_HG + 32 * MiB  , R_KVLAT = R_QLAT + 32 * MiB, R_KROPE = R_KVLAT + 32 * MiB, R_Y = R_KROPE + 8 * MiB  ,
                 R_SG = R_Y + 128 * MiB, R_SH = R_SG + 8 * MiB, R_PG = R_SH + 16 * MiB, R_PH = R_PG + 1 * MiB, R_Q = R_PH + 1 * MiB  , R_KRH = R_Q + 96 * MiB, R_HK = R_KRH + 32 * MiB, R_END1 = R_HK + 32 * MiB;
constexpr size_t R_QRAW = WS_R, R_KVRAW = WS_R + 128 * MiB;
constexpr size_t R_KN = WS_R, R_V = WS_R + 64 * MiB;
constexpr size_t R_QCA = WS_R, R_OCA = WS_R + 64 * MiB;
constexpr size_t R_GH = WS_R, R_UH = WS_R + 16 * MiB, R_URAW = WS_R + 352 * MiB, R_END3 = R_URAW + 352 * MiB;
constexpr size_t WS_END = R_END3;
static_assert(R_END1 <= R_END3, "mixer window must fit the region");
static_assert(WS_END <= (size_t)1024 * MiB, "workspace map exceeds 1 GiB");

constexpr size_t LDS_STAGE = 131072, LDS_MISC = 163840 - 256, LDS_BYTES = 163840;


__device__ __forceinline__ void stat_dma(const float* tab, PG8_LAS float* st, const int pm, const int wid, const int lane) {
#pragma unroll
    for (int i = 0; i < 2; ++i)
        __builtin_amdgcn_global_load_lds((const unsigned*)(tab + ((size_t)pm * 256 + 32 * wid) * 16 + (i * 64 + lane) * 4), (PG8_LAS unsigned*)((PG8_LAS unsigned char*)st + wid * 2048 + i * 1024), 16, 0, 0);
}
__device__ __forceinline__ float rstd_from_lds(const PG8_LAS float* strow) {
    const f32x4 v = *(const PG8_LAS f32x4*)strow;
    float sq = (v[0] + v[1]) + (v[2] + v[3]); sq += __shfl_xor(sq, 16); sq += __shfl_xor(sq, 32);
    return __builtin_amdgcn_rsqf(sq * (1.0f / DM) + EPS);
}
__device__ __forceinline__ float rstd_from_part(const float* part, const size_t row, const int fq) {
    const f32x4 v = *(const f32x4*)(part + row * 16 + 4 * fq);
    float s = (v[0] + v[1]) + (v[2] + v[3]);
    s += __shfl_xor(s, 16); s += __shfl_xor(s, 32);
    return __builtin_amdgcn_rsqf(s * (1.0f / DM) + EPS);
}
struct EpiInProj {
    static constexpr bool PERM = true, AFTER_DRAIN = false;
    unsigned char* wsb;
    const float* bgate; const float* lb;
    PG8_LAS float* st;
    template <int MODE>
    __device__ __forceinline__ void run(const f32x4 (&acc)[2][2][4][2], const int row0, const int cw, const int wc, bf16_t* dst, const float sc, const int lslot, const PG8_LAS float* strow) const {
        const int fq = (cw >> 3) & 3;
#pragma unroll
        for (int ai = 0; ai < 2; ++ai)
#pragma unroll
            for (int m = 0; m < 4; ++m) {
                const size_t row = (size_t)(row0 + ai * 128 + m * 16);
                const float rs = rstd_from_lds(strow + (ai * 128 + m * 16) * 16);
                float lss = 0.f;
#pragma unroll
                for (int bj = 0; bj < 2; ++bj) {
                    f32x4 v0 = acc[ai][bj][m][0] * rs, v1 = acc[ai][bj][m][1] * rs;
                    const int c = bj * 128 + cw;
                    if constexpr (MODE == 0 || MODE == 4) { *(u32x4*)(dst + row * 256 + c) = pack8(v0, v1);
                        if constexpr (MODE == 4) lss += (v0[0] * v0[0] + v0[1] * v0[1]) + (v0[2] * v0[2] + v0[3] * v0[3]) + (v1[0] * v1[0] + v1[1] * v1[1]) + (v1[2] * v1[2] + v1[3] * v1[3]); }
                    else if constexpr (MODE == 1) {
                        f32x4 s0, s1; sigmoid_8(v0, v1, s0, s1);
                        v0 = v0 * s0 * sc; v1 = v1 * s1 * sc;
                        *(u32x4*)(dst + row * 256 + c) = pack8(v0, v1);
                    } else if constexpr (MODE == 2) {
                        const f32x4 l0 = *(const f32x4*)(lb + c), l1 = *(const f32x4*)(lb + c + 4);
                        f32x4 s0, s1; sigmoid_8(v0, v1, s0, s1);
                        f32x4 a0 = l0 + (1.0f - l0) * s0, a1 = l1 + (1.0f - l1) * s1;
                        const f32x4 k0 = 1.0f - a0, k1 = 1.0f - a1;
                        log2_8(a0, a1);
#pragma unroll
                        for (int j = 0; j < 4; ++j) { v0[j] = fminf(a0[j], 0.f); v1[j] = fminf(a1[j], 0.f); }
                        *(u32x4*)((bf16_t*)(wsb + R_HA) + row * 256 + c) = pack8h(v0, v1);
                        *(u32x4*)((bf16_t*)(wsb + R_HK) + row * 256 + c) = pack8(k0, k1);
                    } else {
                        if (bj == 0) {
                            const f32x4 b0 = *(const f32x4*)(bgate + cw), b1 = *(const f32x4*)(bgate + cw + 4);
                            const f32x4 z0 = v0 + b0, z1 = v1 + b1;
                            f32x4 t0, t1;
#pragma unroll
                            for (int j = 0; j < 4; ++j) { t0[j] = fabsf(z0[j]) * -1.4426950408889634f; t1[j] = fabsf(z1[j]) * -1.4426950408889634f; }
                            exp2_8(t0, t1); t0 = t0 + 1.0f; t1 = t1 + 1.0f; log2_8(t0, t1);
#pragma unroll
                            for (int j = 0; j < 4; ++j) { v0[j] = (fminf(z0[j], 0.f) * 1.4426950408889634f - t0[j]) * 0.0625f; v1[j] = (fminf(z1[j], 0.f) * 1.4426950408889634f - t1[j]) * 0.0625f; }
                            *(u32x4*)((bf16_t*)(wsb + R_GA) + row * 128 + cw) = pack8h(v0, v1);
                        } else if (wc < 2) {
                            *(u32x4*)((bf16_t*)(wsb + R_KROPE) + row * 64 + cw) = pack8(v0, v1);
                            float ks = (v0[0] * v0[0] + v0[1] * v0[1]) + (v0[2] * v0[2] + v0[3] * v0[3]) + (v1[0] * v1[0] + v1[1] * v1[1]) + (v1[2] * v1[2] + v1[3] * v1[3]);
                            ks += __shfl_xor(ks, 16); ks += __shfl_xor(ks, 32);
                            if (fq == 0) ((float*)(wsb + WS_LATP))[row * 16 + 8 + wc] = ks;
                        }
                    }
                }
                if constexpr (MODE == 4) { lss += __shfl_xor(lss, 16); lss += __shfl_xor(lss, 32); if (fq == 0) ((float*)(wsb + WS_LATP))[row * 16 + lslot + wc] = lss; }
            }
    }
    __device__ __forceinline__ void prefetch(const pg8::Unit& u, int wid, int lane) const { __builtin_amdgcn_s_barrier(); stat_dma((const float*)(wsb + WS_PART), st, u.pm, wid, lane); }
    __device__ __forceinline__ void operator()(const f32x4 (&acc)[2][2][4][2], const pg8::Unit& u, int wr, int wc, int fr, int fq) const {
        asm volatile("" : "+v"(fr), "+v"(fq));
        const int row0 = u.pm * 256 + wr * 64 + fr, cw = wc * 32 + 8 * fq, pn = u.pn;
        const PG8_LAS float* strow = st + (wr * 64 + fr) * 16 + 4 * fq;
        if (pn == 3) run<3>(acc, row0, cw, wc, nullptr, 1.f, 0, strow);
        else if (pn == 7) run<2>(acc, row0, cw, wc, nullptr, 1.f, 0, strow);
        else if (pn == 5 || pn == 6 || pn == 9) run<1>(acc, row0, cw, wc, (bf16_t*)(wsb + ((pn == 5) ? R_GR : ((pn == 9) ? R_HG : R_HQ))), (pn == 6) ? 0.125f : 1.0f, 0, strow);
        else if (pn < 2) run<4>(acc, row0, cw, wc, (bf16_t*)(wsb + ((pn == 0) ? R_QLAT : R_KVLAT)), 1.f, pn * 4, strow);
        else run<0>(acc, row0, cw, wc, (bf16_t*)(wsb + ((pn == 2) ? R_GQK : (pn == 4) ? R_GV : R_HI)), 1.f, 0, strow);
    }
};
template <bool PARTS>
struct EpiScaleBf16 {
    static constexpr bool PERM = true, AFTER_DRAIN = false;
    const float* rs; bf16_t* O; int ldc;
    PG8_LAS float* st;
    __device__ __forceinline__ void prefetch(const pg8::Unit& u, int wid, int lane) const { if constexpr (PARTS) { __builtin_amdgcn_s_barrier(); stat_dma(rs, st, u.pm, wid, lane); } }
    __device__ __forceinline__ void operator()(const f32x4 (&acc)[2][2][4][2], const pg8::Unit& u, int wr, int wc, int fr, int fq) const {
        asm volatile("" : "+v"(fr), "+v"(fq));
        const int row0 = u.pm * 256 + wr * 64 + fr, c0 = u.pn * 256 + wc * 32 + 8 * fq;
        const PG8_LAS float* strow = st + (wr * 64 + fr) * 16 + 4 * fq;
#pragma unroll
        for (int ai = 0; ai < 2; ++ai)
#pragma unroll
            for (int m = 0; m < 4; ++m) {
                const size_t row = (size_t)(row0 + ai * 128 + m * 16); const float s = PARTS ? rstd_from_lds(strow + (ai * 128 + m * 16) * 16) : rs[row];
#pragma unroll
                for (int bj = 0; bj < 2; ++bj) *(u32x4*)(O + row * ldc + c0 + bj * 128) = pack8(acc[ai][bj][m][0] * s, acc[ai][bj][m][1] * s);
            }
    }
};
struct EpiScaleF32 {
    static constexpr bool PERM = true, AFTER_DRAIN = false;
    const float* rs; float* O; int ldc;
    __device__ __forceinline__ void prefetch(const pg8::Unit&, int, int) const {}
    __device__ __forceinline__ void operator()(const f32x4 (&acc)[2][2][4][2], const pg8::Unit& u, int wr, int wc, int fr, int fq) const {
        asm volatile("" : "+v"(fr), "+v"(fq));
        const int row0 = u.pm * 256 + wr * 64 + fr, c0 = u.pn * 256 + wc * 32 + 8 * fq;
#pragma unroll
        for (int ai = 0; ai < 2; ++ai)
#pragma unroll
            for (int m = 0; m < 4; ++m) {
                const size_t row = (size_t)(row0 + ai * 128 + m * 16); const float s = rs[row];
#pragma unroll
                for (int bj = 0; bj < 2; ++bj) { float* p = O + row * ldc + c0 + bj * 128; *(f32x4*)p = acc[ai][bj][m][0] * s; *(f32x4*)(p + 4) = acc[ai][bj][m][1] * s; }
            }
    }
};
struct EpiResid {
    static constexpr bool PERM = true, AFTER_DRAIN = false;
    bf16_t* h16; bf16_t* h16o; float* out; float* parts; int last;
    __device__ __forceinline__ void prefetch(const pg8::Unit&, int, int) const {}
    __device__ __forceinline__ void operator()(const f32x4 (&acc)[2][2][4][2], const pg8::Unit& u, int wr, int wc, int fr, int fq) const {
        asm volatile("" : "+v"(fr), "+v"(fq));
        const int row0 = u.pm * 256 + wr * 64 + fr, c0 = u.pn * 256 + wc * 32 + 8 * fq;
#pragma unroll
        for (int ai = 0; ai < 2; ++ai) {
            u32x4 hw[4][2];
#pragma unroll
            for (int m = 0; m < 4; ++m)
#pragma unroll
                for (int bj = 0; bj < 2; ++bj) hw[m][bj] = *(const u32x4*)(h16 + (size_t)(row0 + ai * 128 + m * 16) * DM + c0 + bj * 128);
#pragma unroll
            for (int m = 0; m < 4; ++m) {
                const size_t row = (size_t)(row0 + ai * 128 + m * 16);
                float ss = 0.f;
#pragma unroll
                for (int bj = 0; bj < 2; ++bj) { const size_t o = row * DM + c0 + bj * 128;
                    const f32x2 a0 = unpk_f16(hw[m][bj].x), a1 = unpk_f16(hw[m][bj].y), a2 = unpk_f16(hw[m][bj].z), a3 = unpk_f16(hw[m][bj].w);
                    const f32x4 h0 = (f32x4){a0[0], a0[1], a1[0], a1[1]} + acc[ai][bj][m][0], h1 = (f32x4){a2[0], a2[1], a3[0], a3[1]} + acc[ai][bj][m][1];
                    if (last) { *(f32x4*)(out + o) = h0; *(f32x4*)(out + o + 4) = h1; }
                    else { *(u32x4*)(h16o + o) = pack8h(h0, h1);
                        ss += (h0[0] * h0[0] + h0[1] * h0[1]) + (h0[2] * h0[2] + h0[3] * h0[3]) + (h1[0] * h1[0] + h1[1] * h1[1]) + (h1[2] * h1[2] + h1[3] * h1[3]); } }
                if (!last) { ss += __shfl_xor(ss, 16); ss += __shfl_xor(ss, 32); if (fq == 0) parts[row * 16 + u.pn * 4 + wc] = ss; }
            }
        }
    }
};
struct EpiQUp {
    static constexpr bool PERM = true, AFTER_DRAIN = false;
    unsigned char* wsb; const float* qg; PG8_LAS float* sx; PG8_LAS float* st;
    __device__ __forceinline__ void prefetch(const pg8::Unit& u, int wid, int lane) const { __builtin_amdgcn_s_barrier(); stat_dma((const float*)(wsb + WS_LATP), st, u.pm, wid, lane); }
    __device__ __forceinline__ void operator()(const f32x4 (&acc)[2][2][4][2], const pg8::Unit& u, int wr, int wc, int fr, int fq) const {
        asm volatile("" : "+v"(fr), "+v"(fq));
        const int lrow0 = wr * 64 + fr, cw = wc * 32 + 8 * fq, h = u.pn, jb = 4 * (4 * wc + fq);
#pragma unroll
        for (int ai = 0; ai < 2; ++ai)
#pragma unroll
            for (int m = 0; m < 4; ++m) { const int lrow = lrow0 + ai * 128 + m * 16; const size_t row = (size_t)u.pm * 256 + lrow;
                const f32x4 lp = *(const PG8_LAS f32x4*)(st + lrow * 16);
                const float cl1 = __builtin_amdgcn_rsqf(((lp[0] + lp[1]) + (lp[2] + lp[3])) * (1.0f / 256.0f) + EPS);
                float ss = 0.f;
#pragma unroll
                for (int bj = 0; bj < 2; ++bj)
#pragma unroll
                    for (int n = 0; n < 2; ++n) { const f32x4 x = acc[ai][bj][m][n] * cl1; ss += (x[0] * x[0] + x[1] * x[1]) + (x[2] * x[2] + x[3] * x[3]); }
                ss += __shfl_xor(ss, 16); ss += __shfl_xor(ss, 32);
                if (fq == 0) sx[lrow * 4 + wc] = ss; }
        asm volatile("s_waitcnt lgkmcnt(0)" ::: "memory"); __builtin_amdgcn_s_barrier(); asm volatile("" ::: "memory");
        const f32x4 g0 = *(const f32x4*)(qg + cw), g1 = *(const f32x4*)(qg + cw + 4);
        f32x4 gr1 = {0.f, 0.f, 0.f, 0.f}, gr2 = {0.f, 0.f, 0.f, 0.f};
        if (wc < 2) { gr1 = *(const f32x4*)(qg + 128 + jb); gr2 = *(const f32x4*)(qg + 160 + jb); }
#pragma unroll
        for (int ai = 0; ai < 2; ++ai)
#pragma unroll
            for (int m = 0; m < 4; ++m) { const int lrow = lrow0 + ai * 128 + m * 16; const size_t row = (size_t)u.pm * 256 + lrow;
                const f32x4 t4 = *(const PG8_LAS f32x4*)(sx + lrow * 4);
                const f32x4 lp2 = *(const PG8_LAS f32x4*)(st + lrow * 16);
                const float cl2 = __builtin_amdgcn_rsqf(((lp2[0] + lp2[1]) + (lp2[2] + lp2[3])) * (1.0f / 256.0f) + EPS);
                const float sc = cl2 * __builtin_amdgcn_rsqf(((t4[0] + t4[1]) + (t4[2] + t4[3])) * (1.0f / 192.0f) + EPS);
                bf16_t* qrow = (bf16_t*)(wsb + R_Q) + (((size_t)(row >> 13) * 4 + h) * SEQ + (row & (SEQ - 1))) * 192;
                *(u32x4*)(qrow + cw) = pack8(acc[ai][0][m][0] * sc * g0, acc[ai][0][m][1] * sc * g1);
                if (wc < 2) {
                    const f32x4 x1 = acc[ai][1][m][0] * sc * gr1, x2 = acc[ai][1][m][1] * sc * gr2;
                    const f32x4 csa = *(const f32x4*)((const f32x2*)(wsb + WS_ROT) + row * 32 + jb), csb = *(const f32x4*)((const f32x2*)(wsb + WS_ROT) + row * 32 + jb + 2);
                    const float o10 = x1[0] * csa[0] - x2[0] * csa[1], o11 = x1[1] * csa[2] - x2[1] * csa[3], o12 = x1[2] * csb[0] - x2[2] * csb[1], o13 = x1[3] * csb[2] - x2[3] * csb[3];
                    const float o20 = x2[0] * csa[0] + x1[0] * csa[1], o21 = x2[1] * csa[2] + x1[1] * csa[3], o22 = x2[2] * csb[0] + x1[2] * csb[1], o23 = x2[3] * csb[2] + x1[3] * csb[3];
                    *(u32x2*)(qrow + 128 + jb) = (u32x2){cvt_pk_bf16(o10, o11), cvt_pk_bf16(o12, o13)};
                    *(u32x2*)(qrow + 160 + jb) = (u32x2){cvt_pk_bf16(o20, o21), cvt_pk_bf16(o22, o23)};
                } }
    }
};
struct EpiKVUp {
    static constexpr bool PERM = true, AFTER_DRAIN = false;
    unsigned char* wsb; const float* kg; PG8_LAS float* sx; PG8_LAS float* st;
    __device__ __forceinline__ void prefetch(const pg8::Unit& u, int wid, int lane) const { __builtin_amdgcn_s_barrier(); stat_dma((const float*)(wsb + WS_LATP), st, u.pm, wid, lane); }
    __device__ __forceinline__ void operator()(const f32x4 (&acc)[2][2][4][2], const pg8::Unit& u, int wr, int wc, int fr, int fq) const {
        asm volatile("" : "+v"(fr), "+v"(fq));
        const int lrow0 = wr * 64 + fr, cw = wc * 32 + 8 * fq, h = u.pn, j2 = 2 * (4 * wc + fq);
#pragma unroll
        for (int ai = 0; ai < 2; ++ai)
#pragma unroll
            for (int m = 0; m < 4; ++m) { const int lrow = lrow0 + ai * 128 + m * 16; const size_t row = (size_t)u.pm * 256 + lrow;
                const f32x4 lp = *(const PG8_LAS f32x4*)(st + lrow * 16 + 4);
                const float cl1 = __builtin_amdgcn_rsqf(((lp[0] + lp[1]) + (lp[2] + lp[3])) * (1.0f / 256.0f) + EPS);
                float ss = 0.f;
#pragma unroll
                for (int n = 0; n < 2; ++n) { const f32x4 x = acc[ai][0][m][n] * cl1; ss += (x[0] * x[0] + x[1] * x[1]) + (x[2] * x[2] + x[3] * x[3]); }
                ss += __shfl_xor(ss, 16); ss += __shfl_xor(ss, 32);
                if (fq == 0) sx[lrow * 4 + wc] = ss; }
        asm volatile("s_waitcnt lgkmcnt(0)" ::: "memory"); __builtin_amdgcn_s_barrier(); asm volatile("" ::: "memory");
        const f32x4 g0 = *(const f32x4*)(kg + cw), g1 = *(const f32x4*)(kg + cw + 4);
        const f32x2 gk1 = *(const f32x2*)(kg + 128 + j2), gk2 = *(const f32x2*)(kg + 160 + j2);
#pragma unroll
        for (int ai = 0; ai < 2; ++ai)
#pragma unroll
            for (int m = 0; m < 4; ++m) { const int lrow = lrow0 + ai * 128 + m * 16; const size_t row = (size_t)u.pm * 256 + lrow;
                const f32x4 t4 = *(const PG8_LAS f32x4*)(sx + lrow * 4);
                const f32x2 kr = *(const PG8_LAS f32x2*)(st + lrow * 16 + 8);
                const float rk = __builtin_amdgcn_rsqf((((t4[0] + t4[1]) + (t4[2] + t4[3])) + (kr[0] + kr[1])) * (1.0f / 192.0f) + EPS);
                const size_t bhs = ((size_t)(row >> 13) * 4 + h) * SEQ + (row & (SEQ - 1));
                const f32x4 lp2 = *(const PG8_LAS f32x4*)(st + lrow * 16 + 4);
                const float cl2 = __builtin_amdgcn_rsqf(((lp2[0] + lp2[1]) + (lp2[2] + lp2[3])) * (1.0f / 256.0f) + EPS);
                const float sc = cl2 * rk;
                *(u32x4*)((bf16_t*)(wsb + R_KN) + bhs * 128 + cw) = pack8(acc[ai][0][m][0] * sc * g0, acc[ai][0][m][1] * sc * g1);
                *(u32x4*)((bf16_t*)(wsb + R_V) + bhs * 128 + cw) = pack8(acc[ai][1][m][0] * cl2, acc[ai][1][m][1] * cl2);
                const unsigned x1w = *(const unsigned*)((const bf16_t*)(wsb + R_KROPE) + row * 64 + j2), x2w = *(const unsigned*)((const bf16_t*)(wsb + R_KROPE) + row * 64 + 32 + j2);
                const f32x4 cs = *(const f32x4*)((const f32x2*)(wsb + WS_ROT) + row * 32 + j2);
                const float a0 = bflo(x1w) * rk * gk1[0], a1 = bfhi(x1w) * rk * gk1[1], b0 = bflo(x2w) * rk * gk2[0], b1 = bfhi(x2w) * rk * gk2[1];
                *(unsigned*)((bf16_t*)(wsb + R_KRH) + bhs * 64 + j2) = cvt_pk_bf16(a0 * cs[0] - b0 * cs[1], a1 * cs[2] - b1 * cs[3]);
                *(unsigned*)((bf16_t*)(wsb + R_KRH) + bhs * 64 + 32 + j2) = cvt_pk_bf16(b0 * cs[0] + a0 * cs[1], b1 * cs[2] + a1 * cs[3]); }
    }
};

#define DPPU_(old, x, ctrl) ((unsigned)__builtin_amdgcn_update_dpp((int)(old), (int)(x), (ctrl), 0xf, 0xf, false))
__device__ __forceinline__ f16x2_t f2h2(float a, float b) { const f32x2 v = {a, b}; return __builtin_convertvector(v, f16x2_t); }
__device__ __forceinline__ f16x2_t silu_mul_h2(f16x2_t cv, f16x2_t up) {
    const f16x2_t nl = {(_Float16)-1.4426950408889634f, (_Float16)-1.4426950408889634f}, one = {(_Float16)1.0f, (_Float16)1.0f};
    const f16x2_t d = one + __builtin_elementwise_exp2(cv * nl);
    f16x2_t r; r.x = __builtin_amdgcn_rcph(d.x); r.y = __builtin_amdgcn_rcph(d.y);
    return cv * r * up;
}
#define TRANS_PK4(OP, r, x) asm(OP "_e32 %0, %4\n\t" OP "_e32 %1, %5\n\t" OP "_e32 %2, %6\n\t" OP "_e32 %3, %7\n\t" \
        OP "_sdwa %0, %4 dst_sel:WORD_1 dst_unused:UNUSED_PRESERVE src0_sel:WORD_1\n\t" OP "_sdwa %1, %5 dst_sel:WORD_1 dst_unused:UNUSED_PRESERVE src0_sel:WORD_1\n\t" \
        OP "_sdwa %2, %6 dst_sel:WORD_1 dst_unused:UNUSED_PRESERVE src0_sel:WORD_1\n\t" OP "_sdwa %3, %7 dst_sel:WORD_1 dst_unused:UNUSED_PRESERVE src0_sel:WORD_1\n\ts_nop 0" \
        : "=&v"(r[0]), "=&v"(r[1]), "=&v"(r[2]), "=&v"(r[3]) : "v"(x[0]), "v"(x[1]), "v"(x[2]), "v"(x[3]))
struct EpiGateUpConv {
    static constexpr bool PERM = true, AFTER_DRAIN = false;
    const float* parts; bf16_t* act; float* gh; float* uh;
    const float* cw_; const float* cb_;
    PG8_LAS float* hx;
    PG8_LAS float* st;
    __device__ __forceinline__ void prefetch(const pg8::Unit& u, int wid, int lane) const {
        stat_dma(parts, st, u.pm, wid, lane);
    }
    __device__ __forceinline__ void operator()(const f32x4 (&acc)[2][2][4][2], const pg8::Unit& u, int wr, int wc, int fr, int fq) const {
        asm volatile("" : "+v"(fr), "+v"(fq));
        const int row0 = u.pm * 256 + wr * 64 + fr, cw = wc * 32 + 8 * fq, c0 = u.pn * 128 + cw;
        f16x2_t w0p[4], w1p[4], w2p[4], bbp[4];
#pragma unroll
        for (int n = 0; n < 2; ++n) { const f32x4 a = *(const f32x4*)(cw_ + c0 + 4 * n), b = *(const f32x4*)(cw_ + D_FF + c0 + 4 * n), c = *(const f32x4*)(cw_ + 2 * D_FF + c0 + 4 * n), d = *(const f32x4*)(cb_ + c0 + 4 * n);
            w0p[2 * n] = f2h2(a[0], a[1]); w0p[2 * n + 1] = f2h2(a[2], a[3]); w1p[2 * n] = f2h2(b[0], b[1]); w1p[2 * n + 1] = f2h2(b[2], b[3]);
            w2p[2 * n] = f2h2(c[0], c[1]); w2p[2 * n + 1] = f2h2(c[2], c[3]); bbp[2 * n] = f2h2(d[0], d[1]); bbp[2 * n + 1] = f2h2(d[2], d[3]); }
        float rs[2][4];
#pragma unroll
        for (int ai = 0; ai < 2; ++ai)
#pragma unroll
            for (int m = 0; m < 4; ++m) { const f32x4 v = *(const PG8_LAS f32x4*)(st + (wr * 64 + fr + ai * 128 + m * 16) * 16 + 4 * fq);
                float sq = (v[0] + v[1]) + (v[2] + v[3]); sq += __shfl_xor(sq, 16); sq += __shfl_xor(sq, 32);
                rs[ai][m] = __builtin_amdgcn_rsqf(sq * (1.0f / DM) + EPS); }
        if (fr >= 14) {
#pragma unroll
            for (int ai = 0; ai < 2; ++ai)
#pragma unroll
                for (int n = 0; n < 2; ++n) { const f32x4 g = acc[ai][0][3][n] * rs[ai][3];
                    *(PG8_LAS f32x4*)(hx + ((ai * 2 + wr) * 2 + (fr - 14)) * 128 + cw + 4 * n) = g;
                    if (ai == 1 && wr == 1) *(f32x4*)(gh + ((size_t)u.pm * 4 + (fr - 14)) * D_FF + c0 + 4 * n) = g; }
        }
        if (wr == 0 && fr < 2) {
#pragma unroll
            for (int n = 0; n < 2; ++n) { *(f32x4*)(gh + ((size_t)u.pm * 4 + 2 + fr) * D_FF + c0 + 4 * n) = acc[0][0][0][n] * rs[0][0];
                                          *(f32x4*)(uh + ((size_t)u.pm * 2 + fr) * D_FF + c0 + 4 * n) = acc[0][1][0][n] * rs[0][0]; }
        }
        asm volatile("s_waitcnt lgkmcnt(0)" ::: "memory"); __builtin_amdgcn_s_barrier(); asm volatile("" ::: "memory");
#pragma unroll
        for (int ai = 0; ai < 2; ++ai) {
            const int pblk = ai * 2 + wr - 1;
            unsigned prv[4];
#pragma unroll
            for (int n = 0; n < 2; ++n) { const f32x4 pv4 = (pblk >= 0) ? *(const PG8_LAS f32x4*)(hx + (pblk * 2 + (fr & 1)) * 128 + cw + 4 * n) : (f32x4){0.f, 0.f, 0.f, 0.f};
                prv[2 * n] = __builtin_bit_cast(unsigned, f2h2(pv4[0], pv4[1])); prv[2 * n + 1] = __builtin_bit_cast(unsigned, f2h2(pv4[2], pv4[3])); }
#pragma unroll
            for (int m = 0; m < 4; ++m) {
                const size_t row = (size_t)(row0 + ai * 128 + m * 16);
                unsigned gg[4], upk[4], t1[4], t2[4], g1[4], g2[4], xe[4], ee[4], dd[4], rr[4], ow[4]; f16x2_t cv[4];
#pragma unroll
                for (int n = 0; n < 2; ++n) { const f32x4 g0 = acc[ai][0][m][n] * rs[ai][m], up = acc[ai][1][m][n] * rs[ai][m];
                    gg[2 * n] = __builtin_bit_cast(unsigned, f2h2(g0[0], g0[1])); gg[2 * n + 1] = __builtin_bit_cast(unsigned, f2h2(g0[2], g0[3]));
                    upk[2 * n] = __builtin_bit_cast(unsigned, f2h2(up[0], up[1])); upk[2 * n + 1] = __builtin_bit_cast(unsigned, f2h2(up[2], up[3])); }
                asm volatile("" : "+v"(gg[0]), "+v"(gg[1]), "+v"(gg[2]), "+v"(gg[3]), "+v"(prv[0]), "+v"(prv[1]), "+v"(prv[2]), "+v"(prv[3]));
                asm volatile("" : "=v"(t1[0]), "=v"(t1[1]), "=v"(t1[2]), "=v"(t1[3]), "=v"(t2[0]), "=v"(t2[1]), "=v"(t2[2]), "=v"(t2[3]));
#pragma unroll
                for (int q = 0; q < 4; ++q) t1[q] = DPPU_(t1[q], prv[q], 0x15F);
#pragma unroll
                for (int q = 0; q < 4; ++q) g1[q] = DPPU_(t1[q], gg[q], 0x111);
#pragma unroll
                for (int q = 0; q < 4; ++q) t2[q] = DPPU_(t2[q], prv[q], 0x15E);
#pragma unroll
                for (int q = 0; q < 4; ++q) g2[q] = DPPU_(t2[q], g1[q], 0x111);
                const f16x2_t nl = {(_Float16)-1.4426950408889634f, (_Float16)-1.4426950408889634f}, one = {(_Float16)1.0f, (_Float16)1.0f};
#pragma unroll
                for (int q = 0; q < 4; ++q) { cv[q] = bbp[q] + __builtin_bit_cast(f16x2_t, g2[q]) * w0p[q] + __builtin_bit_cast(f16x2_t, g1[q]) * w1p[q] + __builtin_bit_cast(f16x2_t, gg[q]) * w2p[q];
                    xe[q] = __builtin_bit_cast(unsigned, cv[q] * nl); }
                TRANS_PK4("v_exp_f16", ee, xe);
#pragma unroll
                for (int q = 0; q < 4; ++q) dd[q] = __builtin_bit_cast(unsigned, one + __builtin_bit_cast(f16x2_t, ee[q]));
                TRANS_PK4("v_rcp_f16", rr, dd);
#pragma unroll
                for (int q = 0; q < 4; ++q) { ow[q] = __builtin_bit_cast(unsigned, cv[q] * __builtin_bit_cast(f16x2_t, rr[q]) * __builtin_bit_cast(f16x2_t, upk[q])); prv[q] = gg[q]; }
                *(u32x4*)(act + row * D_FF + c0) = (u32x4){ow[0], ow[1], ow[2], ow[3]};
            }
        }
    }
};

namespace att {
constexpr int KVBLK = 64;
constexpr float THR = 8.f;
constexpr size_t SHM_V = 64 * 128 * 2, SHM_K = 64 * 128 * 2, SHM_KR = 64 * 64 * 2;
constexpr size_t OFF_V = 0, OFF_K = 2 * SHM_V, OFF_KR = OFF_K + 2 * SHM_K, OFF_WS = OFF_KR + 2 * SHM_KR, OFF_QR = OFF_WS + 8 * 64 * 4, SHM_ATTN = OFF_QR + 8 * 9216;
#define KSWZ(row, colB) ((row) * 256 + ((colB) ^ (((row) & 7) << 4)))
#define KRSWZ(row, colB) ((row) * 128 + ((colB) ^ ((((row) >> 1) & 7) << 4)))
#define SBAR() __builtin_amdgcn_sched_barrier(0)
__device__ __forceinline__ int crow(int r, int hi) { return (r & 3) + 8 * (r >> 2) + 4 * hi; }

__device__ __forceinline__ void partialSM(f32x16& p0, f32x16& p1, float& m_reg, float& mn, float& alpha, const float Cl, const bool masked) {
    float pmax = p0[0];
#pragma unroll
    for (int r = 1; r < 16; ++r) pmax = fmaxf(pmax, p0[r]);
#pragma unroll
    for (int r = 0; r < 16; ++r) pmax = fmaxf(pmax, p1[r]);
    { auto rr = __builtin_amdgcn_permlane32_swap(__float_as_uint(pmax), __float_as_uint(pmax), false, false);
      pmax = fmaxf(__uint_as_float(rr[0]), __uint_as_float(rr[1])); }
    pmax = masked ? -1e30f : pmax;
    if (__builtin_expect(__all((pmax - m_reg) * Cl <= THR * LOG2E), 1)) { mn = m_reg; alpha = 1.f; }
    else { mn = fmaxf(m_reg, pmax); alpha = __builtin_amdgcn_exp2f((m_reg - mn) * Cl); m_reg = mn; }
    const float mnC = -mn * Cl - (masked ? 1e30f : 0.f);
#pragma unroll
    for (int r = 0; r < 16; ++r) p0[r] = fmaf(p0[r], Cl, mnC);
#pragma unroll
    for (int r = 0; r < 16; ++r) p1[r] = fmaf(p1[r], Cl, mnC);
#pragma unroll
    for (int r = 0; r < 16; ++r) p0[r] = __builtin_amdgcn_exp2f(p0[r]);
}
__device__ __forceinline__ void finishSM(f32x16& p0, f32x16& p1, float alpha, float& l_reg, bf16x8& pa0, bf16x8& pa1, bf16x8& pa2, bf16x8& pa3) {
#pragma unroll
    for (int r = 0; r < 16; ++r) p1[r] = __builtin_amdgcn_exp2f(p1[r]);
    float ps = 0;
#pragma unroll
    for (int r = 0; r < 16; ++r) ps += p0[r];
#pragma unroll
    for (int r = 0; r < 16; ++r) ps += p1[r];
    { auto rr = __builtin_amdgcn_permlane32_swap(__float_as_uint(ps), __float_as_uint(ps), false, false);
      ps = __uint_as_float(rr[0]) + __uint_as_float(rr[1]); }
    l_reg = l_reg * alpha + ps;
#define PK4(P, BASE, OUT) do { unsigned a0 = cvt_pk_bf16(P[BASE + 0], P[BASE + 1]), a1 = cvt_pk_bf16(P[BASE + 2], P[BASE + 3]);   \
    unsigned b0 = cvt_pk_bf16(P[BASE + 4], P[BASE + 5]), b1 = cvt_pk_bf16(P[BASE + 6], P[BASE + 7]);                              \
    auto r0 = __builtin_amdgcn_permlane32_swap(a0, b0, false, false); auto r1 = __builtin_amdgcn_permlane32_swap(a1, b1, false, false); \
    u32x4 w = {r0[0], r1[0], r0[1], r1[1]}; OUT = *reinterpret_cast<bf16x8*>(&w); } while (0)
    PK4(p0, 0, pa0); PK4(p0, 8, pa1); PK4(p1, 0, pa2); PK4(p1, 8, pa3);
#undef PK4
}
template <int NQ, int NQREG>
__device__ __forceinline__ void qkt(f32x16& p0, f32x16& p1, const char* Ks, const char* Krs, const bf16x8* qr, const char* qrl, int r32, int hi) {
    p0 = f32x16{}; p1 = f32x16{};
#pragma unroll
    for (int d0 = 0; d0 < 8; ++d0) { const int cb = (d0 * 16 + hi * 8) * 2;
        bf16x8 b0 = *reinterpret_cast<const bf16x8*>(Ks + KSWZ(r32, cb));
        bf16x8 b1 = *reinterpret_cast<const bf16x8*>(Ks + KSWZ(32 + r32, cb));
        bf16x8 qf; if (d0 < NQREG) qf = qr[d0 < NQREG ? d0 : 0]; else qf = *reinterpret_cast<const bf16x8*>(qrl + (d0 - NQREG) * 1024);
        p0 = __builtin_amdgcn_mfma_f32_32x32x16_bf16(b0, qf, p0, 0, 0, 0);
        p1 = __builtin_amdgcn_mfma_f32_32x32x16_bf16(b1, qf, p1, 0, 0, 0); }
    if constexpr (NQ == 12) {
        SBAR();
#pragma unroll
        for (int d1 = 0; d1 < 4; ++d1) { const int cb = (d1 * 16 + hi * 8) * 2;
            bf16x8 b0 = *reinterpret_cast<const bf16x8*>(Krs + KRSWZ(r32, cb));
            bf16x8 b1 = *reinterpret_cast<const bf16x8*>(Krs + KRSWZ(32 + r32, cb));
            bf16x8 qf; if (8 + d1 < NQREG) qf = qr[8 + d1 < NQREG ? 8 + d1 : 0]; else qf = *reinterpret_cast<const bf16x8*>(qrl + (8 + d1 - NQREG) * 1024);
            p0 = __builtin_amdgcn_mfma_f32_32x32x16_bf16(b0, qf, p0, 0, 0, 0);
            p1 = __builtin_amdgcn_mfma_f32_32x32x16_bf16(b1, qf, p1, 0, 0, 0); }
    }
}
__device__ __forceinline__ int v_st(int k, int c) { const int kk = (k & ~0xC) | ((k & 4) << 1) | ((k & 8) >> 1); return ((kk >> 3) * 4 + (c >> 5)) * 512 + ((kk & 7) * 32 + (c & 31)) * 2; }
__device__ __forceinline__ int v_rd_base(int lane) { return ((lane & 3) << 3) | (((lane >> 2) & 3) << 6) | (((lane >> 4) & 1) << 5) | (((lane >> 5) & 1) << 8); }
constexpr int v_rd_off(int d0, int ks, int half) { return d0 * 512 + ks * 4096 + half * 2048; }
template <int OFF> __device__ __forceinline__ s16x4 tr_read(int vb) {
    s16x4 r; asm volatile("ds_read_b64_tr_b16 %0, %1 offset:%2" : "=&v"(r) : "v"(vb), "i"(OFF) : "memory"); return r;
}
template <int D0> __device__ __forceinline__ void pv_one(f32x16& od, int vb, bf16x8 pa0, bf16x8 pa1, bf16x8 pa2, bf16x8 pa3) {
    const s16x4 l0 = tr_read<v_rd_off(D0, 0, 0)>(vb), h0 = tr_read<v_rd_off(D0, 0, 1)>(vb), l1 = tr_read<v_rd_off(D0, 1, 0)>(vb), h1 = tr_read<v_rd_off(D0, 1, 1)>(vb);
    const s16x4 l2 = tr_read<v_rd_off(D0, 2, 0)>(vb), h2 = tr_read<v_rd_off(D0, 2, 1)>(vb), l3 = tr_read<v_rd_off(D0, 3, 0)>(vb), h3 = tr_read<v_rd_off(D0, 3, 1)>(vb);
    asm volatile("s_waitcnt lgkmcnt(0)" ::: "memory"); SBAR();
#define PK(L, H) (bf16x8){L[0], L[1], L[2], L[3], H[0], H[1], H[2], H[3]}
    od = __builtin_amdgcn_mfma_f32_32x32x16_bf16(pa0, PK(l0, h0), od, 0, 0, 0);
    od = __builtin_amdgcn_mfma_f32_32x32x16_bf16(pa1, PK(l1, h1), od, 0, 0, 0);
    od = __builtin_amdgcn_mfma_f32_32x32x16_bf16(pa2, PK(l2, h2), od, 0, 0, 0);
    od = __builtin_amdgcn_mfma_f32_32x32x16_bf16(pa3, PK(l3, h3), od, 0, 0, 0);
#undef PK
}
__device__ __forceinline__ void pv_d0(f32x16* o, int vb, bf16x8 pa0, bf16x8 pa1, bf16x8 pa2, bf16x8 pa3) {
    pv_one<0>(o[0], vb, pa0, pa1, pa2, pa3); pv_one<1>(o[1], vb, pa0, pa1, pa2, pa3); pv_one<2>(o[2], vb, pa0, pa1, pa2, pa3); pv_one<3>(o[3], vb, pa0, pa1, pa2, pa3);
}

template <int MODE, int SDEPTH>
__device__ __forceinline__ void attn_body(const bf16_t* Qb, const int ldq, const bf16_t* Kn, const bf16_t* Krp, const bf16_t* Vh,
                                          bf16_t* Ob, const int ldo, const int NT, const int last_tile, char* lds) {
    constexpr int NQ = (MODE == 0) ? 12 : 8;
    constexpr int NLD = (MODE == 0) ? 5 : 4;
    int tid = threadIdx.x; asm volatile("" : "+v"(tid));
    const int wid = tid >> 6, lane = tid & 63, r32 = lane & 31, hi = lane >> 5;
    char* V_lds = lds + OFF_V; char* K_lds = lds + OFF_K; char* Kr_lds = lds + OFF_KR;
    float* ws = (float*)(lds + OFF_WS) + wid * 64; float* li_l = ws; float* al_l = ws + 32;
    constexpr int NQREG = (MODE == 0) ? 8 : 8;
    float m_reg = -1e30f, l_reg = 0; f32x16 o[4] = {}; bf16x8 qr[NQREG];
    const bf16_t* Qw = Qb + (size_t)(wid * 32 + r32) * ldq + hi * 8;
#pragma unroll
    for (int d0 = 0; d0 < NQREG; ++d0) qr[d0] = *reinterpret_cast<const bf16x8*>(Qw + d0 * 16);
    char* qrl = lds + OFF_QR + wid * 9216 + lane * 16;
#pragma unroll
    for (int d1 = NQREG; d1 < NQ; ++d1) *reinterpret_cast<bf16x8*>(qrl + (d1 - NQREG) * 1024) = *reinterpret_cast<const bf16x8*>(Qw + d1 * 16);
    float Cl;
    if constexpr (MODE == 0) Cl = 0.07216878364870322f * LOG2E;
    else {
        float ss = 0.f;
#pragma unroll
        for (int d0 = 0; d0 < 8; ++d0)
#pragma unroll
            for (int j = 0; j < 8; ++j) { const float x = bf2f((unsigned short)qr[d0][j]); ss = fmaf(x, x, ss); }
        { auto rr = __builtin_amdgcn_permlane32_swap(__float_as_uint(ss), __float_as_uint(ss), false, false);
          ss = __uint_as_float(rr[0]) + __uint_as_float(rr[1]); }
        Cl = 0.08838834764831845f * LOG2E * __builtin_amdgcn_rsqf(ss * (1.0f / 128.0f) + EPS);
    }
    const int sr = tid >> 4, sc = (tid & 15) * 8, vst0 = v_st(sr, sc), vst1 = v_st(32 + sr, sc);
    const int krr = tid >> 3, krc = (tid & 7) * 8;
    const int vb0 = (int)(uintptr_t)V_lds + v_rd_base(lane);
    struct { bf16x8 vs0, vs1, ks0, ks1, kr; } sr_[SDEPTH];
#define SLOAD(i, k0) do { sr_[i].vs0 = *(const bf16x8*)(Vh + (size_t)((k0) + sr) * 128 + sc); sr_[i].vs1 = *(const bf16x8*)(Vh + (size_t)((k0) + 32 + sr) * 128 + sc); \
    sr_[i].ks0 = *(const bf16x8*)(Kn + (size_t)((k0) + sr) * 128 + sc); sr_[i].ks1 = *(const bf16x8*)(Kn + (size_t)((k0) + 32 + sr) * 128 + sc); \
    if constexpr (MODE == 0) sr_[i].kr = *(const bf16x8*)(Krp + (size_t)((k0) + krr) * 64 + krc); } while (0)
#define SWRITE(b, i) do { *(bf16x8*)(V_lds + (b) * SHM_V + vst0) = sr_[i].vs0;          \
    *(bf16x8*)(V_lds + (b) * SHM_V + vst1) = sr_[i].vs1; const int kc = sc * 2;               \
    *(bf16x8*)(K_lds + (b) * SHM_K + KSWZ(sr, kc)) = sr_[i].ks0;                       \
    *(bf16x8*)(K_lds + (b) * SHM_K + KSWZ(32 + sr, kc)) = sr_[i].ks1;                  \
    if constexpr (MODE == 0) *(bf16x8*)(Kr_lds + (b) * SHM_KR + KRSWZ(krr, krc * 2)) = sr_[i].kr; } while (0)
#define SWAIT() do { if constexpr (SDEPTH == 1) asm volatile("s_waitcnt vmcnt(0)" ::: "memory"); else if constexpr (NLD == 5) asm volatile("s_waitcnt vmcnt(5)" ::: "memory"); else asm volatile("s_waitcnt vmcnt(4)" ::: "memory"); } while (0)
#define RESC(a) do { if (__any((a) < 1.f)) { if (hi == 0) al_l[r32] = (a); asm volatile("s_waitcnt lgkmcnt(0)" ::: "memory"); \
    _Pragma("unroll") for (int d = 0; d < 4; ++d) _Pragma("unroll") for (int r = 0; r < 16; ++r) o[d][r] *= al_l[crow(r, hi)]; } } while (0)
    f32x16 pA0, pA1, pB0, pB1; float mnA, mnB, alA, alB; bf16x8 pa0, pa1, pa2, pa3;
    constexpr int SE = 0, SO = SDEPTH - 1;
    SLOAD(SE, 0); asm volatile("s_waitcnt vmcnt(0)" ::: "memory"); SWRITE(0, SE); __syncthreads();
    qkt<NQ, NQREG>(pA0, pA1, K_lds, Kr_lds, qr, qrl, r32, hi); partialSM(pA0, pA1, m_reg, mnA, alA, Cl, false);
    SLOAD(SO, KVBLK); if constexpr (SDEPTH == 2) { if (2 < NT) SLOAD(SE, 2 * KVBLK); }
    SWAIT(); SWRITE(1, SO); __syncthreads();
    for (int j = 1; j + 1 < NT; j += 2) {
        SBAR(); qkt<NQ, NQREG>(pB0, pB1, K_lds + SHM_K, Kr_lds + SHM_KR, qr, qrl, r32, hi);
        finishSM(pA0, pA1, alA, l_reg, pa0, pa1, pa2, pa3); SBAR();
        SLOAD(SO, (j + SDEPTH) * KVBLK); SBAR();
        pv_d0(o, vb0, pa0, pa1, pa2, pa3); partialSM(pB0, pB1, m_reg, mnB, alB, Cl, j > last_tile);
        __syncthreads(); SWAIT(); SWRITE(0, SE);
        RESC(alB); __syncthreads();
        SBAR(); qkt<NQ, NQREG>(pA0, pA1, K_lds, Kr_lds, qr, qrl, r32, hi);
        finishSM(pB0, pB1, alB, l_reg, pa0, pa1, pa2, pa3); SBAR();
        if (SDEPTH == 1 || j + 3 < NT) SLOAD(SE, (j + 1 + SDEPTH) * KVBLK); SBAR();
        pv_d0(o, vb0 + (int)SHM_V, pa0, pa1, pa2, pa3); partialSM(pA0, pA1, m_reg, mnA, alA, Cl, (j + 1) > last_tile);
        __syncthreads(); SWAIT(); SWRITE(1, SO);
        RESC(alA); __syncthreads();
    }
    SBAR(); qkt<NQ, NQREG>(pB0, pB1, K_lds + SHM_K, Kr_lds + SHM_KR, qr, qrl, r32, hi);
    finishSM(pA0, pA1, alA, l_reg, pa0, pa1, pa2, pa3); SBAR();
    pv_d0(o, vb0, pa0, pa1, pa2, pa3); partialSM(pB0, pB1, m_reg, mnB, alB, Cl, (NT - 1) > last_tile);
    __syncthreads(); RESC(alB);
    finishSM(pB0, pB1, alB, l_reg, pa0, pa1, pa2, pa3); SBAR();
    pv_d0(o, vb0 + (int)SHM_V, pa0, pa1, pa2, pa3);
    if (hi == 0) li_l[r32] = l_reg; asm volatile("s_waitcnt lgkmcnt(0)" ::: "memory");
    float rli[16];
#pragma unroll
    for (int r = 0; r < 16; ++r) rli[r] = __builtin_amdgcn_rcpf(li_l[crow(r, hi)]);
    bf16_t* Ow = Ob + (size_t)(wid * 32) * ldo;
#pragma unroll
    for (int r = 0; r < 16; ++r) { const int orow = crow(r, hi);
#pragma unroll
        for (int d0 = 0; d0 < 4; ++d0) Ow[(size_t)orow * ldo + d0 * 32 + r32] = f2bf(o[d0][r] * rli[r]); }
#undef SLOAD
#undef SWRITE
#undef SWAIT
#undef RESC
}

__device__ __forceinline__ void qkt12(f32x16& p0, f32x16& p1, const char* Ks, const char* Krs, const bf16x8* qr, int r32, int hi) {
    p0 = f32x16{}; p1 = f32x16{};
    const int x7 = (r32 & 7) << 4, xr = ((r32 >> 1) & 7) << 4;
    const int kb = (int)(uintptr_t)Ks + r32 * 256, krb = (int)(uintptr_t)Krs + r32 * 128;
    bf16x8 f0[2], f1[2];
#define QK_RD(slot, d) do { if ((d) < 8) { const int ad_ = kb + ((((d) * 32) + hi * 16) ^ x7); \
            asm volatile("ds_read_b128 %0, %1" : "=&v"(f0[slot]) : "v"(ad_) : "memory"); asm volatile("ds_read_b128 %0, %1 offset:8192" : "=&v"(f1[slot]) : "v"(ad_) : "memory"); } \
        else { const int ad_ = krb + (((((d) - 8) * 32) + hi * 16) ^ xr); \
            asm volatile("ds_read_b128 %0, %1" : "=&v"(f0[slot]) : "v"(ad_) : "memory"); asm volatile("ds_read_b128 %0, %1 offset:4096" : "=&v"(f1[slot]) : "v"(ad_) : "memory"); } } while (0)
    QK_RD(0, 0);
#pragma unroll
    for (int d = 0; d < 12; ++d) { const int sl = d & 1;
        if (d + 1 < 12) { QK_RD(sl ^ 1, d + 1); asm volatile("s_waitcnt lgkmcnt(2)" : "+v"(f0[sl]), "+v"(f1[sl]) :: "memory"); }
        else asm volatile("s_waitcnt lgkmcnt(0)" : "+v"(f0[sl]), "+v"(f1[sl]) :: "memory");
        p0 = __builtin_amdgcn_mfma_f32_32x32x16_bf16(f0[sl], qr[d], p0, 0, 0, 0);
        p1 = __builtin_amdgcn_mfma_f32_32x32x16_bf16(f1[sl], qr[d], p1, 0, 0, 0);
    }
#undef QK_RD
}

constexpr size_t D_OFF_V = 0, D_OFF_K = 3 * SHM_V, D_OFF_KR = D_OFF_K + 3 * SHM_K, D_OFF_WS = D_OFF_KR + 3 * SHM_KR, SHM_ATTN_DMA = D_OFF_WS + 8 * 64 * 4;
__device__ __forceinline__ void attn_body_dma(const bf16_t* Qb, const int ldq, const bf16_t* Kn, const bf16_t* Krp, const bf16_t* Vh,
                                              bf16_t* Ob, const int ldo, const int NT, const int last_tile, char* lds, LAS unsigned char* ldsl) {
    int tid = threadIdx.x; asm volatile("" : "+v"(tid));
    const int wid = __builtin_amdgcn_readfirstlane(tid >> 6), lane = tid & 63, r32 = lane & 31, hi = lane >> 5;
    char* K_lds = lds + D_OFF_K; char* Kr_lds = lds + D_OFF_KR;
    float* ws = (float*)(lds + D_OFF_WS) + wid * 64; float* li_l = ws; float* al_l = ws + 32;
    float m_reg = -1e30f, l_reg = 0; f32x16 o[4] = {}; bf16x8 qr[12];
    const bf16_t* Qw = Qb + (size_t)(wid * 32 + r32) * ldq + hi * 8;
#pragma unroll
    for (int d0 = 0; d0 < 12; ++d0) qr[d0] = *reinterpret_cast<const bf16x8*>(Qw + d0 * 16);
    const float Cl = 0.07216878364870322f * LOG2E;
    unsigned ko[2], vo[2], kro;
#pragma unroll
    for (int i = 0; i < 2; ++i) { const int sb = (i * 8 + wid) * 1024 + lane * 16;
        { const int row = sb >> 8, cb = (sb & 255) ^ ((row & 7) << 4); ko[i] = (unsigned)(row * 128 + (cb >> 1)); }
        { const int sub = sb >> 9, wi = sb & 511, kk = (sub >> 2) * 8 + (wi >> 6), c = (sub & 3) * 32 + ((wi & 63) >> 1), k = (kk & ~0xC) | ((kk & 4) << 1) | ((kk & 8) >> 1);
          vo[i] = (unsigned)(k * 128 + c); } }
    { const int sb = wid * 1024 + lane * 16; const int row = sb >> 7, cb = (sb & 127) ^ (((row >> 1) & 7) << 4); kro = (unsigned)(row * 64 + (cb >> 1)); }
    const int vbb = (int)(uintptr_t)(lds + D_OFF_V) + v_rd_base(lane);
#define ADMA(st, k0) do { _Pragma("unroll") for (int i_ = 0; i_ < 2; ++i_) { \
        __builtin_amdgcn_global_load_lds((const unsigned*)(Kn + (size_t)(k0) * 128 + ko[i_]), (LAS unsigned*)(ldsl + D_OFF_K + (st) * SHM_K + (i_ * 8 + wid) * 1024), 16, 0, 0); \
        __builtin_amdgcn_global_load_lds((const unsigned*)(Vh + (size_t)(k0) * 128 + vo[i_]), (LAS unsigned*)(ldsl + D_OFF_V + (st) * SHM_V + (i_ * 8 + wid) * 1024), 16, 0, 0); } \
        __builtin_amdgcn_global_load_lds((const unsigned*)(Krp + (size_t)(k0) * 64 + kro), (LAS unsigned*)(ldsl + D_OFF_KR + (st) * SHM_KR + wid * 1024), 16, 0, 0); } while (0)
#define AWAIT() asm volatile("s_waitcnt vmcnt(0)" ::: "memory")
#define RESC(a) do { if (__any((a) < 1.f)) { if (hi == 0) al_l[r32] = (a); asm volatile("s_waitcnt lgkmcnt(0)" ::: "memory"); \
    _Pragma("unroll") for (int d = 0; d < 4; ++d) _Pragma("unroll") for (int r = 0; r < 16; ++r) o[d][r] *= al_l[crow(r, hi)]; } } while (0)
    f32x16 pA0, pA1, pB0, pB1; float mnA, mnB, alA, alB; bf16x8 pa0, pa1, pa2, pa3;
    __syncthreads();
    ADMA(0, 0); ADMA(1, KVBLK);
    AWAIT(); __syncthreads();
    qkt12(pA0, pA1, K_lds, Kr_lds, qr, r32, hi); partialSM(pA0, pA1, m_reg, mnA, alA, Cl, false);
    int sa = 0, sb_ = 1, sc = 2;
#pragma unroll 1
    for (int j = 1; j + 1 < NT; j += 2) {
        ADMA(sc, (j + 1) * KVBLK);
        SBAR(); qkt12(pB0, pB1, K_lds + sb_ * SHM_K, Kr_lds + sb_ * SHM_KR, qr, r32, hi);
        finishSM(pA0, pA1, alA, l_reg, pa0, pa1, pa2, pa3); SBAR();
        pv_d0(o, vbb + sa * (int)SHM_V, pa0, pa1, pa2, pa3); partialSM(pB0, pB1, m_reg, mnB, alB, Cl, j > last_tile);
        RESC(alB); AWAIT(); __syncthreads();
        if (j + 2 < NT) ADMA(sa, (j + 2) * KVBLK);
        SBAR(); qkt12(pA0, pA1, K_lds + sc * SHM_K, Kr_lds + sc * SHM_KR, qr, r32, hi);
        finishSM(pB0, pB1, alB, l_reg, pa0, pa1, pa2, pa3); SBAR();
        pv_d0(o, vbb + sb_ * (int)SHM_V, pa0, pa1, pa2, pa3); partialSM(pA0, pA1, m_reg, mnA, alA, Cl, (j + 1) > last_tile);
        RESC(alA); AWAIT(); __syncthreads();
        const int t_ = sa; sa = sc; sc = sb_; sb_ = t_;
    }
    SBAR(); qkt12(pB0, pB1, K_lds + sb_ * SHM_K, Kr_lds + sb_ * SHM_KR, qr, r32, hi);
    finishSM(pA0, pA1, alA, l_reg, pa0, pa1, pa2, pa3); SBAR();
    pv_d0(o, vbb + sa * (int)SHM_V, pa0, pa1, pa2, pa3); partialSM(pB0, pB1, m_reg, mnB, alB, Cl, (NT - 1) > last_tile);
    RESC(alB);
    finishSM(pB0, pB1, alB, l_reg, pa0, pa1, pa2, pa3); SBAR();
    pv_d0(o, vbb + sb_ * (int)SHM_V, pa0, pa1, pa2, pa3);
    if (hi == 0) li_l[r32] = l_reg; asm volatile("s_waitcnt lgkmcnt(0)" ::: "memory");
    float rli[16];
#pragma unroll
    for (int r = 0; r < 16; ++r) rli[r] = __builtin_amdgcn_rcpf(li_l[crow(r, hi)]);
    bf16_t* Ow = Ob + (size_t)(wid * 32) * ldo;
#pragma unroll
    for (int r = 0; r < 16; ++r) { const int orow = crow(r, hi);
#pragma unroll
        for (int d0 = 0; d0 < 4; ++d0) Ow[(size_t)orow * ldo + d0 * 32 + r32] = f2bf(o[d0][r] * rli[r]); }
#undef ADMA
#undef AWAIT
#undef RESC
}
}

static_assert(att::SHM_ATTN <= LDS_MISC && att::SHM_ATTN_DMA <= LDS_MISC, "attention LDS");

struct Params {
    const float* in[29];
    float* out; unsigned char* ws;
    int ph_lo, ph_hi;
};

__device__ const double INVF[32] = {1.0, 0.7498942093324559, 0.5623413251903491, 0.4216965034285822, 0.31622776601683794, 0.23713737056616552, 0.1778279410038923, 0.1333521432163324, 0.1, 0.07498942093324558, 0.05623413251903491, 0.042169650342858224, 0.03162277660168379, 0.023713737056616554, 0.01778279410038923, 0.01333521432163324, 0.01, 0.007498942093324558, 0.005623413251903491, 0.004216965034285823, 0.0031622776601683794, 0.0023713737056616554, 0.0017782794100389228, 0.001333521432163324, 0.001, 0.0007498942093324559, 0.0005623413251903491, 0.00042169650342858224, 0.00031622776601683794, 0.00023713737056616554, 0.00017782794100389227, 0.0001333521432163324};

template <bool F16, class F>
__device__ __forceinline__ void build_bt(bf16_t* Bt0, const int N, const int K, const float* W0, const size_t wstride, const int ldw, const float* gain0, const int gstride, F srcmap,
                                         size_t& g, size_t& base, const size_t ngt) {
    const size_t per = (size_t)(N / 4) * (K / 8), total = per * DEPTH;
    for (; g < base + total; g += ngt) {
        const size_t b = g - base; const int l = (int)(b / per), r = (int)(b % per);
        const int n0 = (r % (N / 4)) * 4, k0 = (r / (N / 4)) * 8;
        float sc; const int src = srcmap(n0, sc);
        if (src == -2) continue;
        const float* W = W0 + (size_t)l * wstride;
        f32x4 v[8];
#pragma unroll
        for (int j = 0; j < 8; ++j) v[j] = (src >= 0) ? *(const f32x4*)(W + (size_t)(k0 + j) * ldw + src) : (f32x4){0.f, 0.f, 0.f, 0.f};
        if (gain0) {
#pragma unroll
            for (int j = 0; j < 8; ++j) v[j] *= gain0[(size_t)l * gstride + k0 + j] * sc;
        } else {
#pragma unroll
            for (int j = 0; j < 8; ++j) v[j] *= sc;
        }
        bf16_t* Bt = Bt0 + (size_t)l * W_LAYER + (size_t)n0 * K + k0;
#pragma unroll
        for (int e = 0; e < 4; ++e) {
            u32x4 w;
            if constexpr (F16) { w.x = cvt_pk_f16(v[0][e], v[1][e]); w.y = cvt_pk_f16(v[2][e], v[3][e]); w.z = cvt_pk_f16(v[4][e], v[5][e]); w.w = cvt_pk_f16(v[6][e], v[7][e]); }
            else { w.x = cvt_pk_bf16(v[0][e], v[1][e]); w.y = cvt_pk_bf16(v[2][e], v[3][e]); w.z = cvt_pk_bf16(v[4][e], v[5][e]); w.w = cvt_pk_bf16(v[6][e], v[7][e]); }
            *(u32x4*)(Bt + (size_t)e * K) = w;
        }
    }
    base += total;
}

__device__ __forceinline__ void sincos_d(double a, float& c, float& s) {
    const double k = __builtin_rint(a * 0.6366197723675814);
    double r = __builtin_fma(-k, 1.5707963267948966, a); r = __builtin_fma(-k, 6.123233995736766e-17, r);
    const double r2 = r * r;
    double sp = -7.647163731819816e-13; sp = sp * r2 + 1.6059043836821613e-10; sp = sp * r2 - 2.505210838544172e-08; sp = sp * r2 + 2.7557319223985893e-06;
    sp = sp * r2 - 1.984126984126984e-04; sp = sp * r2 + 8.333333333333333e-03; sp = sp * r2 - 1.6666666666666666e-01; sp = r + r * r2 * sp;
    double cp = 4.779477332387385e-14; cp = cp * r2 - 1.1470745597729725e-11; cp = cp * r2 + 2.08767569878681e-09; cp = cp * r2 - 2.755731922398589e-07;
    cp = cp * r2 + 2.48015873015873e-05; cp = cp * r2 - 1.388888888888889e-03; cp = cp * r2 + 4.1666666666666664e-02; cp = cp * r2 - 0.5; cp = 1.0 + r2 * cp;
    const int q = ((int)k) & 3;
    const double sv = (q == 0) ? sp : (q == 1) ? cp : (q == 2) ? -sp : -cp;
    const double cv = (q == 0) ? cp : (q == 1) ? -sp : (q == 2) ? -cp : sp;
    s = (float)sv; c = (float)cv;
}

constexpr int SEGL = 256, NSEG = SEQ / SEGL;

namespace scan {
typedef short bf16x4 __attribute__((ext_vector_type(4)));
constexpr int QT = 0, KT = 2048, KH = 4096, VT = 6144, DC = 8192, WREG = 8448;
template <int OFF> __device__ __forceinline__ bf16x4 trd(int addr) { bf16x4 r; asm volatile("ds_read_b64_tr_b16 %0, %1 offset:%2" : "=&v"(r) : "v"(addr), "i"(OFF) : "memory"); return r; }
__device__ __forceinline__ u32x4 pk8(const float* x) { u32x4 w; w.x = cvt_pk_bf16(x[0], x[1]); w.y = cvt_pk_bf16(x[2], x[3]); w.z = cvt_pk_bf16(x[4], x[5]); w.w = cvt_pk_bf16(x[6], x[7]); return w; }

template <int DK, bool OUT>
__device__ __forceinline__ void seg(const _Float16* la_base, const int la_stride, const bf16_t* q_base, const bf16_t* k_base, const bf16_t* v_base, const bf16_t* g_base,
                                    float* Sio, float* Pout, const float* gain, bf16_t* y_base, char* wl, const int lane_in) {
    constexpr int NM = DK / 16, NS = DK / 32;
    int lane = lane_in; asm volatile("" : "+v"(lane));
    const int l16 = lane & 15, g4 = lane >> 4, ch = lane & (DK - 1);
    const int wla = (int)(uintptr_t)wl;
    float* sbase = Sio + (4 * g4) * 64 + l16;
    f32x4 S[NM][4];
#pragma unroll
    for (int m = 0; m < NM; ++m)
#pragma unroll
        for (int n = 0; n < 4; ++n) {
            if constexpr (OUT) {
#pragma unroll
                for (int r = 0; r < 4; ++r) S[m][n][r] = sbase[(16 * m + r) * 64 + 16 * n];
            } else S[m][n] = (f32x4){0.f, 0.f, 0.f, 0.f};
        }
    float gn[4] = {1.f, 1.f, 1.f, 1.f};
    if constexpr (OUT) {
#pragma unroll
        for (int n = 0; n < 4; ++n) gn[n] = gain[16 * n + l16];
        asm volatile("s_waitcnt vmcnt(0)" ::: "memory");
    }
    float btot = 0.f;
    constexpr bool HALF = (DK == 32); constexpr int TT = HALF ? 8 : 16;
    const int hf = HALF ? (lane >> 5) : 0, tb = hf * 8;
    float la_n[TT]; unsigned short q_n[TT], k_n[TT], v_n[16];
#pragma unroll
    for (int t = 0; t < 16; ++t) v_n[t] = v_base[(size_t)t * 256 + lane];
#pragma unroll
    for (int t = 0; t < TT; ++t) { la_n[t] = (float)la_base[(size_t)(tb + t) * la_stride + ch]; k_n[t] = k_base[(size_t)(tb + t) * 256 + ch];
        if constexpr (OUT) q_n[t] = q_base[(size_t)(tb + t) * 256 + ch]; }
#pragma unroll 1
    for (int c = 0; c < SEGL / 16; ++c) {
        unsigned short gt16[4][4];
        if constexpr (OUT) {
#pragma unroll
            for (int r = 0; r < 4; ++r)
#pragma unroll
                for (int n = 0; n < 4; ++n) gt16[r][n] = g_base[((size_t)c * 16 + 4 * g4 + r) * 256 + 16 * n + l16];
        }
        unsigned qw[TT / 2], ktw[TT / 2], khw[TT / 2]; float bL;
        float pre = 0.f, post = 0.f, tot2 = 0.f;
        if constexpr (HALF) { float tot = 0.f;
#pragma unroll
            for (int t = 0; t < TT; ++t) tot += la_n[t];
            auto rr = __builtin_amdgcn_permlane32_swap(__float_as_uint(tot), __float_as_uint(tot), false, false);
            tot2 = __uint_as_float(rr[0]) + __uint_as_float(rr[1]);
            const float oth = tot2 - tot; pre = hf ? oth : 0.f; post = hf ? 0.f : oth; }
        if constexpr (OUT) { float b = pre;
#pragma unroll
            for (int tp = 0; tp < TT / 2; ++tp) {
                b += la_n[2 * tp]; const float e0 = b; b += la_n[2 * tp + 1]; const float e1 = b;
                qw[tp] = cvt_pk_bf16(bf2f(q_n[2 * tp]) * __builtin_amdgcn_exp2f(e0), bf2f(q_n[2 * tp + 1]) * __builtin_amdgcn_exp2f(e1));
                ktw[tp] = cvt_pk_bf16(bf2f(k_n[2 * tp]) * __builtin_amdgcn_exp2f(fminf(-e0, 115.f)), bf2f(k_n[2 * tp + 1]) * __builtin_amdgcn_exp2f(fminf(-e1, 115.f)));
            } }
        { float cs = post;
#pragma unroll
            for (int tp = TT / 2 - 1; tp >= 0; --tp) {
                const float h1 = bf2f(k_n[2 * tp + 1]) * __builtin_amdgcn_exp2f(cs); cs += la_n[2 * tp + 1];
                const float h0 = bf2f(k_n[2 * tp]) * __builtin_amdgcn_exp2f(cs); cs += la_n[2 * tp];
                khw[tp] = cvt_pk_bf16(h0, h1);
            }
            bL = HALF ? tot2 : cs; }
        btot += bL;
        u32x4 vv0, vv1;
        vv0.x = (unsigned)v_n[0] | ((unsigned)v_n[1] << 16); vv0.y = (unsigned)v_n[2] | ((unsigned)v_n[3] << 16); vv0.z = (unsigned)v_n[4] | ((unsigned)v_n[5] << 16); vv0.w = (unsigned)v_n[6] | ((unsigned)v_n[7] << 16);
        vv1.x = (unsigned)v_n[8] | ((unsigned)v_n[9] << 16); vv1.y = (unsigned)v_n[10] | ((unsigned)v_n[11] << 16); vv1.z = (unsigned)v_n[12] | ((unsigned)v_n[13] << 16); vv1.w = (unsigned)v_n[14] | ((unsigned)v_n[15] << 16);
        if (c + 1 < SEGL / 16) {
#pragma unroll
            for (int t = 0; t < 16; ++t) v_n[t] = v_base[((size_t)(c + 1) * 16 + t) * 256 + lane];
#pragma unroll
            for (int t = 0; t < TT; ++t) { const size_t tt = (size_t)(c + 1) * 16 + tb + t;
                la_n[t] = (float)la_base[tt * la_stride + ch]; k_n[t] = k_base[tt * 256 + ch];
                if constexpr (OUT) q_n[t] = q_base[tt * 256 + ch]; }
        }
        if constexpr (HALF) {
            *(u32x4*)(wl + KH + ch * 32 + hf * 16) = (u32x4){khw[0], khw[1], khw[2], khw[3]};
            if constexpr (OUT) { *(u32x4*)(wl + KT + ch * 32 + hf * 16) = (u32x4){ktw[0], ktw[1], ktw[2], ktw[3]}; *(u32x4*)(wl + QT + ch * 32 + hf * 16) = (u32x4){qw[0], qw[1], qw[2], qw[3]}; }
            if (lane < DK) *(float*)(wl + DC + ch * 4) = __builtin_amdgcn_exp2f(bL);
        } else if (lane < DK) {
            *(u32x4*)(wl + KH + ch * 32) = (u32x4){khw[0], khw[1], khw[2], khw[3]}; *(u32x4*)(wl + KH + ch * 32 + 16) = (u32x4){khw[4 % (TT / 2)], khw[5 % (TT / 2)], khw[6 % (TT / 2)], khw[7 % (TT / 2)]};
            if constexpr (OUT) { *(u32x4*)(wl + KT + ch * 32) = (u32x4){ktw[0], ktw[1], ktw[2], ktw[3]}; *(u32x4*)(wl + KT + ch * 32 + 16) = (u32x4){ktw[4 % (TT / 2)], ktw[5 % (TT / 2)], ktw[6 % (TT / 2)], ktw[7 % (TT / 2)]};
                                 *(u32x4*)(wl + QT + ch * 32) = (u32x4){qw[0], qw[1], qw[2], qw[3]}; *(u32x4*)(wl + QT + ch * 32 + 16) = (u32x4){qw[4 % (TT / 2)], qw[5 % (TT / 2)], qw[6 % (TT / 2)], qw[7 % (TT / 2)]}; }
            *(float*)(wl + DC + ch * 4) = __builtin_amdgcn_exp2f(bL);
        }
        *(u32x4*)(wl + VT + lane * 32) = vv0; *(u32x4*)(wl + VT + lane * 32 + 16) = vv1;
        asm volatile("s_waitcnt lgkmcnt(0)" ::: "memory");
        bf16x4 vf[4];
#pragma unroll
        for (int n = 0; n < 4; ++n) vf[n] = *(const bf16x4*)(wl + VT + (16 * n + l16) * 32 + g4 * 8);
        f32x4 O[4];
        if constexpr (OUT) {
            bf16x8 qf[NS], kf8[NS];
#pragma unroll
            for (int s2 = 0; s2 < NS; ++s2) {
                const int a0 = wla + (32 * s2 + 4 * g4) * 32 + l16 * 8;
                bf16x4 q0 = trd<QT>(a0), q1 = trd<QT + 512>(a0), k0 = trd<KT>(a0), k1 = trd<KT + 512>(a0);
                asm volatile("s_waitcnt lgkmcnt(0)" : "+v"(q0), "+v"(q1), "+v"(k0), "+v"(k1) :: "memory");
                qf[s2] = (bf16x8){q0[0], q0[1], q0[2], q0[3], q1[0], q1[1], q1[2], q1[3]};
                kf8[s2] = (bf16x8){k0[0], k0[1], k0[2], k0[3], k1[0], k1[1], k1[2], k1[3]};
            }
            __builtin_amdgcn_sched_barrier(0);
#pragma unroll
            for (int n = 0; n < 4; ++n) { O[n] = (f32x4){0.f, 0.f, 0.f, 0.f};
#pragma unroll
                for (int s2 = 0; s2 < NS; ++s2) {
                    u32x4 w; w.x = cvt_pk_bf16(S[2 * s2][n][0], S[2 * s2][n][1]); w.y = cvt_pk_bf16(S[2 * s2][n][2], S[2 * s2][n][3]);
                    w.z = cvt_pk_bf16(S[2 * s2 + 1][n][0], S[2 * s2 + 1][n][1]); w.w = cvt_pk_bf16(S[2 * s2 + 1][n][2], S[2 * s2 + 1][n][3]);
                    O[n] = __builtin_amdgcn_mfma_f32_16x16x32_bf16(qf[s2], *reinterpret_cast<bf16x8*>(&w), O[n], 0, 0, 0); } }
            f32x4 P = (f32x4){0.f, 0.f, 0.f, 0.f};
#pragma unroll
            for (int s2 = 0; s2 < NS; ++s2) P = __builtin_amdgcn_mfma_f32_16x16x32_bf16(kf8[s2], qf[s2], P, 0, 0, 0);
#pragma unroll
            for (int r = 0; r < 4; ++r) P[r] = (4 * g4 + r <= l16) ? P[r] : 0.f;
            u32x2 pw; pw.x = cvt_pk_bf16(P[0], P[1]); pw.y = cvt_pk_bf16(P[2], P[3]);
            const bf16x4 pf = *reinterpret_cast<bf16x4*>(&pw);
#pragma unroll
            for (int n = 0; n < 4; ++n) O[n] = __builtin_amdgcn_mfma_f32_16x16x16bf16_1k(pf, vf[n], O[n], 0, 0, 0);
        }
#pragma unroll
        for (int m = 0; m < NM; ++m) {
            const f32x4 dc = *(const f32x4*)(wl + DC + (16 * m + 4 * g4) * 4);
            const bf16x4 khf = *(const bf16x4*)(wl + KH + (16 * m + l16) * 32 + g4 * 8);
#pragma unroll
            for (int n = 0; n < 4; ++n) S[m][n] = __builtin_amdgcn_mfma_f32_16x16x16bf16_1k(khf, vf[n], S[m][n] * dc, 0, 0, 0);
        }
        if constexpr (OUT) {
            float ss[4];
#pragma unroll
            for (int r = 0; r < 4; ++r) { ss[r] = (O[0][r] * O[0][r] + O[1][r] * O[1][r]) + (O[2][r] * O[2][r] + O[3][r] * O[3][r]); ss[r] = sum16(ss[r]); }
#pragma unroll
            for (int r = 0; r < 4; ++r) { const float rs = __builtin_amdgcn_rsqf(ss[r] * (1.0f / 64.0f) + EPS); const size_t tt = (size_t)c * 16 + 4 * g4 + r;
#pragma unroll
                for (int n = 0; n < 4; ++n) { const float gt_ = bf2f(gt16[r][n]);
                    y_base[tt * 1024 + 16 * n + l16] = f2bf(O[n][r] * rs * gn[n] * gt_); } }
        }
    }
    if constexpr (!OUT) {
#pragma unroll
        for (int m = 0; m < NM; ++m)
#pragma unroll
            for (int n = 0; n < 4; ++n)
#pragma unroll
                for (int r = 0; r < 4; ++r) sbase[(16 * m + r) * 64 + 16 * n] = S[m][n][r];
        if (lane < DK) Pout[ch] = __builtin_amdgcn_exp2f(btot);
    }
}
}

__device__ __forceinline__ int opq(int i) { asm volatile("" : "+s"(i)); return i; }

constexpr int NPH = 18, NPRE = 3, NPHASES = NPRE + DEPTH * NPH;

template <int SEL>
__global__ void __launch_bounds__(NTHREADS, 2) mk_fwd(Params p) {
    extern __shared__ __attribute__((aligned(16))) unsigned char lds[];
    const int bx = blockIdx.x, G = gridDim.x;
    const size_t ngt = (size_t)G * NTHREADS;
    const int ngw = G * NWAVES;
    PG8_LAS unsigned char* glds = (PG8_LAS unsigned char*)lds;
#define PHASE_BEGIN \
    int tid = threadIdx.x; asm volatile("" : "+v"(tid)); \
    const int lane = tid & 63, wave = __builtin_amdgcn_readfirstlane(tid >> 6); \
    const size_t gt = (size_t)bx * NTHREADS + tid; const int gw = bx * NWAVES + wave; \
    size_t wsz_ = 0; asm volatile("" : "+s"(wsz_)); unsigned char* ws = p.ws + wsz_;     \
    (void)lane; (void)wave; (void)gt; (void)gw;
#define PIN(i) (p.in[opq(i)])
#if MK_FUSED
    volatile LAS unsigned* misc = (volatile LAS unsigned*)((LAS unsigned char*)lds + LDS_MISC);
    if (threadIdx.x < 4) misc[threadIdx.x] = 0u;
    __syncthreads();
    XcdBarrier bar = xcd_barrier_post((unsigned*)(p.ws + WS_CTL), misc);
#define GRID_BAR() xcd_barrier(bar)
#else
#define GRID_BAR() do { } while (0)
#endif
    const int lo = p.ph_lo, hi = p.ph_hi;
#define PHSEL(i) (SEL < 0 || (i) + 1 == SEL)
#define INR(k) (lo <= (k) && (k) < hi)
#define IN(k) (PHSEL(-1) && INR(k))
#define SEAM(k) do { if (INR(k) && INR((k) + 1)) { GRID_BAR(); if ((PROBE_MASK >> 29) & 1) GRID_BAR(); } } while (0)
#define INP(i) (PHSEL(i) && INR(pb + (i)))
#define SEAMP(i) SEAM(pb + (i))

#define x_in (PIN(0))
#define hout (p.out)
#define lbt ((float*)(ws + WS_LB))
#define rstd ((float*)(ws + WS_RSTD))
#define part ((float*)(ws + WS_PART))
#define latpb ((float*)(ws + WS_LATP))
#define cq ((float*)(ws + WS_CQ))
#define ckv ((float*)(ws + WS_CKV))
#define memrstd ((float*)(ws + WS_MEMRSTD))
#define memb ((bf16_t*)(ws + WS_MEMB))
#define kvraw_ca ((float*)(ws + WS_R))
#define kca ((bf16_t*)(ws + WS_KCA))
#define vca ((bf16_t*)(ws + WS_VCA))
#define rot ((f32x2*)(ws + WS_ROT))
#define wall ((bf16_t*)(ws + WS_W))
#define hb ((bf16_t*)(ws + WS_HB))
#define gqk ((bf16_t*)(ws + R_GQK))
#define gv ((bf16_t*)(ws + R_GV))
#define gr ((bf16_t*)(ws + R_GR))
#define hq ((bf16_t*)(ws + R_HQ))
#define hi_ ((bf16_t*)(ws + R_HI))
#define hg ((bf16_t*)(ws + R_HG))
#define hk ((bf16_t*)(ws + R_HK))
#define ga ((const _Float16*)(ws + R_GA))
#define ha ((const _Float16*)(ws + R_HA))
#define qlat ((bf16_t*)(ws + R_QLAT))
#define kvlat ((bf16_t*)(ws + R_KVLAT))
#define krope ((bf16_t*)(ws + R_KROPE))
#define ybuf ((bf16_t*)(ws + R_Y))
#define sg ((float*)(ws + R_SG))
#define sh ((float*)(ws + R_SH))
#define pg ((float*)(ws + R_PG))
#define ph ((float*)(ws + R_PH))
#define qb ((bf16_t*)(ws + R_Q))
#define krh ((bf16_t*)(ws + R_KRH))
#define qraw ((bf16_t*)(ws + R_QRAW))
#define kvraw ((bf16_t*)(ws + R_KVRAW))
#define kn ((bf16_t*)(ws + R_KN))
#define vb ((bf16_t*)(ws + R_V))
#define qca ((bf16_t*)(ws + R_QCA))
#define oca ((bf16_t*)(ws + R_OCA))
#define ghb ((float*)(ws + R_GH))
#define uhb ((float*)(ws + R_UH))
#define uraw ((bf16_t*)(ws + R_URAW))

#define NORM_PHASE(SRC) do {   \
        for (int r0 = gw * 4; r0 < T; r0 += ngw * 4) { \
            f32x4 v[4][4]; float s[4]; \
            _Pragma("unroll") for (int q = 0; q < 4; ++q) { const f32x4* xr = (const f32x4*)((SRC) + (size_t)(r0 + q) * DM) + lane; \
                _Pragma("unroll") for (int j = 0; j < 4; ++j) v[q][j] = xr[64 * j]; } \
            _Pragma("unroll") for (int q = 0; q < 4; ++q) { float a = 0.f; \
                _Pragma("unroll") for (int j = 0; j < 4; ++j) a += (v[q][j][0] * v[q][j][0] + v[q][j][1] * v[q][j][1]) + (v[q][j][2] * v[q][j][2] + v[q][j][3] * v[q][j][3]); \
                s[q] = wave_sum_dpp(a); } \
            _Pragma("unroll") for (int q = 0; q < 4; ++q) { \
                if (lane < 16) part[(size_t)(r0 + q) * 16 + lane] = (lane == 0) ? s[q] : 0.f; \
                u32x2* o8 = (u32x2*)(hb + (size_t)(r0 + q) * DM) + lane; \
                _Pragma("unroll") for (int j = 0; j < 4; ++j) o8[64 * j] = (u32x2){cvt_pk_f16(v[q][j][0], v[q][j][1]), cvt_pk_f16(v[q][j][2], v[q][j][3])}; } \
        } } while (0)
    if (IN(0)) { for (int rep0_ = 0; rep0_ < (((PROBE_MASK >> 30) & 1) ? 2 : 1); ++rep0_) {
        PHASE_BEGIN
        {
            size_t g = gt, base = 0;
            build_bt<true>(wall + W_IN, 2560, 1024, PIN(4), (size_t)DM * P_IN, P_IN, PIN(3), DM, [](int n, float& sc) -> int { sc = 1.f;
                if (n < 512) return n;
                if (n < 640) { sc = 0.17677669529663687f; return 576 + (n - 512); }
                if (n < 768) return 704 + (n - 640);
                if (n < 896) return -2;
                if (n < 960) return 512 + (n - 896);
                if (n < 1024) return -1;
                if (n < 1280) return 832 + (n - 1024);
                if (n < 1536) return 1104 + (n - 1280);
                return 1360 + (n - 1536); }, g, base, ngt);
            build_bt<false>(wall + W_Q, 1024, 256, PIN(6), (size_t)256 * 768, 768, PIN(5), 256, [](int n, float& sc) -> int { sc = 1.f; const int h = n >> 8, c = n & 255;
                if (c < 128) return h * 192 + c;
                if (c >= 192) return -1;
                const int cc = c - 128, jb = 4 * (4 * (cc >> 5) + ((cc >> 3) & 3)), i8 = cc & 7;
                return h * 192 + (i8 < 4 ? 128 + jb + i8 : 160 + jb + (i8 - 4)); }, g, base, ngt);
            build_bt<false>(wall + W_KV, 1024, 256, PIN(8), (size_t)256 * 1024, 1024, PIN(7), 256, [](int n, float& sc) -> int { sc = 1.f; return n; }, g, base, ngt);
            build_bt<false>(wall + W_MIX, 1024, 1024, PIN(16), (size_t)1024 * 1024, 1024, nullptr, 0, [](int n, float& sc) -> int { sc = 1.f; return n; }, g, base, ngt);
            build_bt<true>(wall + W_CAQ, 512, 1024, PIN(19), (size_t)1024 * 512, 512, PIN(17), DM, [](int n, float& sc) -> int { sc = 1.f; return n; }, g, base, ngt);
            build_bt<false>(wall + W_CAKV, 1024, 1024, PIN(20), (size_t)1024 * 1024, 1024, PIN(18), DM, [](int n, float& sc) -> int { sc = 1.f; return n; }, g, base, ngt);
            build_bt<false>(wall + W_CAO, 1024, 512, PIN(23), (size_t)512 * 1024, 1024, nullptr, 0, [](int n, float& sc) -> int { sc = 1.f; return n; }, g, base, ngt);
            build_bt<true>(wall + W_FFI, 5632, 1024, PIN(25), (size_t)1024 * 5632, 5632, PIN(24), DM, [](int n, float& sc) -> int { sc = 1.f; const int j = n >> 8, c = n & 255; return c < 128 ? 128 * j + c : 2816 + 128 * j + (c - 128); }, g, base, ngt);
            build_bt<true>(wall + W_FFO, 1024, 2816, PIN(28), (size_t)2816 * 1024, 1024, nullptr, 0, [](int n, float& sc) -> int { sc = 1.f; return n; }, g, base, ngt);
            for (size_t it = gt; it < (size_t)DEPTH * 128 * 128; it += ngt) {
                const int l = (int)(it >> 14), j = (int)(it & 127), k0 = (int)((it >> 7) & 127) * 8;
                const float* w_in = PIN(4) + (size_t)l * DM * P_IN; const float* wg = PIN(11) + (size_t)l * 16 * 128; const float* gain = PIN(3) + l * DM;
                float v[8];
#pragma unroll
                for (int e = 0; e < 8; ++e) { float s = 0.f;
#pragma unroll
                    for (int r = 0; r < 16; ++r) s = fmaf(w_in[(size_t)(k0 + e) * P_IN + 1088 + r], wg[r * 128 + j], s);
                    v[e] = s * gain[k0 + e]; }
                u32x4 w; w.x = cvt_pk_f16(v[0], v[1]); w.y = cvt_pk_f16(v[2], v[3]); w.z = cvt_pk_f16(v[4], v[5]); w.w = cvt_pk_f16(v[6], v[7]);
                *(u32x4*)(wall + (size_t)l * W_LAYER + W_IN + (size_t)(768 + j) * 1024 + k0) = w;
            }
        }
        for (size_t it = gt; it < (size_t)T * 32; it += ngt) {
            const int j = (int)(it & 31); const size_t t = it >> 5;
            const int pos = ((const int*)PIN(2))[t];
            float c, s; sincos_d((double)pos * INVF[j], c, s);
            rot[it] = (f32x2){c, s};
        }
        if (gt < 256) {
            const float* lg = PIN(14);
            const float a0 = lg[gt], a1 = lg[256 + gt], a2 = lg[512 + gt], a3 = lg[768 + gt];
            const float mx = fmaxf(fmaxf(a0, a1), fmaxf(a2, a3));
            const float e0 = expf(a0 - mx), e1 = expf(a1 - mx), e2 = expf(a2 - mx), e3 = expf(a3 - mx), inv = 1.0f / (e0 + e1 + e2 + e3);
            lbt[gt] = 0.f; lbt[256 + gt] = e1 * inv; lbt[512 + gt] = (e1 + e2) * inv; lbt[768 + gt] = (e1 + e2 + e3) * inv;
        }
        for (int r = gw; r < NB * NMEM; r += ngw) {
            const f32x4* xr = (const f32x4*)(PIN(1) + (size_t)r * DM) + lane;
            f32x4 v[4]; float s = 0.f;
#pragma unroll
            for (int j = 0; j < 4; ++j) { v[j] = xr[64 * j]; s += (v[j][0] * v[j][0] + v[j][1] * v[j][1]) + (v[j][2] * v[j][2] + v[j][3] * v[j][3]); }
            s = wave_sum(s);
            if (lane == 0) memrstd[r] = 1.0f / sqrtf(s * (1.0f / DM) + EPS);
            u32x2* o8 = (u32x2*)(memb + (size_t)r * DM) + lane;
#pragma unroll
            for (int j = 0; j < 4; ++j) o8[64 * j] = (u32x2){cvt_pk_bf16(v[j][0], v[j][1]), cvt_pk_bf16(v[j][2], v[j][3])};
        }
        NORM_PHASE(x_in);
    } }
    SEAM(0);
    if (IN(1)) { PHASE_BEGIN
#pragma unroll 1
        for (int l = 0; l < DEPTH; ++l) {
            pg8::Gemm g{memb, wall + (size_t)l * W_LAYER + W_CAKV, NB * NMEM, 1024, 1024}; pg8::StaticOrder S; S.init(NB * NMEM, 1024, G, (bx + G - 32 * l) % G);
            EpiScaleF32 E{memrstd, kvraw_ca + (size_t)l * 2048 * 1024, 1024};
            pg8::gemm_phase<EpiScaleF32, pg8::StaticOrder>(glds, g, S, E);
            __syncthreads();
        }
    }
    SEAM(1);
    if (IN(2)) { PHASE_BEGIN
#pragma unroll 1
        for (int l = 0; l < DEPTH; ++l) {
            const float* kvraw_l = kvraw_ca + (size_t)l * 2048 * 1024; bf16_t* kca_l = kca + (size_t)l * 2048 * 512; bf16_t* vca_l = vca + (size_t)l * 2048 * 512;

            const float* qg = PIN(21) + l * 128; const float* kg = PIN(22) + l * 128;
            const int h = lane >> 4, i = lane & 15;
            for (int r = gw; r < NB * NMEM; r += ngw) {
                const int b = r >> 8, m = r & 255;
                const float* src = kvraw_l + (size_t)r * 1024 + h * 256;
                const f32x4 k0 = *(const f32x4*)(src + 8 * i), k1 = *(const f32x4*)(src + 8 * i + 4), v0 = *(const f32x4*)(src + 128 + 8 * i), v1 = *(const f32x4*)(src + 128 + 8 * i + 4);
                float ss = (k0[0] * k0[0] + k0[1] * k0[1]) + (k0[2] * k0[2] + k0[3] * k0[3]) + (k1[0] * k1[0] + k1[1] * k1[1]) + (k1[2] * k1[2] + k1[3] * k1[3]);
                ss = sum16(ss);
                const float rs = 1.0f / sqrtf(ss * (1.0f / 128.0f) + EPS);
                const f32x4 g0 = *(const f32x4*)(kg + 8 * i) * *(const f32x4*)(qg + 8 * i), g1 = *(const f32x4*)(kg + 8 * i + 4) * *(const f32x4*)(qg + 8 * i + 4);
                const size_t o = ((size_t)(b * 4 + h) * NMEM + m) * 128 + 8 * i;
                *(u32x4*)(kca_l + o) = pack8(k0 * rs * g0, k1 * rs * g1);
                *(u32x4*)(vca_l + o) = pack8(v0, v1);
            }
        }
    }
    SEAM(2);

    for (int l = 0; l < DEPTH; ++l) {
        const int pb = NPRE + l * NPH;
#define wl (wall + (size_t)l * W_LAYER)
#define hsrc0 ((l == 0) ? x_in : (const float*)hout)


        if (INP(1)) { _Pragma("unroll 1") for (int rep_ = 0; rep_ < (((PROBE_MASK >> 1) & 1) ? 2 : 1); ++rep_) { PHASE_BEGIN
            int bxo = bx; asm volatile("" : "+s"(bxo));
            pg8::Gemm g{hb, wl + W_IN, T, 2560, 1024}; pg8::StaticOrderG1 S; S.init(T, 2560, G, bxo);
            EpiInProj E{ws, PIN(12) + l * 128, lbt + l * 256, (PG8_LAS float*)(glds + LDS_STAGE)};
            pg8::gemm_phase<EpiInProj, pg8::StaticOrderG1, true>(glds, g, S, E);
        } }
        SEAMP(1);

        if (INP(2)) { _Pragma("unroll 1") for (int rep_ = 0; rep_ < (((PROBE_MASK >> 2) & 1) ? 2 : 1); ++rep_) { PHASE_BEGIN
            for (int uu = bx; uu < 256; uu += G) {
                const int j = uu * 4 + (wave & 3), head = j & 3, seg = (j >> 2) & 31, b = j >> 7;
                const size_t t0 = (size_t)b * SEQ + (size_t)seg * SEGL; const int un = (b * 4 + head) * NSEG + seg;
                char* wlp = (char*)lds + wave * scan::WREG;
                if (wave < 4) scan::seg<32, false>(ga + t0 * 128 + head * 32, 128, nullptr, gqk + t0 * 256 + 128 + head * 32, gv + t0 * 256 + head * 64, nullptr, sg + (size_t)un * 2048, pg + (size_t)un * 32, nullptr, nullptr, wlp, lane);
                else          scan::seg<64, false>(ha + t0 * 256 + head * 64, 256, nullptr, hk + t0 * 256 + head * 64, hi_ + t0 * 256 + head * 64, nullptr, sh + (size_t)un * 4096, ph + (size_t)un * 64, nullptr, nullptr, wlp, lane);
            }
        } }
        SEAMP(2);

        if (INP(3)) { _Pragma("unroll 1") for (int rep_ = 0; rep_ < (((PROBE_MASK >> 3) & 1) ? 2 : 1); ++rep_) { PHASE_BEGIN
            for (size_t c = gt; c < (size_t)32 * 32 * 64; c += ngt) {
                const int bh = (int)(c >> 11), d = (int)(c >> 6) & 31, e = (int)c & 63;
                float* a0 = sg + (size_t)bh * NSEG * 2048 + d * 64 + e; const float* p0 = pg + (size_t)bh * NSEG * 32 + d;
                float sv[NSEG], pv[NSEG];
#pragma unroll
                for (int q = 0; q < NSEG; ++q) { sv[q] = a0[(size_t)q * 2048]; pv[q] = p0[q * 32]; }
                float carry = 0.f;
#pragma unroll
                for (int q = 0; q < NSEG; ++q) { const float tmp = sv[q]; a0[(size_t)q * 2048] = carry; carry = fmaf(pv[q], carry, tmp); }
            }
            for (size_t c = gt; c < (size_t)32 * 64 * 64; c += ngt) {
                const int bh = (int)(c >> 12), d = (int)(c >> 6) & 63, e = (int)c & 63;
                float* a0 = sh + (size_t)bh * NSEG * 4096 + d * 64 + e; const float* p0 = ph + (size_t)bh * NSEG * 64 + d;
                float sv[NSEG], pv[NSEG];
#pragma unroll
                for (int q = 0; q < NSEG; ++q) { sv[q] = a0[(size_t)q * 4096]; pv[q] = p0[q * 64]; }
                float carry = 0.f;
#pragma unroll
                for (int q = 0; q < NSEG; ++q) { const float tmp = sv[q]; a0[(size_t)q * 4096] = carry; carry = fmaf(pv[q], carry, tmp); }
            }
        } }
        SEAMP(3);

        if (INP(4)) { _Pragma("unroll 1") for (int rep_ = 0; rep_ < (((PROBE_MASK >> 4) & 1) ? 2 : 1); ++rep_) { PHASE_BEGIN
            for (int uu = bx; uu < 256; uu += G) {
                const int j = uu * 4 + (wave & 3), head = j & 3, seg = (j >> 2) & 31, b = j >> 7;
                const size_t t0 = (size_t)b * SEQ + (size_t)seg * SEGL; const int un = (b * 4 + head) * NSEG + seg;
                char* wlp = (char*)lds + wave * scan::WREG;
                if (wave < 4) scan::seg<32, true>(ga + t0 * 128 + head * 32, 128, gqk + t0 * 256 + head * 32, gqk + t0 * 256 + 128 + head * 32, gv + t0 * 256 + head * 64, gr + t0 * 256 + head * 64,
                                                  sg + (size_t)un * 2048, nullptr, PIN(13) + l * 64, ybuf + t0 * 1024 + 512 + head * 64, wlp, lane);
                else          scan::seg<64, true>(ha + t0 * 256 + head * 64, 256, hq + t0 * 256 + head * 64, hk + t0 * 256 + head * 64, hi_ + t0 * 256 + head * 64, hg + t0 * 256 + head * 64,
                                                  sh + (size_t)un * 4096, nullptr, PIN(15) + l * 64, ybuf + t0 * 1024 + 768 + head * 64, wlp, lane);
            }
        } }
        SEAMP(4);

        if (INP(5)) { _Pragma("unroll 1") for (int rep_ = 0; rep_ < (((PROBE_MASK >> 5) & 1) ? 2 : 1); ++rep_) { PHASE_BEGIN
            { int k256 = 256; asm volatile("" : "+s"(k256)); pg8::Gemm g{qlat, wl + W_Q, T, 1024, k256}; pg8::StaticOrder S; S.init(T, 1024, G, bx);
              EpiQUp E{ws, PIN(9) + l * 192, (PG8_LAS float*)(glds + LDS_STAGE), (PG8_LAS float*)(glds + LDS_STAGE + 4096)};
              pg8::gemm_phase<EpiQUp, pg8::StaticOrder>(glds, g, S, E); }
            __syncthreads();
            { int k256 = 256; asm volatile("" : "+s"(k256)); pg8::Gemm g{kvlat, wl + W_KV, T, 1024, k256}; pg8::StaticOrder S; S.init(T, 1024, G, bx);
              EpiKVUp E{ws, PIN(10) + l * 192, (PG8_LAS float*)(glds + LDS_STAGE), (PG8_LAS float*)(glds + LDS_STAGE + 4096)};
              pg8::gemm_phase<EpiKVUp, pg8::StaticOrder>(glds, g, S, E); }
        } }
        SEAMP(5);

        if (INP(7)) { _Pragma("unroll 1") for (int rep_ = 0; rep_ < (((PROBE_MASK >> 7) & 1) ? 2 : 1); ++rep_) { PHASE_BEGIN
#pragma unroll 1
            for (int uid = bx * 4; uid < 1024; uid += G * 4) {
            const int vbx = uid >> 2;
            const int bh = (vbx & 7) * 4 + ((vbx >> 3) & 3), gg = (vbx >> 5) & 7, b = bh >> 2, h = bh & 3;
#pragma unroll 1
            for (int ui = 0; ui < 3; ++ui) {
                const int qblk = (ui == 0) ? 31 - gg : (ui == 1) ? 16 + gg : 15 - gg;
                att::attn_body_dma(qb + ((size_t)bh * SEQ + (size_t)qblk * 256) * 192, 192, kn + (size_t)bh * SEQ * 128, krh + (size_t)bh * SEQ * 64, vb + (size_t)bh * SEQ * 128,
                                  ybuf + ((size_t)b * SEQ + (size_t)qblk * 256) * 1024 + h * 128, 1024, 4 * qblk + 4, 4 * qblk + (wave >> 1), (char*)lds, (LAS unsigned char*)lds);
            }
            }
            {
                volatile LAS int* slot = (volatile LAS int*)((LAS unsigned char*)lds + LDS_MISC + 128);
                int* ctr = (int*)(ws + WS_CTL + 16384 + l * 64);
#pragma unroll 1
                for (;;) {
                    __syncthreads();
                    if (tid == 0) *slot = atomicAdd(ctr, 1);
                    __syncthreads();
                    const int u = __builtin_amdgcn_readfirstlane(*slot);
                    if (u >= 256) break;
                    const int qblk = 7 - (u >> 5), bh = u & 31, b = bh >> 2, h = bh & 3;
                    att::attn_body_dma(qb + ((size_t)bh * SEQ + (size_t)qblk * 256) * 192, 192, kn + (size_t)bh * SEQ * 128, krh + (size_t)bh * SEQ * 64, vb + (size_t)bh * SEQ * 128,
                                      ybuf + ((size_t)b * SEQ + (size_t)qblk * 256) * 1024 + h * 128, 1024, 4 * qblk + 4, 4 * qblk + (wave >> 1), (char*)lds, (LAS unsigned char*)lds);
                }
            }
        } }
        SEAMP(7);

        if (INP(8)) { _Pragma("unroll 1") for (int rep_ = 0; rep_ < (((PROBE_MASK >> 8) & 1) ? 2 : 1); ++rep_) { PHASE_BEGIN
#pragma unroll 1
            for (int pm = bx; pm < T / 256; pm += G) {
                { pg8::Gemm g{ybuf, wl + W_MIX, T, 1024, 1024}; pg8::PanelOrder S{pm, 4}; EpiResid E{hb, hb, hout, part, 0};
                  pg8::gemm_phase<EpiResid, pg8::PanelOrder>(glds, g, S, E); }
                __syncthreads();
                { pg8::Gemm g{hb, wl + W_CAQ, T, 512, 1024}; pg8::PanelOrder S{pm, 2}; EpiScaleBf16<true> E{part, qca, 512, (PG8_LAS float*)(glds + LDS_STAGE)};
                  pg8::gemm_phase<EpiScaleBf16<true>, pg8::PanelOrder, true>(glds, g, S, E); }
                __syncthreads();
                { const int b = pm >> 5, qblk = pm & 31;
#pragma unroll 1
                  for (int h = 0; h < 4; ++h) { const int bh = b * 4 + h;
                      att::attn_body<1, 2>(qca + ((size_t)b * SEQ + (size_t)qblk * 256) * 512 + h * 128, 512, kca + (size_t)l * 2048 * 512 + (size_t)bh * NMEM * 128, nullptr, vca + (size_t)l * 2048 * 512 + (size_t)bh * NMEM * 128,
                                        oca + ((size_t)b * SEQ + (size_t)qblk * 256) * 512 + h * 128, 512, 4, 1 << 30, (char*)lds); } }
                __syncthreads();
                { pg8::Gemm g{oca, wl + W_CAO, T, 1024, 512}; pg8::PanelOrder S{pm, 4}; EpiResid E{hb, hb, hout, part, 0};
                  pg8::gemm_phase<EpiResid, pg8::PanelOrder>(glds, g, S, E); }
                __syncthreads();
            }
        } }
        SEAMP(8);

        if (false) { }

        if (INP(15)) { _Pragma("unroll 1") for (int rep_ = 0; rep_ < (((PROBE_MASK >> 15) & 1) ? 2 : 1); ++rep_) { PHASE_BEGIN
            pg8::Gemm g{hb, wl + W_FFI, T, 5632, 1024}; pg8::StaticOrder S; S.init(T, 5632, G, bx);
            EpiGateUpConv E{part, uraw, ghb, uhb, PIN(26) + (size_t)l * 3 * D_FF, PIN(27) + (size_t)l * D_FF, (PG8_LAS float*)(glds + LDS_STAGE), (PG8_LAS float*)(glds + LDS_STAGE + 4096)};
            pg8::gemm_phase<EpiGateUpConv, pg8::StaticOrder, true>(glds, g, S, E);
        } }
        SEAMP(15);

        if (INP(16)) { _Pragma("unroll 1") for (int rep_ = 0; rep_ < (((PROBE_MASK >> 16) & 1) ? 2 : 1); ++rep_) { PHASE_BEGIN
            const float* cw = PIN(26) + (size_t)l * 3 * D_FF; const float* cbias = PIN(27) + (size_t)l * D_FF;
            for (size_t it = gt; it < (size_t)256 * (D_FF / 8); it += ngt) {
                const int c = (int)(it % (D_FF / 8)) * 8, pm = (int)(it / (D_FF / 8));
                if ((pm & 31) == 0) continue;
                f32x4 gm2[2], gm1[2], g0[2], g1[2], w0[2], w1[2], w2[2], bb[2], u0[2], u1[2];
#pragma unroll
                for (int hh = 0; hh < 2; ++hh) { const int cc = c + 4 * hh;
                    gm2[hh] = *(const f32x4*)(ghb + ((size_t)(pm - 1) * 4 + 0) * D_FF + cc); gm1[hh] = *(const f32x4*)(ghb + ((size_t)(pm - 1) * 4 + 1) * D_FF + cc);
                    g0[hh] = *(const f32x4*)(ghb + ((size_t)pm * 4 + 2) * D_FF + cc); g1[hh] = *(const f32x4*)(ghb + ((size_t)pm * 4 + 3) * D_FF + cc);
                    u0[hh] = *(const f32x4*)(uhb + ((size_t)pm * 2) * D_FF + cc); u1[hh] = *(const f32x4*)(uhb + ((size_t)pm * 2 + 1) * D_FF + cc);
                    w0[hh] = *(const f32x4*)(cw + cc); w1[hh] = *(const f32x4*)(cw + D_FF + cc); w2[hh] = *(const f32x4*)(cw + 2 * D_FF + cc); bb[hh] = *(const f32x4*)(cbias + cc); }
                float o0[8], o1[8];
#pragma unroll
                for (int hh = 0; hh < 2; ++hh)
#pragma unroll
                    for (int e = 0; e < 4; ++e) {
                        const float c0v = bb[hh][e] + gm2[hh][e] * w0[hh][e] + gm1[hh][e] * w1[hh][e] + g0[hh][e] * w2[hh][e], c1v = bb[hh][e] + gm1[hh][e] * w0[hh][e] + g0[hh][e] * w1[hh][e] + g1[hh][e] * w2[hh][e];
                        o0[4 * hh + e] = fast_silu(c0v) * u0[hh][e]; o1[4 * hh + e] = fast_silu(c1v) * u1[hh][e]; }
                *(u32x4*)(uraw + ((size_t)pm * 256) * D_FF + c) = (u32x4){cvt_pk_f16(o0[0], o0[1]), cvt_pk_f16(o0[2], o0[3]), cvt_pk_f16(o0[4], o0[5]), cvt_pk_f16(o0[6], o0[7])};
                *(u32x4*)(uraw + ((size_t)pm * 256 + 1) * D_FF + c) = (u32x4){cvt_pk_f16(o1[0], o1[1]), cvt_pk_f16(o1[2], o1[3]), cvt_pk_f16(o1[4], o1[5]), cvt_pk_f16(o1[6], o1[7])};
            }
        } }
        SEAMP(16);

        if (INP(17)) { _Pragma("unroll 1") for (int rep_ = 0; rep_ < (((PROBE_MASK >> 17) & 1) ? 2 : 1); ++rep_) { PHASE_BEGIN
            pg8::Gemm g{uraw, wl + W_FFO, T, 1024, 2816}; pg8::StaticOrder S; S.init(T, 1024, G, bx); EpiResid E{hb, (((PROBE_MASK >> 17) & 1) && rep_ == 0) ? (bf16_t*)(ws + WS_R + 32 * MiB) : hb, hout, part, ((l == DEPTH - 1) && !(((PROBE_MASK >> 17) & 1) && rep_ == 0)) ? 1 : 0};
            pg8::gemm_phase<EpiResid, pg8::StaticOrder, true>(glds, g, S, E);
        } }
        SEAMP(17);
    }
#undef IN
#undef SEAM
#undef INP
#undef SEAMP
#undef INR
#undef PHSEL
#undef PHASE_BEGIN
#undef PIN
#undef x_in
#undef hout
#undef lbt
#undef rstd
#undef part
#undef latpb
#undef cq
#undef ckv
#undef memrstd
#undef memb
#undef kvraw_ca
#undef kca
#undef vca
#undef rot
#undef wall
#undef hb
#undef gqk
#undef gv
#undef gr
#undef hq
#undef hi_
#undef hg
#undef hk
#undef ga
#undef ha
#undef qlat
#undef kvlat
#undef krope
#undef ybuf
#undef sg
#undef sh
#undef pg
#undef ph
#undef qb
#undef krh
#undef qraw
#undef kvraw
#undef kn
#undef vb
#undef qca
#undef oca
#undef ghb
#undef uhb
#undef uraw
#undef wl
#undef hsrc0
}

typedef void (*kern_t)(Params);
extern "C" void kernel_launch(void* const* d_in, const int* in_sizes, int n_in, void* d_out, int out_size, void* d_ws, size_t ws_size, hipStream_t stream) {
#if MK_FUSED
    static const kern_t kt[1] = {mk_fwd<-1>};
    constexpr int NK = 1;
#else
    static const kern_t kt[19] = {mk_fwd<0>, mk_fwd<1>, mk_fwd<2>, mk_fwd<3>, mk_fwd<4>, mk_fwd<5>, mk_fwd<6>, mk_fwd<7>, mk_fwd<8>, mk_fwd<9>, mk_fwd<10>, mk_fwd<11>, mk_fwd<12>, mk_fwd<13>, mk_fwd<14>,
                                  mk_fwd<15>, mk_fwd<16>, mk_fwd<17>, mk_fwd<18>};
    constexpr int NK = 19;
#endif
    static int grid = 0;
    if (grid == 0) {
        if (n_in != 29 || out_size != T * DM || ws_size < WS_END) { fprintf(stderr, "kernel_launch: unexpected shapes (n_in %d out %d ws %zu need %zu)\n", n_in, out_size, ws_size, (size_t)WS_END); grid = -1; return; }
        int dev = 0, cus = 0, per_cu = 0;
        if (hipGetDevice(&dev) != hipSuccess || hipDeviceGetAttribute(&cus, hipDeviceAttributeMultiprocessorCount, dev) != hipSuccess) { grid = -1; return; }
        for (int i = 0; i < NK; ++i)
            if (hipFuncSetAttribute((const void*)kt[i], hipFuncAttributeMaxDynamicSharedMemorySize, (int)LDS_BYTES) != hipSuccess) { fprintf(stderr, "kernel_launch: hipFuncSetAttribute failed\n"); grid = -1; return; }
        if (hipOccupancyMaxActiveBlocksPerMultiprocessor(&per_cu, (const void*)kt[0], NTHREADS, LDS_BYTES) != hipSuccess || per_cu < 1) fprintf(stderr, "kernel_launch: occupancy query says %d\n", per_cu);
        (void)hipGetLastError();
        grid = cus;
    }
    if (grid < 0) return;
    (void)hipMemsetAsync((char*)d_ws + WS_CTL, 0, CTL_BYTES, stream);
    Params p{};
    for (int i = 0; i < 29; ++i) p.in[i] = (const float*)d_in[i];
    p.out = (float*)d_out; p.ws = (unsigned char*)d_ws;
#if MK_FUSED
    p.ph_lo = 0; p.ph_hi = NPHASES;
    hipLaunchKernelGGL(kt[0], dim3(grid), dim3(NTHREADS), LDS_BYTES, stream, p);
#else
    for (int k = 0; k < NPHASES; ++k) { p.ph_lo = k; p.ph_hi = k + 1; const int sel = (k < NPRE) ? 0 : ((k - NPRE) % NPH) + 1;
        hipLaunchKernelGGL(kt[sel], dim3(grid), dim3(NTHREADS), LDS_BYTES, stream, p); }
#endif
    const hipError_t le = hipPeekAtLastError();
    if (le != hipSuccess) fprintf(stderr, "kernel_launch: launch failed: %s\n", hipGetErrorName(le));
}
```
